# Optimizing an MI355X kernel written in HIP

```python
import jax, jax.numpy as jnp
from jax import lax
import numpy as np

D_MODEL = 1024
BATCH = 8
SEQ = 2048
DEPTH = 4

GRID_W = 64
CTX_LEN = 256
N_MIXERS = 4
HEAD_DIM = 64
ROPE_THETA = 10000.0
NA_HEADS = 16
NA_WIN_H = 8
NA_WIN_W = 16
GQA_HEADS = 16
GQA_KV_HEADS = 4
SWA_HEADS = 16
SWA_KV_HEADS = 2
SWA_WINDOW = 128
Q_BLOCK = 128
LRU_WIDTH = D_MODEL
LRU_BLOCKS = 16
LRU_BLOCK_DIM = LRU_WIDTH // LRU_BLOCKS
CONV_WIDTH = 4
LRU_C = 8.0
FFN_HIDDEN = ((8 * D_MODEL + 2) // 3 + 255) // 256 * 256
N_MOD = 6
EPS = 1e-6
MASK_VALUE = -1e30
N_NA_LAYERS = (DEPTH + 3) // N_MIXERS
N_GQA_LAYERS = (DEPTH + 2) // N_MIXERS
N_SWA_LAYERS = (DEPTH + 1) // N_MIXERS
N_LRU_LAYERS = DEPTH // N_MIXERS

kernel_name = 'hybrid_dit_interleaved_na_gqa_swa_rglru'


def rms_norm(x, g):
    xf = x.astype(jnp.float32)
    y = xf * lax.rsqrt(jnp.mean(xf * xf, axis=-1, keepdims=True) + EPS)
    return (y * g.astype(jnp.float32)).astype(x.dtype)


def ada_norm(x, g, shift, scale):
    return rms_norm(x, g) * (1.0 + scale) + shift


def axial_angles(n_tokens):
    t = jnp.arange(n_tokens, dtype=jnp.int32)
    row = (t // GRID_W).astype(jnp.float32)
    col = (t % GRID_W).astype(jnp.float32)
    half = HEAD_DIM // 2
    inv_freq = 1.0 / (ROPE_THETA ** (jnp.arange(0, half, 2, dtype=jnp.float32) / half))
    return row[:, None] * inv_freq, col[:, None] * inv_freq


def _rotate(x, ang):
    cos = jnp.cos(ang)[None, :, None, :].astype(x.dtype)
    sin = jnp.sin(ang)[None, :, None, :].astype(x.dtype)
    x1, x2 = jnp.split(x, 2, axis=-1)
    return jnp.concatenate([x1 * cos - x2 * sin, x1 * sin + x2 * cos], axis=-1)


def axial_rope(x, ang_row, ang_col):
    xr, xc = jnp.split(x, 2, axis=-1)
    return jnp.concatenate([_rotate(xr, ang_row), _rotate(xc, ang_col)], axis=-1)


def project_qkv(h, w_qkv, n_q, n_kv):
    b, t, _ = h.shape
    qkv = h @ w_qkv
    q, k, v = jnp.split(qkv, [n_q * HEAD_DIM, (n_q + n_kv) * HEAD_DIM], axis=-1)
    return (q.reshape(b, t, n_q, HEAD_DIM), k.reshape(b, t, n_kv, HEAD_DIM), v.reshape(b, t, n_kv, HEAD_DIM))


def attn_probs(s, sink=None):
    if sink is None:
        return jax.nn.softmax(s, axis=-1)
    sk = sink.astype(jnp.float32)[None, :, :, None, None]
    m = jnp.maximum(jnp.max(s, axis=-1, keepdims=True), sk)
    e = jnp.exp(s - m)
    return e / (jnp.sum(e, axis=-1, keepdims=True) + jnp.exp(sk - m))


def context_attention(q, k, v, sink=None):
    b, t, n_q, dh = q.shape
    n_kv = k.shape[2]
    qg = q.reshape(b, t, n_kv, n_q // n_kv, dh)
    s = jnp.einsum('bqhgd,bshd->bhgqs', qg, k).astype(jnp.float32) * dh ** -0.5
    p = attn_probs(s, sink).astype(v.dtype)
    o = jnp.einsum('bhgqs,bshd->bqhgd', p, v)
    return o.reshape(b, t, n_q * dh)


def neighbourhood_attention_mixer(h_lat, h_ctx, w_qkv, rpb, w_o, with_ctx_out):
    b, s_len, _ = h_lat.shape
    rows = s_len // GRID_W
    kh = min(NA_WIN_H, rows)
    scale = HEAD_DIM ** -0.5
    q, k, v = project_qkv(h_lat, w_qkv, NA_HEADS, NA_HEADS)
    qc, kc, vc = project_qkv(h_ctx, w_qkv, NA_HEADS, NA_HEADS)
    k_grid = k.reshape(b, rows, GRID_W, NA_HEADS, HEAD_DIM)
    v_grid = v.reshape(b, rows, GRID_W, NA_HEADS, HEAD_DIM)
    q_rows = jnp.moveaxis(q.reshape(b, rows, GRID_W, NA_HEADS, HEAD_DIM), 1, 0)
    qcol = jnp.arange(GRID_W, dtype=jnp.int32)
    kcol = jnp.arange(GRID_W, dtype=jnp.int32)
    col_start = jnp.clip(qcol - NA_WIN_W // 2, 0, GRID_W - NA_WIN_W)
    col_in = (kcol[None, :] >= col_start[:, None]) & (kcol[None, :] < col_start[:, None] + NA_WIN_W)
    dcol = jnp.clip(kcol[None, :] - qcol[:, None] + NA_WIN_W - 1, 0, 2 * NA_WIN_W - 2)
    n_nb = kh * GRID_W

    def row_block(args):
        r, q_r = args
        r0 = jnp.clip(r - kh // 2, 0, rows - kh)
        k_b = lax.dynamic_slice_in_dim(k_grid, r0, kh, axis=1)
        v_b = lax.dynamic_slice_in_dim(v_grid, r0, kh, axis=1).reshape(b, n_nb, NA_HEADS, HEAD_DIM)
        drow = r0 + jnp.arange(kh, dtype=jnp.int32) - r + NA_WIN_H - 1
        bias = rpb[:, drow[None, :, None], dcol[:, None, :]]
        s_nb = jnp.einsum('bqhd,biwhd->bhqiw', q_r, k_b).astype(jnp.float32) * scale + bias.astype(jnp.float32)[None]
        s_nb = jnp.where(col_in[None, None, :, None, :], s_nb, MASK_VALUE).reshape(b, NA_HEADS, GRID_W, n_nb)
        s_cx = jnp.einsum('bqhd,bshd->bhqs', q_r, kc).astype(jnp.float32) * scale
        p = jax.nn.softmax(jnp.concatenate([s_nb, s_cx], axis=-1), axis=-1).astype(v.dtype)
        return (jnp.einsum('bhqn,bnhd->bqhd', p[..., :n_nb], v_b)
                + jnp.einsum('bhqs,bshd->bqhd', p[..., n_nb:], vc))

    o = lax.map(row_block, (jnp.arange(rows, dtype=jnp.int32), q_rows))
    y_lat = jnp.moveaxis(o, 0, 1).reshape(b, s_len, NA_HEADS * HEAD_DIM) @ w_o
    y_ctx = context_attention(qc, kc, vc) @ w_o if with_ctx_out else None
    return y_lat, y_ctx


def qknorm_gqa_mixer(h_lat, h_ctx, w_qkv, q_gain, k_gain, w_o, ang_row, ang_col, with_ctx_out):
    b, s_len, _ = h_lat.shape
    g = GQA_HEADS // GQA_KV_HEADS
    scale = HEAD_DIM ** -0.5
    q, k, v = project_qkv(h_lat, w_qkv, GQA_HEADS, GQA_KV_HEADS)
    qc, kc, vc = project_qkv(h_ctx, w_qkv, GQA_HEADS, GQA_KV_HEADS)
    q = axial_rope(rms_norm(q, q_gain), ang_row, ang_col)
    k = axial_rope(rms_norm(k, k_gain), ang_row, ang_col)
    qc = rms_norm(qc, q_gain)
    kc = rms_norm(kc, k_gain)
    k_all = jnp.concatenate([kc, k], axis=1)
    v_all = jnp.concatenate([vc, v], axis=1)
    nb = s_len // Q_BLOCK
    q_blocks = jnp.moveaxis(q.reshape(b, nb, Q_BLOCK, GQA_KV_HEADS, g, HEAD_DIM), 1, 0)

    def block(q_b):
        s = jnp.einsum('bqhgd,bshd->bhgqs', q_b, k_all).astype(jnp.float32) * scale
        p = jax.nn.softmax(s, axis=-1).astype(v_all.dtype)
        return jnp.einsum('bhgqs,bshd->bqhgd', p, v_all)

    o = lax.map(block, q_blocks)
    y_lat = jnp.moveaxis(o, 0, 1).reshape(b, s_len, GQA_HEADS * HEAD_DIM) @ w_o
    y_ctx = context_attention(qc, kc, vc) @ w_o if with_ctx_out else None
    return y_lat, y_ctx


def sliding_window_mixer(h_lat, h_ctx, w_qkv, sinks, w_o, ang_row, ang_col, with_ctx_out):
    b, s_len, _ = h_lat.shape
    g = SWA_HEADS // SWA_KV_HEADS
    scale = HEAD_DIM ** -0.5
    q, k, v = project_qkv(h_lat, w_qkv, SWA_HEADS, SWA_KV_HEADS)
    qc, kc, vc = project_qkv(h_ctx, w_qkv, SWA_HEADS, SWA_KV_HEADS)
    q = axial_rope(q, ang_row, ang_col)
    k = axial_rope(k, ang_row, ang_col)
    sink = sinks.reshape(SWA_KV_HEADS, g)
    band = Q_BLOCK + 2 * SWA_WINDOW
    pad = ((0, 0), (SWA_WINDOW, SWA_WINDOW), (0, 0), (0, 0))
    k_pad = jnp.pad(k, pad)
    v_pad = jnp.pad(v, pad)
    nb = s_len // Q_BLOCK
    q_blocks = jnp.moveaxis(q.reshape(b, nb, Q_BLOCK, SWA_KV_HEADS, g, HEAD_DIM), 1, 0)

    def block(args):
        j, q_b = args
        start = j * Q_BLOCK
        k_b = lax.dynamic_slice_in_dim(k_pad, start, band, axis=1)
        v_b = lax.dynamic_slice_in_dim(v_pad, start, band, axis=1)
        qpos = start + jnp.arange(Q_BLOCK, dtype=jnp.int32)
        kpos = start - SWA_WINDOW + jnp.arange(band, dtype=jnp.int32)
        valid = ((jnp.abs(qpos[:, None] - kpos[None, :]) <= SWA_WINDOW)
                 & (kpos[None, :] >= 0) & (kpos[None, :] < s_len))
        s_loc = jnp.einsum('bqhgd,bshd->bhgqs', q_b, k_b).astype(jnp.float32) * scale
        s_loc = jnp.where(valid, s_loc, MASK_VALUE)
        s_cx = jnp.einsum('bqhgd,bshd->bhgqs', q_b, kc).astype(jnp.float32) * scale
        p = attn_probs(jnp.concatenate([s_loc, s_cx], axis=-1), sink).astype(v.dtype)
        return (jnp.einsum('bhgqs,bshd->bqhgd', p[..., :band], v_b)
                + jnp.einsum('bhgqs,bshd->bqhgd', p[..., band:], vc))

    o = lax.map(block, (jnp.arange(nb, dtype=jnp.int32), q_blocks))
    y_lat = jnp.moveaxis(o, 0, 1).reshape(b, s_len, SWA_HEADS * HEAD_DIM) @ w_o
    y_ctx = context_attention(qc, kc, vc, sink) @ w_o if with_ctx_out else None
    return y_lat, y_ctx


def centred_depthwise_conv(x, w, bias):
    t = x.shape[1]
    left = CONV_WIDTH // 2
    xp = jnp.pad(x, ((0, 0), (left, CONV_WIDTH - 1 - left), (0, 0)))
    return sum(xp[:, kk:kk + t] * w[kk] for kk in range(CONV_WIDTH)) + bias


def rglru_coeffs(x, w_a, b_a, w_x, b_x, lam):
    b, t, _ = x.shape
    xf = x.astype(jnp.float32)
    xb = xf.reshape(b, t, LRU_BLOCKS, LRU_BLOCK_DIM)
    r = jax.nn.sigmoid(jnp.einsum('btnd,nde->btne', xb, w_a.astype(jnp.float32)).reshape(b, t, LRU_WIDTH) + b_a.astype(jnp.float32))
    ig = jax.nn.sigmoid(jnp.einsum('btnd,nde->btne', xb, w_x.astype(jnp.float32)).reshape(b, t, LRU_WIDTH) + b_x.astype(jnp.float32))
    log_a = -LRU_C * r * jax.nn.softplus(-lam.astype(jnp.float32))
    return jnp.exp(log_a), jnp.sqrt(-jnp.expm1(2.0 * log_a)) * (ig * xf)


def linear_scan(a, bx, h0):
    def combine(left, right):
        a_l, b_l = left
        a_r, b_r = right
        return a_r * a_l, a_r * b_l + b_r
    a_cum, b_cum = lax.associative_scan(combine, (a, bx), axis=1)
    return a_cum * h0[:, None, :] + b_cum


def rglru_mixer(h_lat, h_ctx, w_in, conv_w, conv_b, w_a, b_a, w_x, b_x, lam, w_out, with_ctx_out):
    def branches(h):
        xr, gate = jnp.split(h @ w_in, 2, axis=-1)
        return centred_depthwise_conv(xr, conv_w, conv_b), jax.nn.gelu(gate, approximate=True)

    xc, gc = branches(h_ctx)
    xl, gl = branches(h_lat)
    hc_sum = jnp.zeros(xc.shape, jnp.float32)
    hl_sum = jnp.zeros(xl.shape, jnp.float32)
    for d in range(2):
        ac, bc = rglru_coeffs(xc, w_a[d], b_a[d], w_x[d], b_x[d], lam[d])
        al, bl = rglru_coeffs(xl, w_a[d], b_a[d], w_x[d], b_x[d], lam[d])
        if d == 1:
            ac, bc, al, bl = jnp.flip(ac, 1), jnp.flip(bc, 1), jnp.flip(al, 1), jnp.flip(bl, 1)
        hc = linear_scan(ac, bc, jnp.zeros_like(bc[:, 0]))
        hl = linear_scan(al, bl, hc[:, -1])
        if d == 1:
            hc, hl = jnp.flip(hc, 1), jnp.flip(hl, 1)
        hc_sum = hc_sum + hc
        hl_sum = hl_sum + hl
    y_lat = (hl_sum.astype(h_lat.dtype) * gl) @ w_out
    y_ctx = (hc_sum.astype(h_ctx.dtype) * gc) @ w_out if with_ctx_out else None
    return y_lat, y_ctx


def swiglu_ffn(h, w_in, w_out):
    a, g = jnp.split(h @ w_in, 2, axis=-1)
    return (jax.nn.silu(a) * g) @ w_out


def setup_inputs(seed: int = 0) -> dict:
    key = jax.random.key(seed)
    ks = jax.random.split(key, 32)

    def nrm(k, shape, scale):
        return jax.random.normal(k, shape, jnp.float32) * scale

    def gain(k, shape):
        return 1.0 + 0.02 * jax.random.normal(k, shape, jnp.float32)

    d = D_MODEL
    a0 = jnp.sqrt(jax.random.uniform(ks[26], (N_LRU_LAYERS, 2, LRU_WIDTH), jnp.float32, 0.81, 0.998))
    return {
        'x': nrm(ks[0], (BATCH, SEQ, d), 1.0),
        'c': nrm(ks[1], (BATCH, d), 1.0),
        'ctx': nrm(ks[2], (BATCH, CTX_LEN, d), 1.0),
        'c_ctx': nrm(ks[3], (d,), 1.0),
        'ada_w': nrm(ks[4], (DEPTH, d, N_MOD * d), 0.5 * d ** -0.5),
        'ada_b': nrm(ks[5], (DEPTH, N_MOD * d), 0.02),
        'norm_mix': gain(ks[6], (DEPTH, d)),
        'norm_ffn': gain(ks[7], (DEPTH, d)),
        'norm_final': gain(ks[8], (d,)),
        'ffn_w_in': nrm(ks[9], (DEPTH, d, 2 * FFN_HIDDEN), d ** -0.5),
        'ffn_w_out': nrm(ks[10], (DEPTH, FFN_HIDDEN, d), FFN_HIDDEN ** -0.5),
        'na_w_qkv': nrm(ks[11], (N_NA_LAYERS, d, 3 * NA_HEADS * HEAD_DIM), d ** -0.5),
        'na_rpb': nrm(ks[12], (N_NA_LAYERS, NA_HEADS, 2 * NA_WIN_H - 1, 2 * NA_WIN_W - 1), 0.1),
        'na_w_o': nrm(ks[13], (N_NA_LAYERS, NA_HEADS * HEAD_DIM, d), (NA_HEADS * HEAD_DIM) ** -0.5),
        'gqa_w_qkv': nrm(ks[14], (N_GQA_LAYERS, d, (GQA_HEADS + 2 * GQA_KV_HEADS) * HEAD_DIM), d ** -0.5),
        'gqa_q_gain': gain(ks[15], (N_GQA_LAYERS, HEAD_DIM)),
        'gqa_k_gain': gain(ks[16], (N_GQA_LAYERS, HEAD_DIM)),
        'gqa_w_o': nrm(ks[17], (N_GQA_LAYERS, GQA_HEADS * HEAD_DIM, d), (GQA_HEADS * HEAD_DIM) ** -0.5),
        'swa_w_qkv': nrm(ks[18], (N_SWA_LAYERS, d, (SWA_HEADS + 2 * SWA_KV_HEADS) * HEAD_DIM), d ** -0.5),
        'swa_sinks': nrm(ks[19], (N_SWA_LAYERS, SWA_HEADS), 0.5),
        'swa_w_o': nrm(ks[20], (N_SWA_LAYERS, SWA_HEADS * HEAD_DIM, d), (SWA_HEADS * HEAD_DIM) ** -0.5),
        'lru_w_in': nrm(ks[21], (N_LRU_LAYERS, d, 2 * LRU_WIDTH), d ** -0.5),
        'lru_conv_w': nrm(ks[22], (N_LRU_LAYERS, CONV_WIDTH, LRU_WIDTH), CONV_WIDTH ** -0.5),
        'lru_conv_b': nrm(ks[23], (N_LRU_LAYERS, LRU_WIDTH), 0.02),
        'lru_w_a': nrm(ks[24], (N_LRU_LAYERS, 2, LRU_BLOCKS, LRU_BLOCK_DIM, LRU_BLOCK_DIM), LRU_BLOCK_DIM ** -0.5),
        'lru_b_a': nrm(ks[25], (N_LRU_LAYERS, 2, LRU_WIDTH), 0.02),
        'lru_w_x': nrm(ks[27], (N_LRU_LAYERS, 2, LRU_BLOCKS, LRU_BLOCK_DIM, LRU_BLOCK_DIM), LRU_BLOCK_DIM ** -0.5),
        'lru_b_x': nrm(ks[28], (N_LRU_LAYERS, 2, LRU_WIDTH), 0.02),
        'lru_lam': jnp.log(a0) - jnp.log1p(-a0),
        'lru_w_out': nrm(ks[29], (N_LRU_LAYERS, LRU_WIDTH, d), LRU_WIDTH ** -0.5),
    }


def reference(x, c, ctx, c_ctx, ada_w, ada_b, norm_mix, norm_ffn, norm_final, ffn_w_in, ffn_w_out,
              na_w_qkv, na_rpb, na_w_o, gqa_w_qkv, gqa_q_gain, gqa_k_gain, gqa_w_o,
              swa_w_qkv, swa_sinks, swa_w_o, lru_w_in, lru_conv_w, lru_conv_b, lru_w_a, lru_b_a,
              lru_w_x, lru_b_x, lru_lam, lru_w_out):
    s_len = x.shape[1]
    ang_row, ang_col = axial_angles(s_len)
    silu_c = jax.nn.silu(c)
    silu_cc = jax.nn.silu(c_ctx)
    h = x
    hc = ctx
    for i in range(DEPTH):
        kind = i % N_MIXERS
        slot = i // N_MIXERS
        ctx_out = i < DEPTH - 1
        mod_l = (silu_c @ ada_w[i] + ada_b[i])[:, None, :]
        mod_c = (silu_cc @ ada_w[i] + ada_b[i])[None, None, :]
        sh1_l, sc1_l, g1_l, sh2_l, sc2_l, g2_l = jnp.split(mod_l, N_MOD, axis=-1)
        sh1_c, sc1_c, g1_c, sh2_c, sc2_c, g2_c = jnp.split(mod_c, N_MOD, axis=-1)
        a_l = ada_norm(h, norm_mix[i], sh1_l, sc1_l)
        a_c = ada_norm(hc, norm_mix[i], sh1_c, sc1_c)
        if kind == 0:
            y_l, y_c = neighbourhood_attention_mixer(a_l, a_c, na_w_qkv[slot], na_rpb[slot], na_w_o[slot], ctx_out)
        elif kind == 1:
            y_l, y_c = qknorm_gqa_mixer(a_l, a_c, gqa_w_qkv[slot], gqa_q_gain[slot], gqa_k_gain[slot],
                                        gqa_w_o[slot], ang_row, ang_col, ctx_out)
        elif kind == 2:
            y_l, y_c = sliding_window_mixer(a_l, a_c, swa_w_qkv[slot], swa_sinks[slot], swa_w_o[slot],
                                            ang_row, ang_col, ctx_out)
        else:
            y_l, y_c = rglru_mixer(a_l, a_c, lru_w_in[slot], lru_conv_w[slot], lru_conv_b[slot],
                                   lru_w_a[slot], lru_b_a[slot], lru_w_x[slot], lru_b_x[slot],
                                   lru_lam[slot], lru_w_out[slot], ctx_out)
        h = h + g1_l * y_l
        h = h + g2_l * swiglu_ffn(ada_norm(h, norm_ffn[i], sh2_l, sc2_l), ffn_w_in[i], ffn_w_out[i])
        if ctx_out:
            hc = hc + g1_c * y_c
            hc = hc + g2_c * swiglu_ffn(ada_norm(hc, norm_ffn[i], sh2_c, sc2_c), ffn_w_in[i], ffn_w_out[i])
    return rms_norm(h, norm_final)
```

```cpp
#include <hip/hip_runtime.h>
#include <cstdio>
#include <cstdint>

constexpr int DM = 1024, NB = 8, SEQ = 2048, CTXL = 256, HD = 64, FF = 2816, NMOD = 6;
constexpr int ML = NB * SEQ;
constexpr int MC = NB * CTXL;
constexpr int MT = ML + MC;
constexpr float LOG2E = 1.4426950408889634f;
constexpr float QSCALE = 0.125f * LOG2E;
constexpr size_t SLAB = 14155776;
constexpr size_t SL_Q = 0, SL_K = 4718592, SL_V = 9437184;
constexpr size_t SL_HM = 0;
constexpr size_t SL_XR = 0, SL_GL = 4718592;
__host__ __device__ __forceinline__ int pan_b(int pm) { return pm < 64 ? pm >> 3 : pm - 64; }
__host__ __device__ __forceinline__ int pan_p(int pm) { return pm < 64 ? pm & 7 : 8; }
__device__ __forceinline__ int fresh_tid(int wave0) { int l; asm volatile("v_mbcnt_lo_u32_b32 %0, -1, 0\n\tv_mbcnt_hi_u32_b32 %0, -1, %0" : "=v"(l)); return wave0 * 64 + l; }
namespace pg8 {
#define PG8_LAS __attribute__((address_space(3)))
typedef unsigned short bf16_t;
typedef short bf16x8 __attribute__((ext_vector_type(8)));
typedef float f32x4 __attribute__((ext_vector_type(4)));
typedef unsigned u32x4 __attribute__((ext_vector_type(4)));
constexpr int BM = 256, BK = 64, HALF = 128, HTB = HALF * BK * 2  , STAGE_BYTES = 8 * HTB, NXCD = 8, WGM = 8;

__host__ __device__ __forceinline__ int lds_byte(int r, int c) { const int st = (r >> 4) * 2 + (c >> 5), rr = r & 15, cc = c & 31, ob = rr * 64 + cc * 2; return st * 1024 + (ob ^ (((ob >> 9) & 1) << 5)); }
__host__ __device__ __forceinline__ void stage_rc(int b, int& R, int& C) { const int st = b / 1024, sb = b % 1024, swz = sb ^ (((sb >> 9) & 1) << 5); R = (st >> 1) * 16 + swz / 64; C = (st & 1) * 32 + (swz % 64) / 2; }
__host__ __device__ __forceinline__ int perm32(int rho) { const int n = rho >> 4, i = rho & 15; return 8 * (i >> 2) + 4 * n + (i & 3); }

struct Unit { int pm, pn, hm; };
struct Gemm { const bf16_t* A; const bf16_t* Bt; int M, N, K; size_t slab;
    __device__ __forceinline__ const char* abase(int pm, size_t tstep) const { return slab ? (const char*)A + (size_t)pan_b(pm) * slab + (size_t)pan_p(pm) * tstep : (const char*)A + (size_t)pm * tstep; } };

struct StaticOrder {
    int nM, nN, nwg, G, c, xm, xg;
    __host__ __device__ void init(int M, int N, int G_, int c_) { nM = M / BM; nN = N / BM; nwg = nM * nN; G = G_; c = c_; xm = 0; xg = 0; }
    __host__ __device__ void init_x(int M, int N, int x, int lidx) { nM = M / BM == 72 ? 9 : 8; nN = N / BM; nwg = nM * nN; G = 32; c = lidx; xm = 1; xg = x; }
    __host__ __device__ bool next(int i, Unit& u) const {
        const long L0 = (long)i * G + c; const int nfull = (nwg / G) * G, rem = nwg - nfull; const bool halves = rem > 0 && 2 * rem <= G;
        long L = L0; u.hm = -1;
        if (halves && L0 >= nfull) { const long t = L0 - nfull; if (t >= 2 * rem) return false; L = nfull + (t >> 1); u.hm = (int)(t & 1); }
        if (L >= nwg) return false;
        if (xm) { const int p = (int)L % nM; u.pn = (int)L / nM; u.pm = p < 8 ? 8 * xg + p : 64 + xg; return true; }
        int wgid = (int)L; { const int q = nwg / NXCD, r = nwg % NXCD, xcd = wgid % NXCD, off = wgid / NXCD; wgid = (xcd < r ? xcd * (q + 1) : r * (q + 1) + (xcd - r) * q) + off; }
        const int nig = WGM * nN, gid = wgid / nig, fm = gid * WGM, gsz = (nM - fm) < WGM ? (nM - fm) : WGM;
        u.pm = fm + ((wgid % nig) % gsz); u.pn = (wgid % nig) / gsz; return true;
    }
    __device__ __forceinline__ void a_ready(const Unit&) const {}
    __device__ __forceinline__ void done(const Unit&) const {}
};

__device__ __forceinline__ unsigned cvt_pk_bf16(float lo, float hi) { unsigned r; asm volatile("v_cvt_pk_bf16_f32 %0, %1, %2" : "=v"(r) : "v"(lo), "v"(hi)); return r; }
typedef float f32x2 __attribute__((ext_vector_type(2)));
struct ListOrder {
    int pm0, nM, nN, nwg, G, r, nfull, noremap;
    __host__ __device__ void init(int pm0_, int nM_, int N, int G_, int c_, int rot, int halves_, int noremap_ = 0, int nfull_ = -1) { pm0 = pm0_; nM = nM_; nN = N / BM; nwg = nM * nN; G = G_; r = (c_ + rot) % G_;
        nfull = nfull_ >= 0 ? nfull_ : (halves_ ? 0 : nwg); noremap = noremap_; }
    __host__ __device__ bool next(int i, Unit& u) const {
        long L = (long)i * G + r; u.hm = -1;
        if (L >= nfull) { const long t = L - nfull; if (t >= 2 * (nwg - nfull)) return false; u.hm = (int)(t & 1); L = nfull + (t >> 1); }
        if (L >= nwg) return false;
        if (noremap) { u.pm = pm0 + (int)L % nM; u.pn = (int)L / nM; return true; }
        int wgid = (int)L; { const int q = nwg / NXCD, rr = nwg % NXCD, xcd = wgid % NXCD, off = wgid / NXCD; wgid = (xcd < rr ? xcd * (q + 1) : rr * (q + 1) + (xcd - rr) * q) + off; }
        const int nig = WGM * nN, gid = wgid / nig, fm = gid * WGM, gsz = (nM - fm) < WGM ? (nM - fm) : WGM;
        u.pm = pm0 + fm + ((wgid % nig) % gsz); u.pn = (wgid % nig) / gsz; return true;
    }
    __host__ __device__ bool any() const { return r < nfull + 2 * (nwg - nfull); }
    __device__ __forceinline__ void a_ready(const Unit&) const {}
    __device__ __forceinline__ void done(const Unit&) const {}
};

__device__ __forceinline__ float bperm_f(int src_lane, float v) { return __builtin_bit_cast(float, __builtin_amdgcn_ds_bpermute(src_lane << 2, __builtin_bit_cast(int, v))); }
__device__ __forceinline__ int mod_row(int pm) { return pm < 64 ? (pm >> 3) : 8; }
__device__ __forceinline__ float row_rstd(const float* ssq, int row) {
    const f32x4 s = *(const f32x4*)(ssq + (size_t)row * 4);
    return rsqrtf(((s[0] + s[1]) + (s[2] + s[3])) * (1.0f / 1024.0f) + 1e-6f);
}
__device__ __forceinline__ float fq_sum(float t) {
    { auto r = __builtin_amdgcn_permlane16_swap(__float_as_uint(t), __float_as_uint(t), false, false); t = __uint_as_float(r[0]) + __uint_as_float(r[1]); }
    { auto r = __builtin_amdgcn_permlane32_swap(__float_as_uint(t), __float_as_uint(t), false, false); t = __uint_as_float(r[0]) + __uint_as_float(r[1]); }
    return t;
}
__device__ __forceinline__ float row_rstd_q(const float* ssq, int row, int fq) {
    (void)fq; const f32x4 p = *(const f32x4*)(ssq + (size_t)row * 4);
    const float t = (p[0] + p[1]) + (p[2] + p[3]);
    return rsqrtf(t * (1.0f / 1024.0f) + 1e-6f);
}
__device__ __forceinline__ void st_bf16x4(bf16_t* p, f32x4 v) { typedef unsigned u32x2 __attribute__((ext_vector_type(2))); u32x2 w; w.x = cvt_pk_bf16(v[0], v[1]); w.y = cvt_pk_bf16(v[2], v[3]); *(u32x2*)p = w; }
__device__ __forceinline__ void st_bf16x8_pair(bf16_t* p, f32x4 v0, f32x4 v1, int fq) {
    unsigned a0 = cvt_pk_bf16(v0[0], v0[1]), a1 = cvt_pk_bf16(v0[2], v0[3]), b0 = cvt_pk_bf16(v1[0], v1[1]), b1 = cvt_pk_bf16(v1[2], v1[3]);
    auto rx = __builtin_amdgcn_permlane16_swap(a0, b0, false, false); auto ry = __builtin_amdgcn_permlane16_swap(a1, b1, false, false);
    typedef unsigned u32x4_ __attribute__((ext_vector_type(4))); u32x4_ w; w.x = rx[0]; w.y = ry[0]; w.z = rx[1]; w.w = ry[1];
    *(u32x4_*)(p + (fq & 1) * 16 + (fq >> 1) * 8) = w;
}
__device__ __forceinline__ void ld_bf16x8_pair(const bf16_t* p, int fq, f32x4& v0, f32x4& v1) {
    typedef unsigned u32x4_ __attribute__((ext_vector_type(4))); const u32x4_ w = *(const u32x4_*)(p + (fq & 1) * 16 + (fq >> 1) * 8);
    auto rx = __builtin_amdgcn_permlane16_swap(w.x, w.z, false, false); auto ry = __builtin_amdgcn_permlane16_swap(w.y, w.w, false, false);
    v0[0] = __builtin_bit_cast(float, rx[0] << 16); v0[1] = __builtin_bit_cast(float, rx[0] & 0xffff0000u); v0[2] = __builtin_bit_cast(float, ry[0] << 16); v0[3] = __builtin_bit_cast(float, ry[0] & 0xffff0000u);
    v1[0] = __builtin_bit_cast(float, rx[1] << 16); v1[1] = __builtin_bit_cast(float, rx[1] & 0xffff0000u); v1[2] = __builtin_bit_cast(float, ry[1] << 16); v1[3] = __builtin_bit_cast(float, ry[1] & 0xffff0000u);
}
__device__ __forceinline__ float gelu_tanh(float x) { const float z = 0.7978845608028654f * (x + 0.044715f * x * x * x); const float t = 1.0f - 2.0f * __builtin_amdgcn_rcpf(__builtin_amdgcn_exp2f(2.8853900817779268f * z) + 1.0f); return 0.5f * x * (1.0f + t); }

template <int KIND>
struct EpiProj {
    static constexpr bool PERM = false, AFTER_DRAIN = false;
    const float* ssq; const float* bias; int N;
    unsigned char* R; int nk;
    const float* qgain; const float* kgain; const float* cs;
    PG8_LAS const float* rsl = nullptr; int rpm = -1;
    PG8_LAS const float* tb = nullptr;
    __device__ __forceinline__ void operator()(const f32x4 (&acc)[2][2][4][2], const Unit& u, int wr, int wc, int fr, int fq) const {
        asm volatile("" : "+v"(fr), "+v"(fq));
        const int rm = mod_row(u.pm); const bool lat = u.pm < 64;
        const int g = 4 * u.pn + wc;
        const int tcol = u.pn * BM + wc * 32 + 4 * fq;
        unsigned char* Rb = R + (size_t)pan_b(u.pm) * SLAB; const int lr0 = (pan_p(u.pm) - u.pm) * BM;
        f32x4 bv[2][2];
#pragma unroll
        for (int bj = 0; bj < 2; ++bj)
#pragma unroll
            for (int n = 0; n < 2; ++n) bv[bj][n] = *(const f32x4*)(bias + (size_t)rm * N + tcol + bj * HALF + n * 16);
        if constexpr (KIND == 3) {
#pragma unroll
            for (int ai = 0; ai < 2; ++ai) { if (ai > 0 && u.hm >= 0) continue;
                asm volatile("" ::: "memory"); float rsv[4];
                if (rsl != nullptr && u.pm == rpm) {
#pragma unroll
                    for (int m_ = 0; m_ < 4; ++m_) rsv[m_] = rsl[(u.hm > 0 ? HALF : 0) + ai * HALF + wr * 64 + m_ * 16 + fr];
                } else {
                rsv[0] = row_rstd_q(ssq, u.pm * BM + (u.hm > 0 ? HALF : 0) + ai * HALF + wr * 64 + 0 * 16 + fr, fq); rsv[1] = row_rstd_q(ssq, u.pm * BM + (u.hm > 0 ? HALF : 0) + ai * HALF + wr * 64 + 1 * 16 + fr, fq); asm volatile("" ::: "memory"); rsv[2] = row_rstd_q(ssq, u.pm * BM + (u.hm > 0 ? HALF : 0) + ai * HALF + wr * 64 + 2 * 16 + fr, fq); rsv[3] = row_rstd_q(ssq, u.pm * BM + (u.hm > 0 ? HALF : 0) + ai * HALF + wr * 64 + 3 * 16 + fr, fq);
                }
#pragma unroll
                for (int m = 0; m < 4; ++m) { const int row = u.pm * BM + (u.hm > 0 ? HALF : 0) + ai * HALF + wr * 64 + m * 16 + fr; const float rs = rsv[m];
#pragma unroll
                    for (int bj = 0; bj < 2; ++bj) { f32x4 v2[2];
#pragma unroll
                        for (int n = 0; n < 2; ++n) { const f32x4 v = acc[ai][bj][m][n] * rs + bv[bj][n];
                            if (g < 16) v2[n] = v; else { v2[n][0] = gelu_tanh(v[0]); v2[n][1] = gelu_tanh(v[1]); v2[n][2] = gelu_tanh(v[2]); v2[n][3] = gelu_tanh(v[3]); } }
                        st_bf16x8_pair((g < 16 ? (bf16_t*)(Rb + SL_XR) + g * 64 : (bf16_t*)(Rb + SL_GL) + (g - 16) * 64) + (size_t)(row + lr0) * 1024 + 32 * bj, v2[0], v2[1], fq); } } }
        } else {
            const int slot = g < 16 ? 0 : (g < 16 + nk ? 1 : 2);
            bf16_t* dst; int ld;
            if (slot == 0) { dst = (bf16_t*)(Rb + SL_Q) + g * 64; ld = 1024; } else if (slot == 1) { dst = (bf16_t*)(Rb + SL_K) + (g - 16) * 64; ld = 64 * nk; } else { dst = (bf16_t*)(Rb + SL_V) + (g - 16 - nk) * 64; ld = 64 * nk; }
            const float* gp_ = slot == 0 ? qgain : kgain;
            const float osc = slot == 0 ? QSCALE : 1.0f;
#pragma unroll
            for (int ai = 0; ai < 2; ++ai) { if (ai > 0 && u.hm >= 0) continue;
                asm volatile("" ::: "memory"); float rsv[4];
                if (rsl != nullptr && u.pm == rpm) {
#pragma unroll
                    for (int m_ = 0; m_ < 4; ++m_) rsv[m_] = rsl[(u.hm > 0 ? HALF : 0) + ai * HALF + wr * 64 + m_ * 16 + fr];
                } else {
                rsv[0] = row_rstd_q(ssq, u.pm * BM + (u.hm > 0 ? HALF : 0) + ai * HALF + wr * 64 + 0 * 16 + fr, fq); rsv[1] = row_rstd_q(ssq, u.pm * BM + (u.hm > 0 ? HALF : 0) + ai * HALF + wr * 64 + 1 * 16 + fr, fq); asm volatile("" ::: "memory"); rsv[2] = row_rstd_q(ssq, u.pm * BM + (u.hm > 0 ? HALF : 0) + ai * HALF + wr * 64 + 2 * 16 + fr, fq); rsv[3] = row_rstd_q(ssq, u.pm * BM + (u.hm > 0 ? HALF : 0) + ai * HALF + wr * 64 + 3 * 16 + fr, fq);
                }
#pragma unroll
                for (int m = 0; m < 4; ++m) { const int row = u.pm * BM + (u.hm > 0 ? HALF : 0) + ai * HALF + wr * 64 + m * 16 + fr; const float rs = rsv[m];
                    f32x4 v[2][2];
#pragma unroll
                    for (int bj = 0; bj < 2; ++bj)
#pragma unroll
                        for (int n = 0; n < 2; ++n) v[bj][n] = acc[ai][bj][m][n] * rs + bv[bj][n];
                    if constexpr (KIND == 1) { if (slot != 2) {
                        float s = 0.f;
#pragma unroll
                        for (int bj = 0; bj < 2; ++bj)
#pragma unroll
                            for (int n = 0; n < 2; ++n) { const f32x4 x = v[bj][n]; s += (x[0] * x[0] + x[1] * x[1]) + (x[2] * x[2] + x[3] * x[3]); }
                        s = fq_sum(s);
                        const float r = rsqrtf(s * (1.0f / 64.0f) + 1e-6f);
#pragma unroll
                        for (int bj = 0; bj < 2; ++bj)
#pragma unroll
                            for (int n = 0; n < 2; ++n) v[bj][n] = v[bj][n] * r * (*(const PG8_LAS f32x4*)(tb + (slot == 0 ? 2048 : 2112) + 32 * bj + 16 * n + 4 * fq)); } }
                    if constexpr (KIND == 1 || KIND == 2) { if (slot != 2 && lat) {
                        const int t = row & 2047;
#pragma unroll
                        for (int bj = 0; bj < 2; ++bj) { const int pos = bj == 0 ? (t >> 6) : (t & 63);
                            const f32x4 c01 = *(const PG8_LAS f32x4*)(tb + (pos * 16 + 4 * fq) * 2), c23 = *(const PG8_LAS f32x4*)(tb + (pos * 16 + 4 * fq) * 2 + 4);
                            const f32x4 co = {c01[0], c01[2], c23[0], c23[2]}, si = {c01[1], c01[3], c23[1], c23[3]};
                            const f32x4 x1 = v[bj][0], x2 = v[bj][1];
                            v[bj][0] = x1 * co - x2 * si; v[bj][1] = x1 * si + x2 * co; } } }
#pragma unroll
                    for (int bj = 0; bj < 2; ++bj) {
                        if (slot == 1) {
                            const int lrow = row + lr0, chunk = 4 * bj + 2 * (fq & 1) + (fq >> 1);
                            bf16_t* kp = (bf16_t*)(Rb + SL_K) + ((size_t)(((g - 16) * 36 + (lrow >> 6)) * 8 + chunk) * 64 + (lrow & 63)) * 8 - ((fq & 1) * 16 + (fq >> 1) * 8);
                            st_bf16x8_pair(kp, v[bj][0] * osc, v[bj][1] * osc, fq);
                        } else st_bf16x8_pair(dst + (size_t)(row + lr0) * ld + 32 * bj, v[bj][0] * osc, v[bj][1] * osc, fq); } } }
        }
    }
};

struct EpiSwiGLU {
    static constexpr bool PERM = false, AFTER_DRAIN = false;
    const float* ssq; const float* bias; unsigned char* R;
    PG8_LAS const float* rsl = nullptr; int rpm = -1;
    __device__ __forceinline__ void operator()(const f32x4 (&acc)[2][2][4][2], const Unit& u, int wr, int wc, int fr, int fq) const {
        asm volatile("" : "+v"(fr), "+v"(fq));
        const int rm = mod_row(u.pm); const int tcol = u.pn * BM + wc * 32 + 4 * fq;
        f32x4 bv[2][2];
#pragma unroll
        for (int bj = 0; bj < 2; ++bj)
#pragma unroll
            for (int n = 0; n < 2; ++n) bv[bj][n] = *(const f32x4*)(bias + (size_t)rm * (2 * FF) + tcol + bj * HALF + n * 16);
#pragma unroll
        for (int ai = 0; ai < 2; ++ai) { if (ai > 0 && u.hm >= 0) continue;
            asm volatile("" ::: "memory"); float rsv[4];
            if (rsl != nullptr && u.pm == rpm) {
#pragma unroll
                for (int m = 0; m < 4; ++m) rsv[m] = rsl[(u.hm > 0 ? HALF : 0) + ai * HALF + wr * 64 + m * 16 + fr];
            } else {
#pragma unroll
            for (int m = 0; m < 4; ++m) rsv[m] = row_rstd_q(ssq, u.pm * BM + (u.hm > 0 ? HALF : 0) + ai * HALF + wr * 64 + m * 16 + fr, fq); }
#pragma unroll
            for (int m = 0; m < 4; ++m) { const int row = u.pm * BM + (u.hm > 0 ? HALF : 0) + ai * HALF + wr * 64 + m * 16 + fr; const float rs = rsv[m];
                f32x4 o2[2];
#pragma unroll
                for (int n = 0; n < 2; ++n) { const f32x4 a = acc[ai][0][m][n] * rs + bv[0][n], gg = acc[ai][1][m][n] * rs + bv[1][n];
#pragma unroll
                    for (int e = 0; e < 4; ++e) o2[n][e] = a[e] * __builtin_amdgcn_rcpf(1.0f + __builtin_amdgcn_exp2f(-1.4426950408889634f * a[e])) * gg[e]; }
                st_bf16x8_pair((bf16_t*)(R + (size_t)pan_b(u.pm) * SLAB + SL_HM) + (size_t)(row + (pan_p(u.pm) - u.pm) * BM) * FF + u.pn * 128 + wc * 32, o2[0], o2[1], fq); } }
    }
};

template <bool F32IN>
struct EpiResid {
    static constexpr bool PERM = false, AFTER_DRAIN = false;
    bf16_t* Hl; bf16_t* Hc; const float* gate; const float* nsc; const float* ng; bf16_t* XS; float* ssq;
    const float* Rl = nullptr; const float* Rc = nullptr;
    PG8_LAS float* ssl = nullptr;
    __device__ __forceinline__ void operator()(const f32x4 (&acc)[2][2][4][2], const Unit& u, int wr, int wc, int fr, int fq) const {
        asm volatile("" : "+v"(fr), "+v"(fq));
        const int rm = mod_row(u.pm);
        bf16_t* Hb = u.pm < 64 ? Hl + (size_t)u.pm * BM * 1024 : Hc + (size_t)(u.pm - 64) * BM * 1024;
        const float* Rb = F32IN ? (u.pm < 64 ? Rl + (size_t)u.pm * BM * 1024 : Rc + (size_t)(u.pm - 64) * BM * 1024) : nullptr;
        const int col0 = u.pn * BM + wc * 32 + 4 * fq; const int cst = u.pn * BM + wc * 32;
        f32x4 gt[2][2], gs[2][2];
#pragma unroll
        for (int bj = 0; bj < 2; ++bj)
#pragma unroll
            for (int n = 0; n < 2; ++n) { const int col = col0 + bj * HALF + n * 16; gt[bj][n] = *(const f32x4*)(gate + (size_t)rm * 6144 + col);
                if (XS) gs[bj][n] = *(const f32x4*)(ng + col) * (*(const f32x4*)(nsc + (size_t)rm * 6144 + col) + 1.0f); else gs[bj][n] = (f32x4){0.f, 0.f, 0.f, 0.f}; }
#pragma unroll
        for (int ai = 0; ai < 2; ++ai) { if (ai > 0 && u.hm >= 0) continue;
#pragma unroll
          for (int mh = 0; mh < 2; ++mh) {
            asm volatile("" ::: "memory");
            const int rl0 = (u.hm > 0 ? HALF : 0) + ai * HALF + wr * 64 + mh * 32 + fr;
            f32x4 hv[2][2][2];
#pragma unroll
            for (int m = 0; m < 2; ++m)
#pragma unroll
                for (int bj = 0; bj < 2; ++bj) {
                    if constexpr (F32IN) {
#pragma unroll
                        for (int n = 0; n < 2; ++n) hv[m][bj][n] = __builtin_nontemporal_load((const f32x4*)(Rb + (size_t)(rl0 + m * 16) * 1024 + col0 + bj * HALF + n * 16));
                    } else ld_bf16x8_pair(Hb + (size_t)(rl0 + m * 16) * 1024 + cst + bj * HALF, fq, hv[m][bj][0], hv[m][bj][1]); }
            float ssv[2];
#pragma unroll
            for (int m = 0; m < 2; ++m) { const int rl = rl0 + m * 16; const int row = u.pm * BM + rl; float ss = 0.f;
#pragma unroll
                for (int bj = 0; bj < 2; ++bj) { f32x4 xo[2], ho[2];
#pragma unroll
                    for (int n = 0; n < 2; ++n) {
                        const f32x4 hn = hv[m][bj][n] + gt[bj][n] * acc[ai][bj][2 * mh + m][n]; ho[n] = hn;
                        ss += (hn[0] * hn[0] + hn[1] * hn[1]) + (hn[2] * hn[2] + hn[3] * hn[3]);
                        xo[n] = hn * gs[bj][n]; }
                    st_bf16x8_pair(Hb + (size_t)rl * 1024 + cst + bj * HALF, ho[0], ho[1], fq);
                    if (XS) st_bf16x8_pair(XS + (size_t)row * 1024 + cst + bj * HALF, xo[0], xo[1], fq); }
                ssv[m] = fq_sum(ss); }
            if (fq == 0) {
#pragma unroll
                for (int m = 0; m < 2; ++m) ssl[(wr * 4 + wc) * 128 + ai * 64 + mh * 32 + m * 16 + fr] = ssv[m]; } } }
        asm volatile("s_waitcnt lgkmcnt(0)" ::: "memory"); __builtin_amdgcn_s_barrier(); asm volatile("" ::: "memory");
        if (wc == 0) { const int lane_ = fq * 16 + fr;
#pragma unroll
            for (int t = 0; t < 2; ++t) { const int rr = lane_ + 64 * t;
                if (t == 0 || u.hm < 0) { const float tot = (ssl[(wr * 4 + 0) * 128 + rr] + ssl[(wr * 4 + 1) * 128 + rr]) + (ssl[(wr * 4 + 2) * 128 + rr] + ssl[(wr * 4 + 3) * 128 + rr]);
                    const int rl = (u.hm > 0 ? HALF : 0) + (rr >> 6) * HALF + wr * 64 + (rr & 63);
                    ssq[(size_t)(u.pm * BM + rl) * 4 + u.pn] = tot; } } }
    }
};

struct EpiResidFinal {
    static constexpr bool PERM = false, AFTER_DRAIN = true;
    const bf16_t* H; float* out; const float* gate; const float* gfin; float* ssqx; unsigned* cnt;
    __device__ __forceinline__ void fused(f32x4 (&acc)[2][2][4][2], const Unit& u, int wr, int wc, int fr, int fq, PG8_LAS unsigned char* lds, int wid, int lane) const {
        asm volatile("" : "+v"(fr), "+v"(fq));
        const int rm = mod_row(u.pm); const bf16_t* Hb = H + (size_t)u.pm * BM * 1024; const int col0 = u.pn * BM + wc * 32 + 4 * fq; const int cst = u.pn * BM + wc * 32;
        f32x4 gt[2][2];
#pragma unroll
        for (int bj = 0; bj < 2; ++bj)
#pragma unroll
            for (int n = 0; n < 2; ++n) gt[bj][n] = *(const f32x4*)(gate + (size_t)rm * 6144 + col0 + bj * HALF + n * 16);
#pragma unroll
        for (int ai = 0; ai < 2; ++ai)
#pragma unroll
            for (int mh = 0; mh < 2; ++mh) { asm volatile("" ::: "memory");
                const int rl0 = ai * HALF + wr * 64 + mh * 32 + fr; f32x4 hv[2][2][2];
#pragma unroll
                for (int m = 0; m < 2; ++m)
#pragma unroll
                    for (int bj = 0; bj < 2; ++bj) ld_bf16x8_pair(Hb + (size_t)(rl0 + m * 16) * 1024 + cst + bj * HALF, fq, hv[m][bj][0], hv[m][bj][1]);
#pragma unroll
                for (int m = 0; m < 2; ++m) { float ss = 0.f;
#pragma unroll
                    for (int bj = 0; bj < 2; ++bj)
#pragma unroll
                        for (int n = 0; n < 2; ++n) { const f32x4 hn = hv[m][bj][n] + gt[bj][n] * acc[ai][bj][2 * mh + m][n]; acc[ai][bj][2 * mh + m][n] = hn;
                            ss += (hn[0] * hn[0] + hn[1] * hn[1]) + (hn[2] * hn[2] + hn[3] * hn[3]); }
                    ss = fq_sum(ss);
                    if (fq == 0) __hip_atomic_store(ssqx + (size_t)(u.pm * BM + rl0 + m * 16) * 16 + 4 * u.pn + wc, ss, __ATOMIC_RELAXED, __HIP_MEMORY_SCOPE_AGENT); } }
        asm volatile("s_waitcnt vmcnt(0)" ::: "memory");
        if (lane == 0) __hip_atomic_fetch_add(cnt + 64 * u.pm, 1u, __ATOMIC_RELAXED, __HIP_MEMORY_SCOPE_AGENT);
        if (wid == 0) { unsigned sp = 0;
            while ((unsigned)__builtin_amdgcn_readfirstlane(__hip_atomic_load(cnt + 64 * u.pm, __ATOMIC_RELAXED, __HIP_MEMORY_SCOPE_AGENT)) < 32u) { __builtin_amdgcn_s_sleep(2); if (++sp > (1u << 21)) break; }
            __builtin_amdgcn_fence(__ATOMIC_ACQUIRE, "agent"); asm volatile("s_waitcnt vmcnt(0)" ::: "memory"); }
        asm volatile("s_waitcnt lgkmcnt(0)" ::: "memory"); __builtin_amdgcn_s_barrier(); asm volatile("" ::: "memory");
        f32x4 gf[2][2];
#pragma unroll
        for (int bj = 0; bj < 2; ++bj)
#pragma unroll
            for (int n = 0; n < 2; ++n) gf[bj][n] = *(const f32x4*)(gfin + col0 + bj * HALF + n * 16);
#pragma unroll
        for (int ai = 0; ai < 2; ++ai) { asm volatile("" ::: "memory"); float rsv[4];
#pragma unroll
            for (int m = 0; m < 4; ++m) { const unsigned long long* sp8 = (const unsigned long long*)(ssqx + (size_t)(u.pm * BM + ai * HALF + wr * 64 + m * 16 + fr) * 16); float t = 0.f;
#pragma unroll
                for (int q = 0; q < 8; ++q) { const unsigned long long w = __hip_atomic_load(sp8 + q, __ATOMIC_RELAXED, __HIP_MEMORY_SCOPE_AGENT); t += __uint_as_float((unsigned)w) + __uint_as_float((unsigned)(w >> 32)); }
                rsv[m] = rsqrtf(t * (1.0f / 1024.0f) + 1e-6f); }
#pragma unroll
            for (int m = 0; m < 4; ++m) { const int row = u.pm * BM + ai * HALF + wr * 64 + m * 16 + fr;
#pragma unroll
                for (int bj = 0; bj < 2; ++bj)
#pragma unroll
                    for (int n = 0; n < 2; ++n) __builtin_nontemporal_store(acc[ai][bj][m][n] * rsv[m] * gf[bj][n], (f32x4*)(out + (size_t)row * 1024 + col0 + bj * HALF + n * 16)); } }
    }
    __device__ __forceinline__ void operator()(const f32x4 (&)[2][2][4][2], const Unit&, int, int, int, int) const {}
};

template <class Epi, class Sched, bool ALIGN_EPI = false, bool SP2 = false>
__device__ __forceinline__ void gemm_phase(PG8_LAS unsigned char* lds, const Gemm g, const Sched& S, const Epi& E, const int wave0) {
    const int tid = fresh_tid(wave0), wid = __builtin_amdgcn_readfirstlane(tid >> 6), lane = tid & 63, wr = wid >> 2, wc = wid & 3, fr = lane & 15, fq = lane >> 4;
    const int K = g.K, nt = K / BK;
    unsigned voffA[2], voffB[2];
#pragma unroll
    for (int i = 0; i < 2; ++i) { int R, C; stage_rc(tid * 16 + i * 8192, R, C); const int Rb = Epi::PERM ? ((R & ~31) + perm32(R & 31)) : R;
        voffA[i] = (unsigned)(R * K + C) * 2u; voffB[i] = (unsigned)(Rb * K + C) * 2u; }
    const size_t kstep = (size_t)(BK * 2);
    const size_t hstep = (size_t)HALF * K * 2;
    const size_t tstep = 2 * hstep;
    const unsigned ldsw = (unsigned)wid * 1024u;
    const int aoff = lds_byte(wr * 64 + fr, fq * 8), boff = lds_byte(wc * 32 + fr, fq * 8);
#define PG8_SA(b, h) (((b) * 2 + (h)) * HTB)
#define PG8_SB(b, h) ((4 + (b) * 2 + (h)) * HTB)
#define PG8_STAGE(bufoff, gbase, voff) do { _Pragma("unroll") for (int _i = 0; _i < 2; ++_i) \
        __builtin_amdgcn_global_load_lds((const unsigned*)((const char*)(gbase) + (voff)[_i]), (PG8_LAS unsigned*)(lds + (bufoff) + ldsw + _i * 8192), 16, 0, 0); } while (0)
#define PG8_LDA(dst, b, h) do { _Pragma("unroll") for (int m = 0; m < 4; ++m) _Pragma("unroll") for (int k = 0; k < 2; ++k) dst[m][k] = *(const PG8_LAS bf16x8*)(lds + PG8_SA(b, h) + aoff + m * 2048 + k * 1024); } while (0)
#define PG8_LDB(dst, b, h) do { _Pragma("unroll") for (int n = 0; n < 2; ++n) _Pragma("unroll") for (int k = 0; k < 2; ++k) dst[n][k] = *(const PG8_LAS bf16x8*)(lds + PG8_SB(b, h) + boff + n * 2048 + k * 1024); } while (0)
#define PG8_MMA(ai, bj, At, Bt) do { __builtin_amdgcn_s_setprio(1); _Pragma("unroll") for (int m = 0; m < 4; ++m) _Pragma("unroll") for (int n = 0; n < 2; ++n) _Pragma("unroll") for (int k = 0; k < 2; ++k) \
        acc[ai][bj][m][n] = __builtin_amdgcn_mfma_f32_16x16x32_bf16(Bt[n][k], At[m][k], acc[ai][bj][m][n], 0, 0, 0); __builtin_amdgcn_s_setprio(0); } while (0)
#define PG8_WAIT_V(n) asm volatile("s_waitcnt vmcnt(" #n ")" ::: "memory")
#define PG8_WAIT_L(n) asm volatile("s_waitcnt lgkmcnt(" #n ")" ::: "memory")
#define PG8_BAR __builtin_amdgcn_s_barrier()
#define PG8_SCHED __builtin_amdgcn_sched_barrier(0)
    Unit cur, nxt; int ui = 0;
    if (!S.next(0, cur)) return;
    f32x4 acc[2][2][4][2];
#pragma unroll
    for (int a = 0; a < 2; ++a)
#pragma unroll
        for (int b = 0; b < 2; ++b)
#pragma unroll
            for (int m = 0; m < 4; ++m)
#pragma unroll
                for (int n = 0; n < 2; ++n) acc[a][b][m][n] = (f32x4){0.f, 0.f, 0.f, 0.f};
    bf16x8 At[4][2], B0[2][2], B1[2][2];
    static_assert(SP2, "half units are wired into the SP2 loop only");
    const char* cA = g.abase(cur.pm, tstep) + (cur.hm > 0 ? hstep : 0); const char* cB = (const char*)g.Bt + (size_t)cur.pn * tstep;
    size_t cAh = cur.hm >= 0 ? 0 : hstep;
    S.a_ready(cur);
    if constexpr (SP2) {
        PG8_STAGE(PG8_SB(0, 0), cB, voffB); PG8_STAGE(PG8_SB(0, 1), cB + hstep, voffB); PG8_STAGE(PG8_SA(0, 0), cA, voffA); PG8_STAGE(PG8_SA(0, 1), cA + cAh, voffA);
        if (wr == 1) PG8_BAR;
        PG8_WAIT_V(2); PG8_BAR;
        PG8_STAGE(PG8_SB(1, 0), cB + kstep, voffB); PG8_STAGE(PG8_SA(1, 0), cA + kstep, voffA); PG8_STAGE(PG8_SB(1, 1), cB + hstep + kstep, voffB);
        PG8_WAIT_V(6); PG8_BAR;
    } else {
        PG8_STAGE(PG8_SB(0, 0), cB, voffB); PG8_STAGE(PG8_SA(0, 0), cA, voffA); PG8_STAGE(PG8_SB(0, 1), cB + hstep, voffB); PG8_STAGE(PG8_SA(0, 1), cA + hstep, voffA);
        if (wr == 1) PG8_BAR;
        PG8_WAIT_V(4); PG8_BAR;
        PG8_STAGE(PG8_SB(1, 0), cB + kstep, voffB); PG8_STAGE(PG8_SA(1, 0), cA + kstep, voffA); PG8_STAGE(PG8_SB(1, 1), cB + hstep + kstep, voffB);
        PG8_WAIT_V(6); PG8_BAR;
    }
    for (;;) {
        const bool has_next = S.next(ui + 1, nxt);
        const char* nA = has_next ? g.abase(nxt.pm, tstep) + (nxt.hm > 0 ? hstep : 0) : cA; const char* nB = has_next ? (const char*)g.Bt + (size_t)nxt.pn * tstep : cB;
        const size_t nAh = has_next ? (nxt.hm >= 0 ? 0 : hstep) : cAh; const bool cfull = cur.hm < 0;
        for (int t = 0; t < nt; t += 2) {
            const bool last = (t == nt - 2);
            int tq = t; asm volatile("" : "+s"(tq));
            const char* a1 = cA + (size_t)(tq + 1) * kstep;
            const char* a2 = last ? nA : cA + (size_t)(tq + 2) * kstep; const char* b2 = last ? nB : cB + (size_t)(tq + 2) * kstep;
            const char* a3 = a2 + kstep; const char* b3 = b2 + kstep;
            const size_t a2h = last ? nAh : cAh;
            if (last && has_next) S.a_ready(nxt);
            if constexpr (SP2) {
            PG8_LDB(B0, 0, 0); PG8_LDB(B1, 0, 1); PG8_SCHED; PG8_LDA(At, 0, 0); PG8_STAGE(PG8_SA(1, 1), a1 + cAh, voffA);
            PG8_WAIT_V(8); PG8_WAIT_L(0); PG8_BAR; PG8_MMA(0, 0, At, B0); PG8_MMA(0, 1, At, B1); PG8_BAR; PG8_SCHED;
            if (cfull) PG8_LDA(At, 0, 1); PG8_STAGE(PG8_SB(0, 0), b2, voffB); PG8_STAGE(PG8_SB(0, 1), b2 + hstep, voffB); PG8_STAGE(PG8_SA(0, 0), a2, voffA);
            PG8_WAIT_V(8); PG8_WAIT_L(0); PG8_BAR; if (cfull) { PG8_MMA(1, 0, At, B0); PG8_MMA(1, 1, At, B1); } PG8_BAR; PG8_SCHED;
            PG8_LDB(B0, 1, 0); PG8_LDB(B1, 1, 1); PG8_SCHED; PG8_LDA(At, 1, 0); PG8_STAGE(PG8_SA(0, 1), a2 + a2h, voffA);
            PG8_WAIT_V(8); PG8_WAIT_L(0); PG8_BAR; PG8_MMA(0, 0, At, B0); PG8_MMA(0, 1, At, B1); PG8_BAR; PG8_SCHED;
            if (cfull) PG8_LDA(At, 1, 1); PG8_STAGE(PG8_SB(1, 0), b3, voffB); PG8_STAGE(PG8_SB(1, 1), b3 + hstep, voffB); PG8_STAGE(PG8_SA(1, 0), a3, voffA);
            PG8_WAIT_V(8); PG8_WAIT_L(0); PG8_BAR; if (cfull) { PG8_MMA(1, 0, At, B0); PG8_MMA(1, 1, At, B1); } PG8_BAR; PG8_SCHED;
            } else {
            PG8_LDB(B0, 0, 0); PG8_SCHED; PG8_LDA(At, 0, 0); PG8_STAGE(PG8_SA(1, 1), a1 + hstep, voffA);
            PG8_WAIT_L(8); PG8_BAR; PG8_WAIT_L(0); PG8_MMA(0, 0, At, B0); PG8_BAR; PG8_SCHED;
            PG8_LDB(B1, 0, 1); PG8_STAGE(PG8_SB(0, 0), b2, voffB);
            PG8_BAR; PG8_WAIT_L(0); PG8_MMA(0, 1, At, B1); PG8_BAR;
            PG8_LDA(At, 0, 1); PG8_STAGE(PG8_SA(0, 0), a2, voffA);
            PG8_BAR; PG8_WAIT_L(0); PG8_MMA(1, 0, At, B0); PG8_BAR; PG8_SCHED;
            PG8_STAGE(PG8_SB(0, 1), b2 + hstep, voffB);
            PG8_WAIT_V(6); PG8_BAR; PG8_MMA(1, 1, At, B1); PG8_BAR;
            PG8_LDB(B0, 1, 0); PG8_SCHED; PG8_LDA(At, 1, 0); PG8_STAGE(PG8_SA(0, 1), a2 + hstep, voffA);
            PG8_WAIT_L(8); PG8_BAR; PG8_WAIT_L(0); PG8_MMA(0, 0, At, B0); PG8_BAR; PG8_SCHED;
            PG8_LDB(B1, 1, 1); PG8_STAGE(PG8_SB(1, 0), b3, voffB);
            PG8_BAR; PG8_WAIT_L(0); PG8_MMA(0, 1, At, B1); PG8_BAR;
            PG8_LDA(At, 1, 1); PG8_STAGE(PG8_SA(1, 0), a3, voffA);
            PG8_BAR; PG8_WAIT_L(0); PG8_MMA(1, 0, At, B0); PG8_BAR; PG8_SCHED;
            PG8_STAGE(PG8_SB(1, 1), b3 + hstep, voffB);
            PG8_WAIT_V(6); PG8_BAR; PG8_MMA(1, 1, At, B1); PG8_BAR;
            }
        }
        if constexpr (ALIGN_EPI) { if (wr == 0) PG8_BAR; }
        if constexpr (!Epi::AFTER_DRAIN) { E(acc, cur, wr, wc, fr, fq); S.done(cur); }
        if (!has_next) break;
#pragma unroll
        for (int a = 0; a < 2; ++a)
#pragma unroll
            for (int b = 0; b < 2; ++b)
#pragma unroll
                for (int m = 0; m < 4; ++m)
#pragma unroll
                    for (int n = 0; n < 2; ++n) acc[a][b][m][n] = (f32x4){0.f, 0.f, 0.f, 0.f};
        cur = nxt; cA = nA; cB = nB; cAh = nAh; ++ui;
        if constexpr (ALIGN_EPI) { if (wr == 1) PG8_BAR; }
    }
    PG8_WAIT_V(0);
    if constexpr (!ALIGN_EPI) { if (wr == 0) PG8_BAR; }
    PG8_BAR;
    if constexpr (Epi::AFTER_DRAIN) { E.fused(acc, cur, wr, wc, fr, fq, lds, wid, lane); S.done(cur); }
#undef PG8_SA
#undef PG8_SB
#undef PG8_STAGE
#undef PG8_LDA
#undef PG8_LDB
#undef PG8_MMA
#undef PG8_WAIT_V
#undef PG8_WAIT_L
#undef PG8_BAR
#undef PG8_SCHED
}
}
#define GAS __attribute__((address_space(1)))
#define LAS __attribute__((address_space(3)))
typedef unsigned short bf16;
typedef unsigned v4u __attribute__((ext_vector_type(4)));
typedef float f32x4 __attribute__((ext_vector_type(4)));
constexpr int NWAVES = 8;
constexpr bool MFMA_ATTN[3] = {true, true, true};
constexpr bool LRU_MFMA = true;
constexpr bool XCDMODE = true;
constexpr bool CHAIN = true;
constexpr int PROBE_DUP_PRO = 1;
constexpr int PROBE_DUP_ATT = 1;
constexpr int PROBE_DUP_P3 = 1, PROBE_DUP_P4 = 1, PROBE_DUP_P5 = 1;
constexpr int PROBE_DUP_ATTN_ONLY[3] = {1, 1, 1};
constexpr int LDS_BYTES = 147456;
constexpr size_t MiB = 1u << 20;
constexpr size_t WS_CTL = 0, CTL_ZERO_BYTES = 1 * MiB;
constexpr size_t WS_MOD = 1 * MiB;
constexpr size_t WS_CS = 2 * MiB;
constexpr size_t WS_BIAS = 3 * MiB;
constexpr size_t BIAS_SLOT = 9 * 5632;
constexpr size_t WS_SSQ = 5 * MiB;
constexpr size_t WS_HC = 8 * MiB;
constexpr size_t WS_WT = 16 * MiB;
constexpr size_t WS_XS = 106 * MiB;
constexpr size_t WS_R = 142 * MiB;
constexpr size_t R3 = 36 * MiB;
constexpr size_t WS_HF = 250 * MiB;
constexpr size_t WS_LRU = 314 * MiB;
constexpr size_t WS_END = 346 * MiB;
constexpr size_t WO_QKV0 = 0, WO_WO0 = WO_QKV0 + 3072 * 1024, WO_QKV1 = WO_WO0 + 1024 * 1024, WO_WO1 = WO_QKV1 + 1536 * 1024, WO_QKV2 = WO_WO1 + 1024 * 1024,
                 WO_WO2 = WO_QKV2 + 1280 * 1024, WO_WIN3 = WO_WO2 + 1024 * 1024, WO_WOUT3 = WO_WIN3 + 2048 * 1024, WO_FIN = WO_WOUT3 + 1024 * 1024,
                 WO_FOUT = WO_FIN + 4 * (size_t)5632 * 1024, WO_END = WO_FOUT + 4 * (size_t)1024 * 2816;
static_assert(WO_END * 2 <= 90 * MiB, "weight region");

struct Args { const float* in[30]; float* out; unsigned char* ws; };

struct Frame {
    LAS unsigned char* lds; int vcu, G, wave0; int xm, xg, lidx;
    float* out; unsigned char* ws;
    float* MOD; float* CS; float* BIAS; float* SSQ; bf16* HC; bf16* HL; bf16* WT; bf16* XS; unsigned char* R; float* HF;
};
#define PHASE_IDS() const int tid = fresh_tid(F.wave0), lane = tid & 63, wave = __builtin_amdgcn_readfirstlane(tid >> 6); (void)tid; (void)lane; (void)wave
#define LDS_WAIT() asm volatile("s_waitcnt lgkmcnt(0)" ::: "memory")
__device__ __forceinline__ unsigned f2bf(float f) { unsigned u = __builtin_bit_cast(unsigned, f); return (u + 0x7fffu + ((u >> 16) & 1u)) >> 16; }
__device__ __forceinline__ unsigned pk2(float lo, float hi) { return f2bf(lo) | (f2bf(hi) << 16); }
__device__ __forceinline__ float bf_lo(unsigned w) { return __builtin_bit_cast(float, w << 16); }
__device__ __forceinline__ float bf_hi(unsigned w) { return __builtin_bit_cast(float, w & 0xffff0000u); }
__device__ __forceinline__ float wave_sum(float v, int lane) {
#pragma unroll
    for (int o = 1; o < 64; o <<= 1) v += pg8::bperm_f(lane ^ o, v);
    return v;
}
__device__ __forceinline__ float silu_f(float x) { return x / (1.0f + __expf(-x)); }

__device__ __forceinline__ int perm_row32(int perm, int n0) {
    if (perm == 1) { const int t = n0 >> 8, w = n0 & 255; return (t << 8) + (((w >> 5) & 1) << 7) + (((w >> 6) & 3) << 5); }
    if (perm == 2) { const int half = n0 >= FF ? 1 : 0; const int i = half ? n0 - FF : n0; return ((i >> 7) << 8) + (half << 7) + (i & 127); }
    return n0;
}
__device__ __forceinline__ void p0_transpose_item(const float* W, int K, int N, bf16* WT, int perm, LAS float* scr, int item, int lane) {
    const int nblk = N / 32, kb = item / nblk, nb = item % nblk, k0 = 64 * kb, n0 = 32 * nb;
    const int orow = perm_row32(perm, n0);
    float wv[32];
#pragma unroll
    for (int i = 0; i < 32; ++i) wv[i] = W[(size_t)(k0 + 2 * i + (lane >> 5)) * N + n0 + (lane & 31)];
#pragma unroll
    for (int i = 0; i < 32; ++i) scr[(2 * i + (lane >> 5)) * 33 + (lane & 31)] = wv[i];
    LDS_WAIT(); asm volatile("" ::: "memory");
    const int c = lane & 7;
#pragma unroll
    for (int j = 0; j < 4; ++j) { const int n = (lane >> 3) + 8 * j; const LAS float* s = scr + (8 * c) * 33 + n;
        v4u o; o.x = pk2(s[0 * 33], s[1 * 33]); o.y = pk2(s[2 * 33], s[3 * 33]); o.z = pk2(s[4 * 33], s[5 * 33]); o.w = pk2(s[6 * 33], s[7 * 33]);
        *(GAS v4u*)(WT + (size_t)(orow + n) * K + k0 + 8 * c) = o; }
    LDS_WAIT(); asm volatile("" ::: "memory");
}
struct WDesc { const float* W; bf16* WT; int K, N, perm; };
__device__ __forceinline__ WDesc wdesc(const Frame& F, const Args& A_, int i) {
    WDesc d;
    switch (i) {
    case 0: d = {A_.in[11], F.WT + WO_QKV0, 1024, 3072, 1}; break;
    case 1: d = {A_.in[13], F.WT + WO_WO0, 1024, 1024, 0}; break;
    case 2: d = {A_.in[14], F.WT + WO_QKV1, 1024, 1536, 1}; break;
    case 3: d = {A_.in[17], F.WT + WO_WO1, 1024, 1024, 0}; break;
    case 4: d = {A_.in[18], F.WT + WO_QKV2, 1024, 1280, 1}; break;
    case 5: d = {A_.in[20], F.WT + WO_WO2, 1024, 1024, 0}; break;
    case 6: d = {A_.in[21], F.WT + WO_WIN3, 1024, 2048, 1}; break;
    case 7: d = {A_.in[29], F.WT + WO_WOUT3, 1024, 1024, 0}; break;
    case 8: case 9: case 10: case 11: d = {A_.in[9] + (size_t)(i - 8) * 1024 * 5632, F.WT + WO_FIN + (size_t)(i - 8) * 5632 * 1024, 1024, 5632, 2}; break;
    default: d = {A_.in[10] + (size_t)(i - 12) * 2816 * 1024, F.WT + WO_FOUT + (size_t)(i - 12) * 1024 * 2816, 2816, 1024, 0}; break;
    }
    return d;
}
__device__ __forceinline__ void p0a(Frame& F, const Args& A_) {
    PHASE_IDS();
    LAS float* sl = (LAS float*)F.lds;
    LAS float* red = (LAS float*)(F.lds + 40960);
#pragma unroll
    for (int j = 0; j < 5; ++j) { const int i4 = (tid + 512 * j) * 4;
        if (i4 < 9 * 1024) { const f32x4 v = i4 < 8192 ? *(const f32x4*)(A_.in[1] + i4) : *(const f32x4*)(A_.in[3] + (i4 - 8192));
            f32x4 o; o[0] = silu_f(v[0]); o[1] = silu_f(v[1]); o[2] = silu_f(v[2]); o[3] = silu_f(v[3]); *(LAS f32x4*)(sl + i4) = o; } }
    __syncthreads();
    for (int u = blockIdx.x; u < 4 * 64; u += F.G) {
        const int l = u >> 6, jb = u & 63; const int lc = lane < 48 ? lane : 47;
        const float* w = A_.in[4] + (size_t)l * 1024 * 6144 + jb * 96 + 2 * lc;
        float a0[9], a1[9];
#pragma unroll
        for (int r = 0; r < 9; ++r) { a0[r] = 0.f; a1[r] = 0.f; }
        const int kb = wave * 128;
#pragma unroll 16
        for (int k = 0; k < 128; ++k) { typedef float f32x2 __attribute__((ext_vector_type(2))); const f32x2 wv = __builtin_nontemporal_load((const f32x2*)(w + (size_t)(kb + k) * 6144));
#pragma unroll
            for (int r = 0; r < 9; ++r) { const float sv = sl[r * 1024 + kb + k]; a0[r] += sv * wv[0]; a1[r] += sv * wv[1]; } }
        if (lane < 48) {
#pragma unroll
            for (int r = 0; r < 9; ++r) { red[(wave * 9 + r) * 96 + 2 * lane] = a0[r]; red[(wave * 9 + r) * 96 + 2 * lane + 1] = a1[r]; } }
        __syncthreads();
        for (int i = tid; i < 9 * 96; i += 512) { const int r = i / 96, j = i % 96; float sm = 0.f;
#pragma unroll
            for (int wv = 0; wv < 8; ++wv) sm += red[(wv * 9 + r) * 96 + j];
            F.MOD[((size_t)l * 9 + r) * 6144 + jb * 96 + j] = sm + A_.in[5][(size_t)l * 6144 + jb * 96 + j]; }
        __syncthreads();
    }
    if (blockIdx.x < 16 && tid < 64) for (int i = blockIdx.x * 64 + tid; i < 64 * 16; i += 1024) { const int pos = i >> 4, j = i & 15; const float inv = 1.0f / powf(10000.0f, (float)(2 * j) / 32.0f); const float ang = (float)pos * inv;
        F.CS[2 * i] = cosf(ang); F.CS[2 * i + 1] = sinf(ang); }
    __syncthreads();
}
struct CItem { const float* src; bf16* dst; int N, K; };
__device__ __forceinline__ CItem citem(const Frame& F, const Args& A_, int gidx) {
    int i = 0, r = gidx;
#pragma unroll 1
    for (; i < 15; ++i) { const WDesc d = wdesc(F, A_, i); const int nit = (d.K / 64) * (d.N / 32); if (r < nit) break; r -= nit; }
    const WDesc d = wdesc(F, A_, i); const int nblk = d.N / 32, kb = r / nblk, nb = r % nblk, k0 = 64 * kb, n0 = 32 * nb;
    CItem c; c.src = d.W + (size_t)k0 * d.N + n0; c.dst = d.WT + (size_t)perm_row32(d.perm, n0) * d.K + k0; c.N = d.N; c.K = d.K; return c;
}
__device__ __forceinline__ void convert_all_weights(Frame& F, const Args& A_) {
    PHASE_IDS();
    LAS float* scr = (LAS float*)(F.lds + wave * 8704);
    constexpr int TOTAL = 1536 + 512 + 768 + 512 + 640 + 512 + 1024 + 512 + 4 * 2816 + 4 * 1408;
    const int gw = F.vcu * NWAVES + wave, NGW = F.G * NWAVES;
    if (gw >= TOTAL) return;
    CItem cur = citem(F, A_, gw);
    float wv[32];
#pragma unroll
    for (int i = 0; i < 32; ++i) wv[i] = __builtin_nontemporal_load(cur.src + (size_t)(2 * i + (lane >> 5)) * cur.N + (lane & 31));
#pragma unroll 1
    for (int g = gw; g < TOTAL; g += NGW) {
#pragma unroll
        for (int i = 0; i < 32; ++i) scr[(2 * i + (lane >> 5)) * 33 + (lane & 31)] = wv[i];
        const CItem me = cur;
        if (g + NGW < TOTAL) { cur = citem(F, A_, g + NGW);
#pragma unroll
            for (int i = 0; i < 32; ++i) wv[i] = __builtin_nontemporal_load(cur.src + (size_t)(2 * i + (lane >> 5)) * cur.N + (lane & 31)); }
        LDS_WAIT(); asm volatile("" ::: "memory");
        const int c = lane & 7;
#pragma unroll
        for (int j = 0; j < 4; ++j) { const int n = (lane >> 3) + 8 * j; const LAS float* sp = scr + (8 * c) * 33 + n;
            v4u o; o.x = pk2(sp[0 * 33], sp[1 * 33]); o.y = pk2(sp[2 * 33], sp[3 * 33]); o.z = pk2(sp[4 * 33], sp[5 * 33]); o.w = pk2(sp[6 * 33], sp[7 * 33]);
            *(GAS v4u*)(me.dst + (size_t)n * me.K + 8 * c) = o; }
        LDS_WAIT(); asm volatile("" ::: "memory");
    }
}

__device__ __forceinline__ void bias_layer(Frame& F, int l0, int l1, int rank, int count) {
    PHASE_IDS();
    typedef short bf16x8 __attribute__((ext_vector_type(8)));
    LAS unsigned short* shb = (LAS unsigned short*)F.lds;
    int ubase = 0;
#pragma unroll 1
    for (int gi = 2 * l0; gi < 2 * l1; ++gi) {
        const int layer = gi >> 1; const int g = (gi & 1) == 0 ? layer : 4 + layer, l = layer; const int N = g >= 4 ? 5632 : (g == 0 ? 3072 : g == 1 ? 1536 : g == 2 ? 1280 : 2048);
        const bf16* wt = F.WT + (g >= 4 ? WO_FIN + (size_t)l * 5632 * 1024 : (g == 0 ? WO_QKV0 : g == 1 ? WO_QKV1 : g == 2 ? WO_QKV2 : WO_WIN3));
        const int shoff = g >= 4 ? 3 * 1024 : 0; const int nun = N / 128;
        for (int uu = ubase + ((rank - ubase % count + count) % count); uu < ubase + nun; uu += count) {
            const int ch = uu - ubase;
            __syncthreads();
#pragma unroll
            for (int j = 0; j < 8; ++j) { const int i = tid + 512 * j; const int r = i >> 8, k4 = (i & 255) * 4; typedef unsigned u32x2_ __attribute__((ext_vector_type(2))); u32x2_ w = {0u, 0u};
                if (r < 9) { const f32x4 v = *(const f32x4*)(F.MOD + ((size_t)l * 9 + r) * 6144 + shoff + k4); w.x = pk2(v[0], v[1]); w.y = pk2(v[2], v[3]); }
                *(LAS u32x2_*)(shb + r * 1032 + k4) = w; }
            __syncthreads();
            const int n0 = ch * 128 + wave * 16; const bf16* wp = wt + (size_t)(n0 + (lane & 15)) * 1024 + 8 * (lane >> 4);
            f32x4 acc = {0.f, 0.f, 0.f, 0.f};
#pragma unroll 16
            for (int st = 0; st < 32; ++st) { const bf16x8 b = *(const bf16x8*)(wp + 32 * st); const bf16x8 a = *(const LAS bf16x8*)(shb + (lane & 15) * 1032 + 32 * st + 8 * (lane >> 4));
                acc = __builtin_amdgcn_mfma_f32_16x16x32_bf16(a, b, acc, 0, 0, 0); }
#pragma unroll
            for (int e = 0; e < 4; ++e) { const int r = 4 * (lane >> 4) + e; if (r < 9) F.BIAS[(size_t)g * BIAS_SLOT + (size_t)r * N + n0 + (lane & 15)] = acc[e]; }
        }
        ubase += nun;
    }
    __syncthreads();
}
__device__ __forceinline__ void p0b(Frame& F, const Args& A_) {
    bias_layer(F, 0, 4, (int)blockIdx.x, (int)F.G);
    PHASE_IDS();
    const int gw = F.vcu * NWAVES + wave, NGW = F.G * NWAVES;
    for (int row0 = gw; row0 < MT; row0 += 3 * NGW) {
        f32x4 v[3][4];
#pragma unroll
        for (int q = 0; q < 3; ++q) { const int row = row0 + q * NGW; if (row < MT) { const bool lat = row < ML; const float* src = lat ? A_.in[0] + (size_t)row * 1024 : A_.in[2] + (size_t)(row - ML) * 1024;
#pragma unroll
            for (int j = 0; j < 4; ++j) v[q][j] = *(const f32x4*)(src + 256 * j + 4 * lane); } }
#pragma unroll
        for (int q = 0; q < 3; ++q) { const int row = row0 + q * NGW; if (row < MT) { const bool lat = row < ML; const int rm = lat ? (row >> 11) : 8;
            const float* sc = F.MOD + (size_t)rm * 6144 + 1024; const float* ng = A_.in[6];
            float sq = 0.f;
#pragma unroll
            for (int j = 0; j < 4; ++j) { const int col = 256 * j + 4 * lane; const f32x4 x = v[q][j];
                sq += (x[0] * x[0] + x[1] * x[1]) + (x[2] * x[2] + x[3] * x[3]);
                const f32x4 o = x * (*(const f32x4*)(ng + col)) * (*(const f32x4*)(sc + col) + 1.0f);
                typedef unsigned u32x2 __attribute__((ext_vector_type(2))); u32x2 w; w.x = pk2(o[0], o[1]); w.y = pk2(o[2], o[3]); *(u32x2*)(F.XS + (size_t)row * 1024 + col) = w; }
            sq = wave_sum(sq, lane);
            if (lane < 4) F.SSQ[(size_t)row * 4 + lane] = lane == 0 ? sq : 0.f; } }
    }
}
__device__ __forceinline__ void p_final(Frame& F, const Args& A_) {
    PHASE_IDS();
    const int gw = F.vcu * NWAVES + wave, NGW = F.G * NWAVES;
    for (int row = gw; row < ML; row += NGW) {
        const float rs = pg8::row_rstd(F.SSQ, row); float* p = F.out + (size_t)row * 1024; const bf16* hp = F.HL + (size_t)row * 1024;
#pragma unroll
        for (int j = 0; j < 4; ++j) { const int col = 256 * j + 4 * lane; typedef unsigned u32x2_ __attribute__((ext_vector_type(2))); const u32x2_ w = *(const u32x2_*)(hp + col);
            const f32x4 hv = {bf_lo(w.x), __builtin_bit_cast(float, w.x & 0xffff0000u), bf_lo(w.y), __builtin_bit_cast(float, w.y & 0xffff0000u)};
            *(f32x4*)(p + col) = hv * rs * (*(const f32x4*)(A_.in[8] + col)); }
    }
}
namespace att {
typedef unsigned short bf16;
using bf16x8=__attribute__((ext_vector_type(8)))short;
using s16x4=__attribute__((ext_vector_type(4)))short;
using f32x16=__attribute__((ext_vector_type(16)))float;
using u32x4=__attribute__((ext_vector_type(4)))unsigned;
constexpr int D=64,NW=8,QBLK=32,QB=QBLK*NW,KVBLK=64,QP=1024;
__device__ __forceinline__ int crow(int r,int hi){return (r&3)+8*(r>>2)+4*hi;}
#define SBAR() __builtin_amdgcn_sched_barrier(0)
constexpr int NSLOT=3, SLOTB=8192;
constexpr int LDS_K=0, LDS_V=NSLOT*SLOTB, LDS_WS=2*NSLOT*SLOTB, LDS_OST=LDS_WS+NW*64*4, LDS_BYTES=LDS_OST+NW*4096;
constexpr int LDS_RPB=86016;
struct Job { const bf16* Q; bf16* O; const bf16* Kc; const bf16* Vc; const bf16* Kl; const bf16* Vl; int NT; int lat; int qpos0; int kt0; int h; int wave0; const float* aux; };

__device__ __forceinline__ void glds16(const void*gsrc,unsigned lds_dst){unsigned keep;
  asm volatile("s_mov_b32 %0, m0\n\ts_mov_b32 m0, %2\n\ts_nop 0\n\tglobal_load_lds_dwordx4 %1, off\n\ts_mov_b32 m0, %0":"=&s"(keep):"v"(gsrc),"s"(lds_dst):"memory");}
__device__ __forceinline__ void glds16s(const void*sbase,unsigned voff,unsigned lds_dst){unsigned keep;
  asm volatile("s_nop 4\n\ts_mov_b32 %0, m0\n\ts_mov_b32 m0, %3\n\ts_nop 0\n\tglobal_load_lds_dwordx4 %1, %2\n\ts_mov_b32 m0, %0":"=&s"(keep):"v"(voff),"s"(sbase),"s"(lds_dst):"memory");}
__device__ __forceinline__ float max3f(float a,float b,float c){float r;asm("v_max3_f32 %0, %1, %2, %3":"=v"(r):"v"(a),"v"(b),"v"(c));return r;}
__device__ __forceinline__ float max2f(float a,float b){float r;asm("v_max_f32_e32 %0, %1, %2":"=v"(r):"v"(a),"v"(b));return r;}
__device__ __forceinline__ float fadd_s(float a,float b){float r;asm("v_add_f32_e32 %0, %1, %2":"=v"(r):"v"(a),"v"(b));return r;}
__device__ __forceinline__ float fsub_s(float a,float b){float r;asm("v_sub_f32_e32 %0, %1, %2":"=v"(r):"v"(a),"v"(b));return r;}
typedef float f32x2_t __attribute__((ext_vector_type(2))); typedef __bf16 bf16x2_t __attribute__((ext_vector_type(2)));
__device__ __forceinline__ unsigned cvtpk_s(float lo,float hi){f32x2_t v={lo,hi};bf16x2_t b=__builtin_convertvector(v,bf16x2_t);return __builtin_bit_cast(unsigned,b);}
#define WAIT_BAR(N) asm volatile("s_waitcnt vmcnt(" #N ") lgkmcnt(0)\n\ts_barrier":::"memory")
__device__ __forceinline__ void qkt(f32x16&p0,f32x16&p1,const char*Kslot,const bf16x8*qr,const f32x16&negm,int r32,int hi){
  const char*kb=Kslot+hi*1024+r32*16;
  #pragma unroll
  for(int d0=0;d0<4;++d0){
    const bf16x8 b0=*reinterpret_cast<const bf16x8*>(kb+d0*2048);
    const bf16x8 b1=*reinterpret_cast<const bf16x8*>(kb+d0*2048+512);
    if(d0==0){p0=__builtin_amdgcn_mfma_f32_32x32x16_bf16(b0,qr[0],negm,0,0,0);p1=__builtin_amdgcn_mfma_f32_32x32x16_bf16(b1,qr[0],negm,0,0,0);}
    else{p0=__builtin_amdgcn_mfma_f32_32x32x16_bf16(b0,qr[d0],p0,0,0,0);p1=__builtin_amdgcn_mfma_f32_32x32x16_bf16(b1,qr[d0],p1,0,0,0);}}
}
typedef __attribute__((address_space(3))) const char* lds_cptr;
typedef short v4i16_t __attribute__((ext_vector_type(4)));
__device__ __forceinline__ void kload8(bf16x8*kf,lds_cptr kp){
  kf[0]=*(const __attribute__((address_space(3))) bf16x8*)(kp);      kf[1]=*(const __attribute__((address_space(3))) bf16x8*)(kp+512);
  kf[2]=*(const __attribute__((address_space(3))) bf16x8*)(kp+2048); kf[3]=*(const __attribute__((address_space(3))) bf16x8*)(kp+2560);
  kf[4]=*(const __attribute__((address_space(3))) bf16x8*)(kp+4096); kf[5]=*(const __attribute__((address_space(3))) bf16x8*)(kp+4608);
  kf[6]=*(const __attribute__((address_space(3))) bf16x8*)(kp+6144); kf[7]=*(const __attribute__((address_space(3))) bf16x8*)(kp+6656);
}
__device__ __forceinline__ void kload2(bf16x8*kf,lds_cptr kp,int j){ kf[2*j]=*(const __attribute__((address_space(3))) bf16x8*)(kp+j*2048); kf[2*j+1]=*(const __attribute__((address_space(3))) bf16x8*)(kp+j*2048+512); }
__device__ __forceinline__ s16x4 vtr(lds_cptr p){ return __builtin_bit_cast(s16x4,__builtin_amdgcn_ds_read_tr16_b64_v4i16((__attribute__((address_space(3))) v4i16_t*)p)); }
__device__ __forceinline__ float rowmax(const f32x16&p0,const f32x16&p1){
  float a=max3f(p0[0],p0[1],p1[0]),b=max3f(p0[2],p0[3],p1[1]);a=max3f(a,p1[2],p1[3]);
  #pragma unroll
  for(int r=4;r<16;r+=4){a=max3f(a,p0[r],p0[r+1]);b=max3f(b,p0[r+2],p0[r+3]);a=max3f(a,p1[r],p1[r+1]);b=max3f(b,p1[r+2],p1[r+3]);}
  const float m=max2f(a,b);
  auto rr=__builtin_amdgcn_permlane32_swap(__float_as_uint(m),__float_as_uint(m),false,false);
  return max2f(__uint_as_float(rr[0]),__uint_as_float(rr[1]));
}
__device__ __forceinline__ void pv(f32x16*o,int vb,bf16x8 pa0,bf16x8 pa1,bf16x8 pa2,bf16x8 pa3){
  #pragma unroll
  for(int d0=0;d0<2;++d0){s16x4 lo[4],hi[4];
    #pragma unroll
    for(int ks=0;ks<4;++ks){
      asm volatile("ds_read_b64_tr_b16 %0,%1 offset:%c2":"=&v"(lo[ks]):"v"(vb),"i"(d0*4096+ks*1024):"memory");
      asm volatile("ds_read_b64_tr_b16 %0,%1 offset:%c2":"=&v"(hi[ks]):"v"(vb),"i"(d0*4096+ks*1024+512):"memory");}
    asm volatile("s_waitcnt lgkmcnt(0)":::"memory");SBAR();
    #define PK(k) (bf16x8){lo[k][0],lo[k][1],lo[k][2],lo[k][3],hi[k][0],hi[k][1],hi[k][2],hi[k][3]}
    o[d0]=__builtin_amdgcn_mfma_f32_32x32x16_bf16(pa0,PK(0),o[d0],0,0,0);
    o[d0]=__builtin_amdgcn_mfma_f32_32x32x16_bf16(pa1,PK(1),o[d0],0,0,0);
    o[d0]=__builtin_amdgcn_mfma_f32_32x32x16_bf16(pa2,PK(2),o[d0],0,0,0);
    o[d0]=__builtin_amdgcn_mfma_f32_32x32x16_bf16(pa3,PK(3),o[d0],0,0,0);
    #undef PK
  }
}
typedef __attribute__((address_space(3))) const float* lds_fptr;
__device__ __forceinline__ bf16 f2bf_(float f){ unsigned u=__builtin_bit_cast(unsigned,f); return (bf16)((u+0x7fffu+((u>>16)&1u))>>16); }
struct MaskCtx { int kt0, v0, v1, v2, v3, v4; lds_fptr rp; };
template<int KIND> __device__ __forceinline__ void mask_setup(MaskCtx&mc,const Job&J,char*shm,int tid,int wid,int r32,int hi){
  mc.kt0=J.kt0; mc.v0=mc.v1=mc.v2=mc.v3=0; mc.v4=wid&1; mc.rp=(lds_fptr)(shm+LDS_RPB);
  if constexpr(KIND==0){
    if(J.lat&&tid<465) ((__attribute__((address_space(3))) float*)(shm+LDS_RPB))[tid]=J.aux[tid]*1.4426950408889634f;
    const int rq=(J.qpos0>>6)+(wid>>1), qc=(wid&1)*32+r32; int r0=rq-4; r0=r0<0?0:(r0>24?24:r0); int cs=qc-8; cs=cs<0?0:(cs>48?48:cs);
    mc.v0=rq; mc.v1=qc; mc.v2=r0; mc.v3=cs;
  } else if constexpr(KIND==2){ mc.v0=J.qpos0+wid*32+r32; mc.v1=J.qpos0+wid*32; }
}
template<int KIND> __device__ __forceinline__ void mask_tile(f32x16&p0,f32x16&p1,int t,const MaskCtx&mc,int hi){
  const float NEG=-INFINITY;
  if constexpr(KIND==0){
    if(t<4)return;
    const int kr=mc.kt0+(t-4);
    if(kr<mc.v2||kr>=mc.v2+8){
      _Pragma("unroll") for(int r=0;r<16;++r){p0[r]=NEG;p1[r]=NEG;} return; }
    const lds_fptr T=mc.rp+(kr-mc.v0+7)*31; const int ib=15-mc.v1+4*hi, wb=4*hi-mc.v3;
    _Pragma("unroll") for(int r=0;r<16;++r){ const int c=(r&3)+8*(r>>2);
      if(mc.v4==0||r>=12){ const bool ok=(unsigned)(wb+c)<16u; const float bv=T[ok?ib+c:0]; p0[r]=ok?p0[r]+bv:NEG; } else p0[r]=NEG;
      if(mc.v4!=0||r<4){ const bool ok=(unsigned)(wb+c+32)<16u; const float bv=T[ok?ib+c+32:0]; p1[r]=ok?p1[r]+bv:NEG; } else p1[r]=NEG; }
  } else if constexpr(KIND==2){
    if(t<4)return;
    const int k0=64*(mc.kt0+t-4), dk=k0-mc.v1;
    if(dk>=-96&&dk<=64)return;
    if(dk<=-192||dk>=160){ _Pragma("unroll") for(int r=0;r<16;++r){p0[r]=NEG;p1[r]=NEG;} return; }
    const int dq=k0+4*hi-mc.v0+128;
    _Pragma("unroll") for(int r=0;r<16;++r){ const int c=(r&3)+8*(r>>2); if((unsigned)(dq+c)>256u)p0[r]=NEG; if((unsigned)(dq+c+32)>256u)p1[r]=NEG; }
  }
}
template<int KIND> __device__ __forceinline__ bool tile_dead(int t,const MaskCtx&mc){
  if constexpr(KIND==0){ if(t<4)return false; const int kr=mc.kt0+(t-4); return kr<mc.v2||kr>=mc.v2+8; }
  else if constexpr(KIND==2){ if(t<4)return false; const int dk=64*(mc.kt0+t-4)-mc.v1; return dk<=-192||dk>=160; }
  else return false;
}
#ifndef ATTN_STORE16
#define ATTN_STORE16(p,v) (*(u32x4*)(p)=(v))
#endif
template<int KIND,int THRL> __device__ __forceinline__ void attn_unit(const Job&J,char*shm){
  constexpr int LDK=KIND==0?1024:KIND==1?256:128;
  const int tid=fresh_tid(J.wave0),lane=tid&63,r32=lane&31,hi=lane>>5; const int wid=__builtin_amdgcn_readfirstlane(tid>>6);
  const bf16*Qw=J.Q+(long)(wid*QBLK)*QP;
  const unsigned lds0=(unsigned)(uintptr_t)shm;
  float*wsf=(float*)(shm+LDS_WS)+wid*64;
  const unsigned kvo=(unsigned)(wid*512+lane*8)*2u, vvo=(unsigned)((16*(wid&3)+(lane>>2))*LDK+(wid>>2)*32+(lane&3)*8)*2u;
  const unsigned kdst=lds0+LDS_K+wid*1024, vdst=lds0+LDS_V+wid*1024;
  #define DMA_K(t,slot) glds16s(((t)<4?J.Kc+(long)(t)*4096:J.Kl+(long)((t)-4)*4096),kvo,(unsigned)__builtin_amdgcn_readfirstlane(kdst+(slot)))
  #define DMA_V(t,slot) glds16s(((t)<4?J.Vc+(long)(t)*KVBLK*LDK:J.Vl+(long)((t)-4)*KVBLK*LDK),vvo,(unsigned)__builtin_amdgcn_readfirstlane(vdst+(slot)))
  const int vb0=(int)(lds0+LDS_V)+((lane>>4)&1)*32+(lane&3)*8+(4*hi+((lane&15)>>2))*64;
  const char*Kbase=shm+LDS_K; bf16x8 kf[8];
  const lds_cptr shm3=(lds_cptr)shm; const lds_cptr kp0=shm3+LDS_K+hi*1024+r32*16; const lds_cptr vp0=shm3+LDS_V+((lane>>4)&1)*32+(lane&3)*8+(4*hi+((lane&15)>>2))*64;
  const int NT=J.NT;
  MaskCtx mc; mask_setup<KIND>(mc,J,shm,tid,wid,r32,hi);
  DMA_K(0,0);DMA_V(0,0);DMA_K(1,SLOTB);
  bf16x8 qr[4];
  #pragma unroll
  for(int d0=0;d0<4;++d0)qr[d0]=*reinterpret_cast<const bf16x8*>(&Qw[(long)r32*QP+d0*16+hi*8]);
  float mhat=0.f,l_reg=0.f;f32x16 o[2];o[0]=f32x16{};o[1]=f32x16{};f32x16 negm=f32x16{};asm volatile("":"+v"(negm));
  #define CMASK(P0,P1,t) mask_tile<KIND>(P0,P1,(t),mc,hi)
  bool resc=false;
  #define START(P0,P1) do{ const float rm=rowmax(P0,P1); resc=false; \
    { const float dl=rm; mhat=fadd_s(mhat,dl); \
      _Pragma("unroll") for(int r=0;r<16;++r){P0[r]=fsub_s(P0[r],dl);P1[r]=fsub_s(P1[r],dl);} \
      _Pragma("unroll") for(int r=0;r<16;++r)negm[r]=-mhat; asm volatile("":"+v"(negm)); } \
    _Pragma("unroll") for(int r=0;r<16;++r)P0[r]=__builtin_amdgcn_exp2f(P0[r]); }while(0)
  #define RESC() do{ if(resc){ asm volatile("s_waitcnt lgkmcnt(0)":::"memory"); \
      _Pragma("unroll") for(int d_=0;d_<2;++d_) _Pragma("unroll") for(int r=0;r<16;++r)o[d_][r]*=wsf[crow(r,hi)]; } }while(0)
  f32x16 pA0,pA1,pB0,pB1;
  int sl_prev=0,sl_cur=0,sl_next=SLOTB;
  #define ROT() do{sl_prev=sl_cur;sl_cur=sl_next;sl_next=(sl_next==(NSLOT-1)*SLOTB)?0:sl_next+SLOTB;}while(0)
  DMA_K(2,2*SLOTB);
  WAIT_BAR(3);
  qkt(pA0,pA1,Kbase,qr,negm,r32,hi);asm volatile("s_nop 15\n\ts_nop 7":"+v"(pA0),"+v"(pA1));
  START(pA0,pA1);
  _Pragma("unroll") for(int r=0;r<16;++r)pA1[r]=__builtin_amdgcn_exp2f(pA1[r]);
  WAIT_BAR(0);
  DMA_K(3,0);DMA_V(1,SLOTB);
  ROT();
  kload8(kf,kp0+sl_cur);
  WAIT_BAR(2);
  s16x4 vlo[8],vhi[8]; u32x4 pw0,pw1,pw2,pw3;
  #define PKW(P,B) cvtpk_s(P[B],P[B+1])
  #define PAF(k) __builtin_bit_cast(bf16x8,pw##k)
  #define VFR(i) (bf16x8){vlo[i][0],vlo[i][1],vlo[i][2],vlo[i][3],vhi[i][0],vhi[i][1],vhi[i][2],vhi[i][3]}
  #define PIN(x) asm volatile("":"+v"(x))
  #define MX3(a,b,c) __builtin_fmaxf(__builtin_fmaxf((a),(b)),(c))
  #define GAPA(MF,A0,A1,A2,A3,W0,W1,PW) do{ MF; sacc+=A0; sacc+=A1; sacc+=A2; sacc+=A3; PIN(sacc); W0; W1; PIN(PW); SBAR(); }while(0)
  #define EX(v) __builtin_amdgcn_exp2f(v)
  #define GAPB(MF,X,B) do{ MF; X[B]=EX(X[B]); X[B+1]=EX(X[B+1]); X[B+2]=EX(X[B+2]); X[B+3]=EX(X[B+3]); PIN(X); SBAR(); }while(0)
  #define VRD(i) do{ vlo[i]=vtr(vp_+(((i)>>2)*4096+((i)&3)*1024)); vhi[i]=vtr(vp_+(((i)>>2)*4096+((i)&3)*1024+512)); }while(0)
  #define KRD(G,j) do{ if(G){ kload2(kf,kp0+sl_next,j); SBAR(); } }while(0)
  #define STEP(C0,C1,P0,P1,t,GK,GV,GL) do{ SBAR(); \
    if(KIND!=1&&tile_dead<KIND>((t),mc)&&tile_dead<KIND>((t)-1,mc)){   \
      if(GK){DMA_K((t)+3,sl_cur);} if(GV){DMA_V((t)+1,sl_next);} KRD(GL,0); KRD(GL,1); KRD(GL,2); KRD(GL,3); \
      _Pragma("unroll") for(int r_=0;r_<16;++r_){C0[r_]=0.f;C1[r_]=0.f;} resc=false; SBAR(); } else { \
    const lds_cptr vp_=vp0+sl_prev; \
    VRD(0); SBAR(); float sacc=(P0[0]+P0[1]); \
    GAPA(C0=__builtin_amdgcn_mfma_f32_32x32x16_bf16(kf[0],qr[0],negm,0,0,0), P0[2],P0[3],P0[4],P0[5],     pw0[0]=PKW(P0,0), pw0[1]=PKW(P0,2), pw0); \
    VRD(4); SBAR(); GAPA(C1=__builtin_amdgcn_mfma_f32_32x32x16_bf16(kf[1],qr[0],negm,0,0,0), P0[6],P0[7],P0[8],P0[9],     pw0[2]=PKW(P0,4), pw0[3]=PKW(P0,6), pw0); \
    VRD(1); SBAR(); GAPA(C0=__builtin_amdgcn_mfma_f32_32x32x16_bf16(kf[2],qr[1],C0,0,0,0),   P0[10],P0[11],P0[12],P0[13], pw1[0]=PKW(P0,8), pw1[1]=PKW(P0,10), pw1); \
    VRD(5); SBAR(); GAPA(C1=__builtin_amdgcn_mfma_f32_32x32x16_bf16(kf[3],qr[1],C1,0,0,0),   P0[14],P0[15],P1[0],P1[1],   pw1[2]=PKW(P0,12),pw1[3]=PKW(P0,14), pw1); \
    VRD(2); SBAR(); GAPA(C0=__builtin_amdgcn_mfma_f32_32x32x16_bf16(kf[4],qr[2],C0,0,0,0),   P1[2],P1[3],P1[4],P1[5],     pw2[0]=PKW(P1,0), pw2[1]=PKW(P1,2), pw2); \
    VRD(6); SBAR(); GAPA(C1=__builtin_amdgcn_mfma_f32_32x32x16_bf16(kf[5],qr[2],C1,0,0,0),   P1[6],P1[7],P1[8],P1[9],     pw2[2]=PKW(P1,4), pw2[3]=PKW(P1,6), pw2); \
    VRD(3); SBAR(); GAPA(C0=__builtin_amdgcn_mfma_f32_32x32x16_bf16(kf[6],qr[3],C0,0,0,0),   P1[10],P1[11],P1[12],P1[13], pw3[0]=PKW(P1,8), pw3[1]=PKW(P1,10), pw3); \
    VRD(7); SBAR(); GAPA(C1=__builtin_amdgcn_mfma_f32_32x32x16_bf16(kf[7],qr[3],C1,0,0,0),   P1[14],P1[15],0.f,0.f,       pw3[2]=PKW(P1,12),pw3[3]=PKW(P1,14), pw3); \
    l_reg+=sacc; \
    if(GK){DMA_K((t)+3,sl_cur);} if(GV){DMA_V((t)+1,sl_next);} \
    CMASK(C0,C1,t); \
    { float a=MX3(C0[0],C0[1],C1[0]),b=MX3(C0[2],C0[3],C1[1]); a=MX3(a,C1[2],C1[3]); \
      _Pragma("unroll") for(int r=4;r<16;r+=4){a=MX3(a,C0[r],C0[r+1]);b=MX3(b,C0[r+2],C0[r+3]);a=MX3(a,C1[r],C1[r+1]);b=MX3(b,C1[r+2],C1[r+3]);} \
      float rm=__builtin_fmaxf(a,b); { auto rr=__builtin_amdgcn_permlane32_swap(__float_as_uint(rm),__float_as_uint(rm),false,false); rm=__builtin_fmaxf(__uint_as_float(rr[0]),__uint_as_float(rr[1])); } \
      resc=false; \
      if(__builtin_expect(__any(rm>(float)THRL),0)){ const float dl=__builtin_fmaxf(rm,0.f); mhat+=dl; \
        _Pragma("unroll") for(int r=0;r<16;++r){C0[r]-=dl;C1[r]-=dl;} \
        _Pragma("unroll") for(int r=0;r<16;++r)negm[r]=-mhat; asm volatile("":"+v"(negm)); \
        const float f=__builtin_amdgcn_exp2f(-dl); l_reg*=f; if(hi==0)wsf[r32]=f; resc=true; } } \
    SBAR(); \
    GAPB(o[0]=__builtin_amdgcn_mfma_f32_32x32x16_bf16(PAF(0),VFR(0),o[0],0,0,0), C0,0); \
    GAPB(o[1]=__builtin_amdgcn_mfma_f32_32x32x16_bf16(PAF(0),VFR(4),o[1],0,0,0), C0,4); \
    KRD(GL,0); GAPB(o[0]=__builtin_amdgcn_mfma_f32_32x32x16_bf16(PAF(1),VFR(1),o[0],0,0,0), C0,8); \
    KRD(GL,1); GAPB(o[1]=__builtin_amdgcn_mfma_f32_32x32x16_bf16(PAF(1),VFR(5),o[1],0,0,0), C0,12); \
    KRD(GL,2); GAPB(o[0]=__builtin_amdgcn_mfma_f32_32x32x16_bf16(PAF(2),VFR(2),o[0],0,0,0), C1,0); \
    KRD(GL,3); GAPB(o[1]=__builtin_amdgcn_mfma_f32_32x32x16_bf16(PAF(2),VFR(6),o[1],0,0,0), C1,4); \
    GAPB(o[0]=__builtin_amdgcn_mfma_f32_32x32x16_bf16(PAF(3),VFR(3),o[0],0,0,0), C1,8); \
    GAPB(o[1]=__builtin_amdgcn_mfma_f32_32x32x16_bf16(PAF(3),VFR(7),o[1],0,0,0), C1,12); \
    } }while(0)
  int t=1;
  #undef CMASK
  #define CMASK(P0,P1,t) do{}while(0)
  if constexpr(KIND==1) for(;t+5<NT;t+=2){
    STEP(pB0,pB1,pA0,pA1,t,true,true,true);     WAIT_BAR(2); RESC(); ROT();
    STEP(pA0,pA1,pB0,pB1,t+1,true,true,true);   WAIT_BAR(2); RESC(); ROT();
  }
  #undef CMASK
  #define CMASK(P0,P1,t) mask_tile<KIND>(P0,P1,(t),mc,hi)
  #define ENDW(tt) do{ if((tt)+3<NT){WAIT_BAR(2);} else if((tt)+2<NT){WAIT_BAR(1);} else {WAIT_BAR(0);} }while(0)
  for(;t+1<NT;t+=2){
    STEP(pB0,pB1,pA0,pA1,t,(t+3<NT),(t+1<NT),(t+1<NT));       ENDW(t);   RESC(); ROT();
    STEP(pA0,pA1,pB0,pB1,t+1,(t+4<NT),(t+2<NT),(t+2<NT));     ENDW(t+1); RESC(); ROT();
  }
  STEP(pB0,pB1,pA0,pA1,NT-1,false,false,false); RESC();
  { float sacc=pB0[0]+pB0[1]; _Pragma("unroll") for(int r=2;r<16;++r)sacc+=pB0[r]; _Pragma("unroll") for(int r=0;r<16;++r)sacc+=pB1[r]; l_reg+=sacc;
    pw0=(u32x4){PKW(pB0,0),PKW(pB0,2),PKW(pB0,4),PKW(pB0,6)};pw1=(u32x4){PKW(pB0,8),PKW(pB0,10),PKW(pB0,12),PKW(pB0,14)};pw2=(u32x4){PKW(pB1,0),PKW(pB1,2),PKW(pB1,4),PKW(pB1,6)};pw3=(u32x4){PKW(pB1,8),PKW(pB1,10),PKW(pB1,12),PKW(pB1,14)};
    SBAR(); pv(o,vb0+sl_cur,PAF(0),PAF(1),PAF(2),PAF(3)); }
  #undef PKW
  #undef PAF
  #undef VFR
  #undef PIN
  #undef MX3
  #undef GAPA
  #undef GAPB
  #undef EX
  #undef VRD
  #undef KRD
  #undef STEP
  #undef ENDW
  {auto rr=__builtin_amdgcn_permlane32_swap(__float_as_uint(l_reg),__float_as_uint(l_reg),false,false);l_reg=__uint_as_float(rr[0])+__uint_as_float(rr[1]);}
  if constexpr(KIND==2) l_reg+=__builtin_amdgcn_exp2f(J.aux[0]*1.4426950408889634f-mhat);
  if(hi==0)wsf[32+r32]=l_reg;asm volatile("s_waitcnt lgkmcnt(0)":::"memory");
  float rli[16];
  #pragma unroll
  for(int r=0;r<16;++r)rli[r]=__builtin_amdgcn_rcpf(wsf[32+crow(r,hi)]);
  bf16*Ow=J.O+(long)(wid*QBLK)*QP;
  { bf16*stg=(bf16*)(shm+LDS_OST)+wid*2048;
    #pragma unroll
    for(int r=0;r<16;++r){const int orow=crow(r,hi);
      #pragma unroll
      for(int d0=0;d0<2;++d0)stg[orow*64+d0*32+r32]=(bf16)cvtpk_s(o[d0][r]*rli[r],0.f);}
    asm volatile("s_waitcnt lgkmcnt(0)":::"memory");
    #pragma unroll
    for(int i=0;i<4;++i){const int row=i*8+(lane>>3),ch=lane&7; const u32x4 v=*(const u32x4*)(stg+row*64+ch*8); ATTN_STORE16(Ow+(long)row*QP+ch*8,v);} }
  asm volatile("s_waitcnt lgkmcnt(0)\n\ts_barrier":::"memory");
  #undef DMA_K
  #undef DMA_V
  #undef CMASK
  #undef START
  #undef RESC
  #undef ROT
}
#undef SBAR
#undef WAIT_BAR
}
__device__ __forceinline__ void sb_arrive(Frame& F, int j);
template <int KIND> __device__ __forceinline__ void attn_phase(Frame& F, const Args& A_) {
    constexpr int ldk = KIND == 0 ? 1024 : KIND == 1 ? 256 : 128, gsz = KIND == 0 ? 1 : KIND == 1 ? 4 : 8;
    char* shm = (char*)F.lds;
#pragma unroll 1
    for (int it = 0; ; ++it) {
        int U;
        if (F.xm && it == 4) sb_arrive(F, 18 + 2 * KIND);
        if (F.xm) {
            if (it < 4) U = F.xg * 128 + 4 * F.lidx + it; else if (it == 4 && F.lidx < 16) U = 1024 + F.xg * 16 + F.lidx; else break;
        } else { const int rounds = (1024 + 4 * F.G - 1) / (4 * F.G); const int r = it >> 2;
          if (r < rounds) { U = 4 * F.vcu + (it & 3) + r * 4 * F.G; if (U >= 1024) continue; }
          else { U = 1024 + F.vcu + (it - 4 * rounds) * F.G; if (U >= 1152) break; } }
        const bool lat = U < 1024; const int bh = lat ? (U >> 3) : (U - 1024), qb = lat ? (U & 7) : 0, b = bh >> 4, h = bh & 15, kvh = h / gsz;
        int kt0 = 0, nlt = 0;
        if (lat) {
            if constexpr (KIND == 1) { kt0 = 0; nlt = 32; }
            else if constexpr (KIND == 2) { const int q0 = qb * 256; const int lo = q0 - 128 < 0 ? 0 : q0 - 128, hi_ = q0 + 383 > SEQ - 1 ? SEQ - 1 : q0 + 383; kt0 = lo >> 6; nlt = (hi_ >> 6) - kt0 + 1; }
            else { const int rf = qb * 4; int r0f = rf - 4; r0f = r0f < 0 ? 0 : (r0f > 24 ? 24 : r0f); int r0l = rf + 3 - 4; r0l = r0l < 0 ? 0 : (r0l > 24 ? 24 : r0l);
                kt0 = r0f; nlt = r0l + 8 - r0f; if (nlt & 1) { if (kt0 + nlt < 32) ++nlt; else { --kt0; ++nlt; } } }
        }
        const size_t qrow = lat ? (size_t)b * SEQ + qb * 256 : (size_t)ML + b * CTXL;
        att::Job J;
        unsigned char* Rb = F.R + (size_t)b * SLAB; const size_t lrow = lat ? (size_t)qb * 256 : (size_t)SEQ;
        J.Q = (bf16*)(Rb + SL_Q) + lrow * 1024 + h * 64; J.O = (bf16*)F.HF + qrow * 1024 + h * 64;
        J.Kc = (bf16*)(Rb + SL_K) + (size_t)(kvh * 36 + 32) * 4096; J.Vc = (bf16*)(Rb + SL_V) + (size_t)SEQ * ldk + kvh * 64;
        J.Kl = (bf16*)(Rb + SL_K) + (size_t)(kvh * 36 + kt0) * 4096; J.Vl = (bf16*)(Rb + SL_V) + (size_t)(kt0 * 64) * ldk + kvh * 64;
        J.NT = 4 + nlt; J.lat = lat ? 1 : 0; J.qpos0 = qb * 256; J.kt0 = kt0; J.h = h; J.wave0 = F.wave0;
        J.aux = KIND == 0 ? A_.in[12] + (size_t)h * 465 : (KIND == 2 ? A_.in[19] + h : nullptr);
        att::attn_unit<KIND, 8>(J, shm);
    }
    if (F.xm) sb_arrive(F, 19 + 2 * KIND);
}
constexpr size_t WS_WG = 2 * MiB + 65536;
constexpr size_t LRU_AGG_OFF = 0, LRU_HIN_OFF = 16 * MiB;
__device__ __forceinline__ void lru_wprep(Frame& F, const Args& A_) {
    PHASE_IDS();
    bf16* WG = (bf16*)(F.ws + WS_WG);
    for (int i = (F.vcu * NWAVES + wave) * 64 + lane; i < 16 * 4 * 64 * 64; i += F.G * NWAVES * 64) {
        const int d = i & 63, e = (i >> 6) & 63, s = (i >> 12) & 3, n = i >> 14; const int dir = s >> 1;
        const float* src = (s & 1) ? A_.in[26] : A_.in[24];
        WG[i] = (bf16)f2bf(src[((size_t)(dir * 16 + n) * 64 + d) * 64 + e]); }
}
struct LruSpan { int dir, isctx, T, tok0; size_t rowb; };
__device__ __forceinline__ LruSpan lru_span(int step) { LruSpan s; s.dir = step >= 9 ? 1 : 0; const int s9 = step - 9 * s.dir; s.isctx = s9 == 0 ? 1 : 0; const int sp = s.dir ? 8 - s9 : s9 - 1;
    s.T = s.isctx ? CTXL : SEQ; s.tok0 = s.isctx ? 0 : sp * 256; s.rowb = s.isctx ? (size_t)SEQ : (size_t)0; return s; }
__device__ __forceinline__ void lru_sweeps(Frame& F, const Args& A_) {
    PHASE_IDS();
    typedef short bf16x8 __attribute__((ext_vector_type(8))); typedef float f32x16 __attribute__((ext_vector_type(16)));
    const int r32 = lane & 31, hi = lane >> 5;
    LAS float* xcf = (LAS float*)F.lds;
    LAS unsigned short* xcb = (LAS unsigned short*)(F.lds + 36864);
    LAS unsigned short* glt = (LAS unsigned short*)(F.lds + 73728);
    LAS unsigned short* hft = (LAS unsigned short*)(F.lds + 94208);
    LAS unsigned short* wgt = (LAS unsigned short*)(F.lds + 114688);
    LAS float* agg = (LAS float*)(F.lds + 123904);
    const bf16* WG = (const bf16*)(F.ws + WS_WG);
    bf16* HFW = (bf16*)F.HF;
    const int cq = tid & 15, tg = tid >> 4;
    const int trow = tid >> 2, tq = tid & 3;
#pragma unroll 1
    for (int v = F.xm ? F.xg * 32 + F.lidx : F.vcu; v < 256; v += F.xm ? 256 : F.G) {
        const int b = v >> 5, n = (v >> 1) & 15, hf = v & 1;
        const int ch = 64 * n + 32 * hf + r32;
        const char* XRb = (const char*)(F.R + (size_t)b * SLAB + SL_XR) + (size_t)(64 * n) * 2; bf16* GL = (bf16*)(F.R + (size_t)b * SLAB + SL_GL) + 64 * n + 32 * hf;
        bf16* HFb = HFW + (size_t)b * SEQ * 1024 + 64 * n + 32 * hf;
        bf16* dummy = (bf16*)(F.ws + WS_HC + 4 * MiB) + ((size_t)v * 512 + tid) * 16;
        f32x4 cwv[4];
#pragma unroll
        for (int k = 0; k < 4; ++k) cwv[k] = *(const f32x4*)(A_.in[22] + k * 1024 + 64 * n + 4 * cq);
        const f32x4 cbv = *(const f32x4*)(A_.in[23] + 64 * n + 4 * cq);
        typedef unsigned u32x2 __attribute__((ext_vector_type(2))); u32x2 xin[11]; v4u gin[2], hin[2];
#define LRU_FETCH(sp_) do { \
        _Pragma("unroll") for (int i = 0; i < 11; ++i) { int tt = (sp_).tok0 + 8 * tg - 2 + i; if (i < 2) tt = tt < 0 ? 0 : tt; if (i == 10) tt = tt > (sp_).T - 1 ? (sp_).T - 1 : tt; \
            xin[i] = *(const u32x2*)(XRb + (unsigned)((((int)(sp_).rowb + tt) * 1024 + 4 * cq) * 2)); } \
        { const unsigned e_ = ((sp_).dir && !(sp_).isctx) ? (unsigned)(((sp_).tok0 + trow) * 1024 + 8 * tq) : 0u;     \
          const bf16* gp = GL + e_; gin[0] = *(const GAS v4u*)gp; gin[1] = *(const GAS v4u*)(gp + 128 * 1024); const bf16* hp = HFb + e_; hin[0] = *(const GAS v4u*)hp; hin[1] = *(const GAS v4u*)(hp + 128 * 1024); } } while (0)
        { const LruSpan s0 = lru_span(0); LRU_FETCH(s0); }
#pragma unroll 1
        for (int d = 0; d < 2; ++d) {
            float S = 0.f;
            if (d == 1) asm volatile("s_waitcnt vmcnt(0)" ::: "memory");
            const float nba = -LOG2E * A_.in[25][d * 1024 + ch], nbx = -LOG2E * A_.in[27][d * 1024 + ch]; const float sp = -8.0f * LOG2E * log1pf(expf(-A_.in[28][d * 1024 + ch]));
            { const int row = tid >> 3, pc = tid & 7, st_ = row >> 5, e = row & 31;
              *(LAS v4u*)(wgt + row * 72 + 8 * pc) = *(const GAS v4u*)(WG + ((size_t)((n * 4 + 2 * d + st_) * 64 + 32 * hf + e) * 64 + 8 * pc)); }
#pragma unroll 1
        for (int s9 = 0; s9 < 9; ++s9) {
            const int step = 9 * d + s9;
            const LruSpan cur = lru_span(step);
            f32x4 xf[11];
            { const u32x2 z = {0u, 0u}; const int t0 = cur.tok0 + 8 * tg; if (t0 - 2 < 0) xin[0] = z; if (t0 - 1 < 0) xin[1] = z; if (t0 + 8 >= cur.T) xin[10] = z; }
#pragma unroll
            for (int i = 0; i < 11; ++i) { xf[i][0] = bf_lo(xin[i].x); xf[i][1] = __builtin_bit_cast(float, xin[i].x & 0xffff0000u); xf[i][2] = bf_lo(xin[i].y); xf[i][3] = __builtin_bit_cast(float, xin[i].y & 0xffff0000u); }
#pragma unroll
            for (int j = 0; j < 8; ++j) { const int tok = 8 * tg + j; const f32x4 a = cbv + cwv[0] * xf[j] + cwv[1] * xf[j + 1] + cwv[2] * xf[j + 2] + cwv[3] * xf[j + 3];
                if ((cq >> 3) == hf) *(LAS f32x4*)(xcf + tok * 36 + 4 * (cq & 7)) = a;
                u32x2 w; w.x = att::cvtpk_s(a[0], a[1]); w.y = att::cvtpk_s(a[2], a[3]); *(LAS u32x2*)(xcb + tok * 72 + 4 * cq) = w; }
            if (cur.dir && !cur.isctx) { *(LAS v4u*)(glt + trow * 40 + 8 * tq) = gin[0]; *(LAS v4u*)(glt + (trow + 128) * 40 + 8 * tq) = gin[1];
                                         *(LAS v4u*)(hft + trow * 40 + 8 * tq) = hin[0]; *(LAS v4u*)(hft + (trow + 128) * 40 + 8 * tq) = hin[1]; }
            __syncthreads();
            { const LruSpan nx = lru_span(step + 1 < 18 ? step + 1 : 17); LRU_FETCH(nx); }
            bf16x8 Af[4];
#pragma unroll
            for (int ks = 0; ks < 4; ++ks) Af[ks] = *(const LAS bf16x8*)(xcb + (32 * wave + r32) * 72 + 16 * ks + 8 * hi);
            f32x16 acc[2];
#pragma unroll
            for (int s = 0; s < 2; ++s) { acc[s] = (f32x16){};
#pragma unroll
                for (int ks = 0; ks < 4; ++ks) acc[s] = __builtin_amdgcn_mfma_f32_32x32x16_bf16(Af[ks], *(const LAS bf16x8*)(wgt + (s * 32 + r32) * 72 + 16 * ks + 8 * hi), acc[s], 0, 0, 0); }
            float af[16], bv[16];
#pragma unroll
            for (int r = 0; r < 16; ++r) { const int tok = 32 * wave + (r & 3) + 8 * (r >> 2) + 4 * hi; const float xv = xcf[tok * 36 + r32];
                const float rg = __builtin_amdgcn_rcpf(1.0f + __builtin_amdgcn_exp2f(__builtin_fmaf(acc[0][r], -LOG2E, nba))), ig = __builtin_amdgcn_rcpf(1.0f + __builtin_amdgcn_exp2f(__builtin_fmaf(acc[1][r], -LOG2E, nbx)));
                const float a = __builtin_amdgcn_exp2f(sp * rg);
                af[r] = a; bv[r] = __builtin_amdgcn_sqrtf(1.0f - a * a) * (ig * xv); }
            float RA[4], RB[4], LA[4], UA[4], LB[4], UB[4], st[4], h[16];
            if (cur.dir == 0) {
#pragma unroll
                for (int j = 0; j < 4; ++j) { float A = 1.f, Bv = 0.f;
#pragma unroll
                    for (int i = 0; i < 4; ++i) { Bv = af[4 * j + i] * Bv + bv[4 * j + i]; A *= af[4 * j + i]; }
                    RA[j] = A; RB[j] = Bv; }
            } else {
#pragma unroll
                for (int j = 0; j < 4; ++j) { float A = 1.f, Bv = 0.f;
#pragma unroll
                    for (int i = 3; i >= 0; --i) { Bv = af[4 * j + i] * Bv + bv[4 * j + i]; A *= af[4 * j + i]; }
                    RA[j] = A; RB[j] = Bv; }
            }
#pragma unroll
            for (int j = 0; j < 4; ++j) { auto ra = __builtin_amdgcn_permlane32_swap(__float_as_uint(RA[j]), __float_as_uint(RA[j]), false, false); LA[j] = __uint_as_float(ra[0]); UA[j] = __uint_as_float(ra[1]);
                auto rb = __builtin_amdgcn_permlane32_swap(__float_as_uint(RB[j]), __float_as_uint(RB[j]), false, false); LB[j] = __uint_as_float(rb[0]); UB[j] = __uint_as_float(rb[1]); }
            { float s = 0.f, At = 1.f;
              if (cur.dir == 0) {
#pragma unroll
                  for (int j = 0; j < 4; ++j) { s = LA[j] * s + LB[j]; s = UA[j] * s + UB[j]; At *= LA[j] * UA[j]; }
              } else {
#pragma unroll
                  for (int j = 3; j >= 0; --j) { s = UA[j] * s + UB[j]; s = LA[j] * s + LB[j]; At *= LA[j] * UA[j]; }
              }
              if (hi == 0) { typedef float f32x2_ __attribute__((ext_vector_type(2))); f32x2_ w2; w2[0] = At; w2[1] = s; *(LAS f32x2_*)(agg + (wave * 32 + r32) * 2) = w2; } }
            __syncthreads();
            float mine = 0.f;
            { float s = S;
#pragma unroll
              for (int k = 0; k < 8; ++k) { const int w = cur.dir ? 7 - k : k; typedef float f32x2_ __attribute__((ext_vector_type(2))); const f32x2_ ab2 = *(const LAS f32x2_*)(agg + (w * 32 + r32) * 2);
                  mine = (w == wave) ? s : mine; s = ab2[0] * s + ab2[1]; }
              S = s; }
            if (cur.dir == 0) {
                { float s = mine;
#pragma unroll
                  for (int j = 0; j < 4; ++j) { const float slo = s; s = LA[j] * s + LB[j]; const float sup = s; s = UA[j] * s + UB[j]; st[j] = hi ? sup : slo; } }
#pragma unroll
                for (int j = 0; j < 4; ++j) { float hh = st[j];
#pragma unroll
                    for (int i = 0; i < 4; ++i) { hh = af[4 * j + i] * hh + bv[4 * j + i]; h[4 * j + i] = hh; } }
            } else {
                { float s = mine;
#pragma unroll
                  for (int j = 3; j >= 0; --j) { const float sup = s; s = UA[j] * s + UB[j]; const float slo = s; s = LA[j] * s + LB[j]; st[j] = hi ? sup : slo; } }
#pragma unroll
                for (int j = 0; j < 4; ++j) { float hh = st[j];
#pragma unroll
                    for (int i = 3; i >= 0; --i) { hh = af[4 * j + i] * hh + bv[4 * j + i]; h[4 * j + i] = hh; } }
            }
            if (!cur.isctx) {
                if (cur.dir == 0) {
#pragma unroll
                    for (int r = 0; r < 16; ++r) { const int tok = 32 * wave + (r & 3) + 8 * (r >> 2) + 4 * hi; hft[tok * 40 + r32] = (unsigned short)att::cvtpk_s(h[r], 0.f); }
                } else {
#pragma unroll
                    for (int r = 0; r < 16; ++r) { const int tok = 32 * wave + (r & 3) + 8 * (r >> 2) + 4 * hi;
                        const float gl = bf_lo((unsigned)glt[tok * 40 + r32]), hfv = bf_lo((unsigned)hft[tok * 40 + r32]); glt[tok * 40 + r32] = (unsigned short)att::cvtpk_s((hfv + h[r]) * gl, 0.f); }
                }
            }
            __syncthreads();
            { const unsigned e_ = (unsigned)((cur.tok0 + trow) * 1024 + 8 * tq); const LAS unsigned short* src = (cur.dir ? glt : hft) + trow * 40 + 8 * tq;
              bf16* op = cur.isctx ? dummy : (cur.dir == 0 ? HFb + e_ : GL + e_); *(GAS v4u*)op = *(const LAS v4u*)src; *(GAS v4u*)(op + (cur.isctx ? 8 : 128 * 1024)) = *(const LAS v4u*)(src + 128 * 40); }
        } }
#undef LRU_FETCH
    }
}

#define XB_TMO      128
#define XB_XCNT(j)  (256  + 64 * (j))
#define XB_XSUB(j)  (1280 + 64 * (j))
#define XB_XGEN(j)  (2304 + 64 * (j))
#define XB_TOP      3328
#define XB_TOPGEN   3392
#define XCD_BAR_WORDS 3456
#define XB_SPIN_CAP (1u << 18)

__device__ __forceinline__ unsigned xb_ld(unsigned* p)              { return __hip_atomic_load(p, __ATOMIC_RELAXED, __HIP_MEMORY_SCOPE_AGENT); }
__device__ __forceinline__ unsigned xb_add(unsigned* p, unsigned v) { return __hip_atomic_fetch_add(p, v, __ATOMIC_RELAXED, __HIP_MEMORY_SCOPE_AGENT); }
__device__ __forceinline__ unsigned xb_xcc_id() { return (unsigned)__builtin_amdgcn_s_getreg((3 << 11) | 20) & 0xFu; }
#define XB_SPIN(cond, bar) do { unsigned _sp = 0; while (cond) { __builtin_amdgcn_s_sleep(1); \
    if ((++_sp & 255u) == 0u) { if (xb_ld(&(bar)[XB_TMO])) break; if (_sp > XB_SPIN_CAP) { atomicAdd(&(bar)[XB_TMO], 1u); break; } } } } while (0)

struct XcdBarrier {
    unsigned* bar; unsigned x;
    volatile LAS unsigned* st;
};

__device__ __forceinline__ XcdBarrier xcd_barrier_post(unsigned* bar, volatile LAS unsigned* st) {
    XcdBarrier b; b.bar = bar; b.x = xb_xcc_id(); b.st = st;
    if (threadIdx.x == 0) (void)xb_add(&bar[XB_XCNT(b.x)], 1u);
    return b;
}
__device__ __forceinline__ void xcd_barrier_complete(unsigned* bar, unsigned x, unsigned& nloc, unsigned& nx) {
    const unsigned G = gridDim.x * gridDim.y * gridDim.z;
    unsigned sum, cnt, mine, sp = 0u;
    for (;;) {
        sum = 0u; cnt = 0u; mine = 0u;
#pragma unroll
        for (unsigned j = 0; j < 16; ++j) { const unsigned c = xb_ld(&bar[XB_XCNT(j)]); sum += c; cnt += (c > 0u) ? 1u : 0u; mine = (j == x) ? c : mine; }
        if (sum == G) break;
        __builtin_amdgcn_s_sleep(1);
        if ((++sp & 255u) == 0u) { if (xb_ld(&bar[XB_TMO])) break; if (sp > XB_SPIN_CAP) { atomicAdd(&bar[XB_TMO], 1u); break; } }
    }
    nloc = mine > 0u ? mine : 1u; nx = cnt > 0u ? cnt : 1u;
}

__device__ __forceinline__ void xcd_barrier(const XcdBarrier& b) {
    asm volatile("s_waitcnt vmcnt(0)" ::: "memory");
    __syncthreads();
    if (threadIdx.x == 0) {
        unsigned* bar = b.bar; unsigned bx = b.x; asm volatile("" : "+s"(bx), "+s"(bar));
        __builtin_amdgcn_s_waitcnt(0);
        unsigned nloc = b.st[0], nx = b.st[1];
        if (nloc == 0u) { xcd_barrier_complete(bar, bx, nloc, nx); b.st[0] = nloc; b.st[1] = nx; }
        const unsigned old = xb_add(&bar[XB_XSUB(bx)], 1u);
        const unsigned gen = old / nloc;
        if (old + 1u == (gen + 1u) * nloc) {
            __builtin_amdgcn_fence(__ATOMIC_RELEASE, "agent");
            asm volatile("s_waitcnt vmcnt(0)" ::: "memory");
            const unsigned og = xb_add(&bar[XB_TOP], 1u);
            const unsigned tg = og / nx;
            if (og + 1u == (tg + 1u) * nx) xb_add(&bar[XB_TOPGEN], 1u);
            else XB_SPIN(xb_ld(&bar[XB_TOPGEN]) == tg, bar);
            __builtin_amdgcn_fence(__ATOMIC_ACQUIRE, "agent");
            xb_add(&bar[XB_XGEN(bx)], 1u);
            asm volatile("s_waitcnt vmcnt(0)" ::: "memory");
        } else {
            XB_SPIN(xb_ld(&bar[XB_XGEN(bx)]) == gen, bar);
            __builtin_amdgcn_fence(__ATOMIC_ACQUIRE, "agent");
            asm volatile("s_waitcnt vmcnt(0)" ::: "memory");
        }
    }
    __syncthreads();
}

constexpr int MISC_OFF = 131072 + 320;
#define GSYNC() xcd_barrier(bar)
__device__ __forceinline__ void xl_barrier(Frame& F) {
    asm volatile("s_waitcnt vmcnt(0)" ::: "memory");
    __syncthreads();
    if (threadIdx.x == 0) { unsigned* cntw = (unsigned*)(F.ws + WS_CTL) + 56320 + 64 * F.xg; unsigned* relw = (unsigned*)(F.ws + WS_CTL) + 57344 + 64 * F.xg;
        __builtin_amdgcn_s_waitcnt(0);
        const unsigned old = __hip_atomic_fetch_add(cntw, 1u, __ATOMIC_RELAXED, __HIP_MEMORY_SCOPE_AGENT); const unsigned gen = old >> 5;
        if ((old & 31u) == 31u) __hip_atomic_fetch_add(relw, 1u, __ATOMIC_RELAXED, __HIP_MEMORY_SCOPE_AGENT);
        else { unsigned sp = 0; while (__hip_atomic_load(relw, __ATOMIC_RELAXED, __HIP_MEMORY_SCOPE_AGENT) <= gen) { __builtin_amdgcn_s_sleep(1); if (++sp > (1u << 22)) break; } }
        __builtin_amdgcn_fence(__ATOMIC_ACQUIRE, "agent"); asm volatile("s_waitcnt vmcnt(0)" ::: "memory"); }
    __syncthreads();
}
#define XSYNC() do { if (F.xm) xl_barrier(F); else xcd_barrier(bar); } while (0)

#define SB_XSUB(j, x) (((j) < 18 ? 32768 + (j) * 1152 : 98304 + ((j) - 18) * 1152) + 64 * (x))
#define SB_TOP(j)     SB_XSUB(j, 16)
__device__ __forceinline__ void sb_arrive(Frame& F, int j) {
    asm volatile("s_waitcnt vmcnt(0)" ::: "memory");
    __syncthreads();
    if (F.xm) { if (threadIdx.x == 0) { unsigned* ctl = (unsigned*)(F.ws + WS_CTL);
            const unsigned old = __hip_atomic_fetch_add(ctl + SB_XSUB(j, F.xg), 1u, __ATOMIC_RELAXED, __HIP_MEMORY_SCOPE_AGENT);
            if (old + 1u == 32u) __hip_atomic_store(ctl + SB_XSUB(j, F.xg + 8), 32u, __ATOMIC_RELAXED, __HIP_MEMORY_SCOPE_AGENT); }
        return; }
    if (threadIdx.x == 0) { unsigned* ctl = (unsigned*)(F.ws + WS_CTL); const unsigned x = xb_xcc_id(); const unsigned nloc = ((volatile LAS unsigned*)(F.lds + MISC_OFF))[0];
        const unsigned old = __hip_atomic_fetch_add(ctl + SB_XSUB(j, x), 1u, __ATOMIC_RELAXED, __HIP_MEMORY_SCOPE_AGENT);
        if (old + 1u == nloc) {
            __builtin_amdgcn_fence(__ATOMIC_RELEASE, "agent"); asm volatile("s_waitcnt vmcnt(0)" ::: "memory");
            __hip_atomic_fetch_add(ctl + SB_TOP(j), nloc, __ATOMIC_RELAXED, __HIP_MEMORY_SCOPE_AGENT); } }
}
__device__ __forceinline__ void sb_wait(Frame& F, int j) {
    if (threadIdx.x == 0) { unsigned* w = (unsigned*)(F.ws + WS_CTL) + (F.xm ? SB_XSUB(j, F.xg + 8) : SB_TOP(j)); unsigned sp = 0; const unsigned need = F.xm ? 32u : (unsigned)F.G;
        while (__hip_atomic_load(w, __ATOMIC_RELAXED, __HIP_MEMORY_SCOPE_AGENT) < need) { __builtin_amdgcn_s_sleep(2); if (++sp > (1u << 23)) break; }
        __builtin_amdgcn_fence(__ATOMIC_ACQUIRE, "agent"); asm volatile("s_waitcnt vmcnt(0)" ::: "memory"); }
    __syncthreads();
}

__device__ __forceinline__ LAS const float* rstd_table(Frame& F, int pm) {
    LAS float* tb = (LAS float*)(F.lds + 131072 + 1024); const int tid_ = fresh_tid(F.wave0);
#pragma unroll
    for (int t = 0; t < 2; ++t) { const int lane_ = tid_ & 63, w_ = tid_ >> 6; const int r = t * 128 + w_ * 16 + (lane_ & 15);
        const float rs = pg8::row_rstd_q(F.SSQ, pm * 256 + r, lane_ >> 4); if ((lane_ >> 4) == 0) tb[r] = rs; }
    __syncthreads(); return (LAS const float*)tb;
}
template <int L> __device__ __forceinline__ void p1_std(Frame& F, const Args& A_) {
    constexpr int N = L == 0 ? 3072 : L == 1 ? 1536 : L == 2 ? 1280 : 2048;
    const bf16* wt = F.WT + (L == 0 ? WO_QKV0 : L == 1 ? WO_QKV1 : L == 2 ? WO_QKV2 : WO_WIN3);
    pg8::Gemm g{F.XS, wt, MT, N, 1024, 0}; pg8::StaticOrder S; if (F.xm) S.init_x(MT, N, F.xg, F.lidx); else S.init(MT, N, F.G, (int)blockIdx.x);
    pg8::EpiProj<L> E{F.SSQ, F.BIAS + (size_t)L * BIAS_SLOT, N, F.R, L == 0 ? 16 : L == 1 ? 4 : 2, A_.in[15], A_.in[16], F.CS};
    pg8::gemm_phase<pg8::EpiProj<L>, pg8::StaticOrder, true, true>(F.lds, g, S, E, F.wave0);
}
template <int L> __device__ __forceinline__ void mixer(Frame& F, const Args& A_, const XcdBarrier& bar) {
    if constexpr (L < 3) attn_phase<L>(F, A_);
    else lru_sweeps(F, A_);
}
template <int L> __device__ __forceinline__ void tail_std(Frame& F, const Args& A_, const XcdBarrier& bar) {
    const float* mod = F.MOD + (size_t)L * 9 * 6144;
    constexpr int Mo = L == 3 ? ML : MT;
    {
        const bf16* A = L == 3 ? (const bf16*)(F.R + SL_GL) : (const bf16*)F.HF;
        const bf16* wt = F.WT + (L == 0 ? WO_WO0 : L == 1 ? WO_WO1 : L == 2 ? WO_WO2 : WO_WOUT3);
        pg8::Gemm g{A, wt, Mo, 1024, 1024, L == 3 ? SLAB : (size_t)0}; pg8::StaticOrder S; if (F.xm) S.init_x(Mo, 1024, F.xg, F.lidx); else S.init(Mo, 1024, F.G, (int)blockIdx.x);
        pg8::EpiResid<L == 0> E{F.HL, F.HC, mod + 2 * 1024, mod + 4 * 1024, A_.in[7] + L * 1024, F.XS, F.SSQ, L == 0 ? A_.in[0] : nullptr, L == 0 ? A_.in[2] : nullptr};
        E.ssl = (LAS float*)(F.lds + 131072 + 11264);
        pg8::gemm_phase<pg8::EpiResid<L == 0>, pg8::StaticOrder, true, true>(F.lds, g, S, E, F.wave0);
    }
    XSYNC();
    {
        pg8::Gemm g{F.XS, F.WT + WO_FIN + (size_t)L * 5632 * 1024, Mo, 5632, 1024, 0}; pg8::StaticOrder S; if (F.xm) S.init_x(Mo, 5632, F.xg, F.lidx); else S.init(Mo, 5632, F.G, (int)blockIdx.x);
        pg8::EpiSwiGLU E{F.SSQ, F.BIAS + (size_t)(4 + L) * BIAS_SLOT, F.R};
        { pg8::Unit u0; if (S.next(0, u0)) { E.rpm = u0.pm; E.rsl = rstd_table(F, u0.pm); } }
        pg8::gemm_phase<pg8::EpiSwiGLU, pg8::StaticOrder, true, true>(F.lds, g, S, E, F.wave0);
    }
    XSYNC();
    {
        pg8::Gemm g{(const bf16*)(F.R + SL_HM), F.WT + WO_FOUT + (size_t)L * 1024 * 2816, Mo, 1024, 2816, SLAB}; pg8::StaticOrder S; if (F.xm) S.init_x(Mo, 1024, F.xg, F.lidx); else S.init(Mo, 1024, F.G, (int)blockIdx.x);
        const float* modn = F.MOD + (size_t)(L + 1) * 9 * 6144;
        if constexpr (L == 3) { if (S.nwg == S.G) {
            pg8::EpiResidFinal EF{F.HL, F.out, mod + 5 * 1024, A_.in[8], (float*)(F.ws + WS_SSQ + 1 * MiB), (unsigned*)(F.ws + WS_CTL) + 61440};
            pg8::gemm_phase<pg8::EpiResidFinal, pg8::StaticOrder, false, true>(F.lds, g, S, EF, F.wave0);
            return; } }
        pg8::EpiResid<false> E{F.HL, F.HC, mod + 5 * 1024, L < 3 ? modn + 1024 : nullptr, A_.in[6] + (L < 3 ? (L + 1) * 1024 : 0), L < 3 ? F.XS : nullptr, F.SSQ};
        E.ssl = (LAS float*)(F.lds + 131072 + 11264);
        pg8::gemm_phase<pg8::EpiResid<false>, pg8::StaticOrder, true, true>(F.lds, g, S, E, F.wave0);
    }
    XSYNC();
    if constexpr (L == 3) p_final(F, A_);
}
template <int L> __device__ __forceinline__ void chain(Frame& F, const Args& A_, const XcdBarrier& bar) {
    const float* mod = F.MOD + (size_t)L * 9 * 6144;
    const int c = F.xm ? (F.lidx ^ 16) : (int)blockIdx.x, G = F.xm ? 32 : (int)F.G, J = 6 * L, H2 = G / 2;
    const int EA = 18 + 2 * L, EC = 19 + 2 * L;
    const int lp0 = F.xm ? 8 * F.xg : 0, lnM = F.xm ? 8 : 64, cp0 = F.xm ? 64 + F.xg : 64, cnM = F.xm ? 1 : 8, nr = F.xm;
    {
        const bf16* wt = F.WT + (L == 0 ? WO_WO0 : L == 1 ? WO_WO1 : WO_WO2);
        pg8::Gemm g{(const bf16*)F.HF, wt, MT, 1024, 1024, 0};
        pg8::EpiResid<L == 0> E{F.HL, F.HC, mod + 2 * 1024, mod + 4 * 1024, A_.in[7] + L * 1024, F.XS, F.SSQ, L == 0 ? A_.in[0] : nullptr, L == 0 ? A_.in[2] : nullptr};
        E.ssl = (LAS float*)(F.lds + 131072 + 11264);
        pg8::ListOrder Sl; Sl.init(lp0, lnM, 1024, G, c, 0, 0, nr);
        if (F.xm) sb_wait(F, EA);
        pg8::gemm_phase<pg8::EpiResid<L == 0>, pg8::ListOrder, true, true>(F.lds, g, Sl, E, F.wave0);
        sb_arrive(F, J + 0);
        pg8::ListOrder Sc; Sc.init(cp0, cnM, 1024, G, c, 0, 1, nr);
        if (F.xm && Sc.any()) sb_wait(F, EC);
        pg8::gemm_phase<pg8::EpiResid<L == 0>, pg8::ListOrder, true, true>(F.lds, g, Sc, E, F.wave0);
        sb_arrive(F, J + 1);
    }
    {
        pg8::Gemm g{F.XS, F.WT + WO_FIN + (size_t)L * 5632 * 1024, MT, 5632, 1024, 0};
        pg8::EpiSwiGLU E{F.SSQ, F.BIAS + (size_t)(4 + L) * BIAS_SLOT, F.R};
        pg8::ListOrder Sl; Sl.init(lp0, lnM, 5632, G, c, H2, 0, nr);
        sb_wait(F, J + 0);
        if (F.xm) sb_wait(F, EC);
        { pg8::Unit u0; if (Sl.next(0, u0)) { E.rpm = u0.pm; E.rsl = rstd_table(F, u0.pm); } }
        pg8::gemm_phase<pg8::EpiSwiGLU, pg8::ListOrder, true, true>(F.lds, g, Sl, E, F.wave0);
        sb_arrive(F, J + 2);
        pg8::ListOrder Sc; Sc.init(cp0, cnM, 5632, G, c, 0, 0, nr, F.xm ? 16 : -1);
        if (Sc.any()) sb_wait(F, J + 1);
        pg8::gemm_phase<pg8::EpiSwiGLU, pg8::ListOrder, true, true>(F.lds, g, Sc, E, F.wave0);
        sb_arrive(F, J + 3);
    }
    {
        pg8::Gemm g{(const bf16*)(F.R + SL_HM), F.WT + WO_FOUT + (size_t)L * 1024 * 2816, MT, 1024, 2816, SLAB};
        const float* modn = F.MOD + (size_t)(L + 1) * 9 * 6144;
        pg8::EpiResid<false> E{F.HL, F.HC, mod + 5 * 1024, modn + 1024, A_.in[6] + (L + 1) * 1024, F.XS, F.SSQ};
        E.ssl = (LAS float*)(F.lds + 131072 + 11264);
        pg8::ListOrder Sl; Sl.init(lp0, lnM, 1024, G, c, 0, 0, nr);
        sb_wait(F, J + 2);
        pg8::gemm_phase<pg8::EpiResid<false>, pg8::ListOrder, true, true>(F.lds, g, Sl, E, F.wave0);
        sb_arrive(F, J + 4);
        pg8::ListOrder Sc; Sc.init(cp0, cnM, 1024, G, c, F.xm ? 24 : (5 * G) / 16, 1, nr);
        if (Sc.any()) sb_wait(F, J + 3);
        pg8::gemm_phase<pg8::EpiResid<false>, pg8::ListOrder, true, true>(F.lds, g, Sc, E, F.wave0);
        sb_arrive(F, J + 5);
    }
    {
        constexpr int N = L == 0 ? 1536 : L == 1 ? 1280 : 2048;
        const bf16* wt = F.WT + (L == 0 ? WO_QKV1 : L == 1 ? WO_QKV2 : WO_WIN3);
        pg8::Gemm g{F.XS, wt, MT, N, 1024, 0};
        pg8::EpiProj<L + 1> E{F.SSQ, F.BIAS + (size_t)(L + 1) * BIAS_SLOT, N, F.R, L == 0 ? 4 : 2, A_.in[15], A_.in[16], F.CS};
        if constexpr (L < 2) {
            LAS float* tb = (LAS float*)(F.lds + 131072 + 2048); const int tid_ = fresh_tid(F.wave0);
            for (int i = tid_; i < 2048; i += 512) tb[i] = F.CS[i];
            if (tid_ < 64) { tb[2048 + tid_] = A_.in[15][tid_]; tb[2112 + tid_] = A_.in[16][tid_]; }
            __syncthreads(); E.tb = (LAS const float*)tb; }
        pg8::ListOrder Sl; if (L == 0 && F.xm) { const bool ex = c >= 8 && c < 16; Sl.init(lp0, lnM, ex ? 0 : N, 24, ex ? 0 : (c >= 16 ? c - 16 : c + 16), 0, 0, nr); }
        else Sl.init(lp0, lnM, N, G, c, F.xm ? (L == 1 ? 16 : 8) : 0, 0, nr);
        sb_wait(F, J + 4);
        { pg8::Unit u0; if (Sl.next(0, u0)) { E.rpm = u0.pm; E.rsl = rstd_table(F, u0.pm); } }
        pg8::gemm_phase<pg8::EpiProj<L + 1>, pg8::ListOrder, true, true>(F.lds, g, Sl, E, F.wave0);
        pg8::ListOrder Sc; Sc.init(cp0, cnM, N, G, c, F.xm ? (L >= 1 ? 8 : 24) : H2, (L >= 1 && F.xm) ? 1 : 0, nr);
        if (Sc.any()) sb_wait(F, J + 5);
        pg8::gemm_phase<pg8::EpiProj<L + 1>, pg8::ListOrder, true, true>(F.lds, g, Sc, E, F.wave0);
    }
    XSYNC();
}

__global__ void __launch_bounds__(NWAVES * 64, 2) fwd_kernel(Args args) {
    extern __shared__ __attribute__((aligned(16))) unsigned char lds[];
    Frame F;
    F.lds = (LAS unsigned char*)lds;
        F.wave0 = __builtin_amdgcn_readfirstlane(threadIdx.x >> 6);
    F.G = gridDim.x; { const int bx = blockIdx.x; F.vcu = (F.G % 8 == 0) ? (bx % 8) * (F.G / 8) + bx / 8 : bx; }
    F.out = args.out; F.ws = args.ws;
    F.MOD = (float*)(F.ws + WS_MOD); F.CS = (float*)(F.ws + WS_CS); F.BIAS = (float*)(F.ws + WS_BIAS); F.SSQ = (float*)(F.ws + WS_SSQ); F.HC = (bf16*)(F.ws + WS_HC); F.HL = (bf16*)(F.ws + WS_LRU);
    F.WT = (bf16*)(F.ws + WS_WT); F.XS = (bf16*)(F.ws + WS_XS); F.R = F.ws + WS_R; F.HF = (float*)(F.ws + WS_HF);
    if (threadIdx.x < 8) ((LAS unsigned*)(F.lds + MISC_OFF))[threadIdx.x] = 0u;
    __syncthreads();
    XcdBarrier bar; bar.bar = (unsigned*)(F.ws + WS_CTL) + 4096; bar.st = (volatile LAS unsigned*)(F.lds + MISC_OFF); bar.x = xb_xcc_id();
    if (threadIdx.x == 0) { const unsigned li = xb_add(&bar.bar[XB_XCNT(bar.x)], 1u); ((volatile LAS unsigned*)(F.lds + MISC_OFF))[3] = li; }
    __syncthreads();
    F.xg = (int)bar.x; F.lidx = __builtin_amdgcn_readfirstlane((int)((volatile LAS unsigned*)(F.lds + MISC_OFF))[3]); F.xm = 0;
    p0a(F, args); lru_wprep(F, args); convert_all_weights(F, args);
    GSYNC();
    if (XCDMODE) {
        if (threadIdx.x == 0) { unsigned ok = (F.G == 256) ? 1u : 0u;
            for (unsigned j = 0; j < 16; ++j) { const unsigned cj = xb_ld(&bar.bar[XB_XCNT(j)]); if (cj != (j < 8 ? 32u : 0u)) ok = 0u; }
            ((volatile LAS unsigned*)(F.lds + MISC_OFF))[4] = ok; }
        __syncthreads();
        F.xm = __builtin_amdgcn_readfirstlane((int)((volatile LAS unsigned*)(F.lds + MISC_OFF))[4]);
    }
    p0b(F, args); GSYNC();
    p1_std<0>(F, args); XSYNC(); mixer<0>(F, args, bar); if (!(CHAIN && F.xm)) XSYNC();
    if constexpr (CHAIN) { chain<0>(F, args, bar); } else { tail_std<0>(F, args, bar); p1_std<1>(F, args); XSYNC(); }
    mixer<1>(F, args, bar); if (!(CHAIN && F.xm)) XSYNC();
    if constexpr (CHAIN) { chain<1>(F, args, bar); } else { tail_std<1>(F, args, bar); p1_std<2>(F, args); XSYNC(); }
    mixer<2>(F, args, bar); if (!(CHAIN && F.xm)) XSYNC();
    if constexpr (CHAIN) { chain<2>(F, args, bar); } else { tail_std<2>(F, args, bar); p1_std<3>(F, args); XSYNC(); }
    mixer<3>(F, args, bar); XSYNC();
    tail_std<3>(F, args, bar);
}

extern "C" void kernel_launch(void* const* d_in, const int* in_sizes, int n_in, void* d_out, int out_size, void* d_ws, size_t ws_size, hipStream_t stream) {
    static int grid = 0;
    if (grid == 0) {
        if (n_in != 30 || out_size != ML * DM || ws_size < WS_END) { fprintf(stderr, "kernel_launch: unexpected shapes (n_in %d out %d ws %zu); nothing launched\n", n_in, out_size, ws_size); grid = -1; return; }
        int dev = 0, cus = 0, per_cu = 0;
        if (hipGetDevice(&dev) != hipSuccess || hipDeviceGetAttribute(&cus, hipDeviceAttributeMultiprocessorCount, dev) != hipSuccess) { grid = -1; return; }
        if (hipFuncSetAttribute((const void*)fwd_kernel, hipFuncAttributeMaxDynamicSharedMemorySize, LDS_BYTES) != hipSuccess) { fprintf(stderr, "kernel_launch: hipFuncSetAttribute failed\n"); grid = -1; return; }
        if (hipOccupancyMaxActiveBlocksPerMultiprocessor(&per_cu, (const void*)fwd_kernel, NWAVES * 64, LDS_BYTES) != hipSuccess || per_cu < 1) { fprintf(stderr, "kernel_launch: occupancy query says %d\n", per_cu); per_cu = 1; }
        (void)hipGetLastError();
        grid = cus * (per_cu > 1 ? 1 : per_cu);
    }
    if (grid < 0) return;
    if (hipMemsetAsync((char*)d_ws + WS_CTL, 0, CTL_ZERO_BYTES, stream) != hipSuccess) { fprintf(stderr, "kernel_launch: memset failed\n"); return; }
    Args a{};
    for (int i = 0; i < 30; ++i) a.in[i] = (const float*)d_in[i];
    a.out = (float*)d_out; a.ws = (unsigned char*)d_ws;
    void* kargs[] = {&a};
    const hipError_t e = hipLaunchCooperativeKernel((const void*)fwd_kernel, dim3(grid), dim3(NWAVES * 64), kargs, LDS_BYTES, stream);
    if (e != hipSuccess) fprintf(stderr, "kernel_launch: cooperative launch failed: %s (grid %d)\n", hipGetErrorString(e), grid);
}
```

```cpp
#include <hip/hip_runtime.h>
#include <cstdio>
#include <cstdint>

constexpr int DM = 1024, NB = 8, SEQ = 2048, CTXL = 256, HD = 64, FF = 2816, NMOD = 6;
constexpr int ML = NB * SEQ;
constexpr int MC = NB * CTXL;
constexpr int MT = ML + MC;
constexpr float LOG2E = 1.4426950408889634f;
constexpr float QSCALE = 0.125f * LOG2E;
constexpr size_t SLAB = 14155776;
constexpr size_t SL_Q = 0, SL_K = 4718592, SL_V = 9437184;
constexpr size_t SL_HM = 0;
constexpr size_t SL_XR = 0, SL_GL = 4718592;
__host__ __device__ __forceinline__ int pan_b(int pm) { return pm < 64 ? pm >> 3 : pm - 64; }
__host__ __device__ __forceinline__ int pan_p(int pm) { return pm < 64 ? pm & 7 : 8; }
__device__ __forceinline__ int fresh_tid(int wave0) { int l; asm volatile("v_mbcnt_lo_u32_b32 %0, -1, 0\n\tv_mbcnt_hi_u32_b32 %0, -1, %0" : "=v"(l)); return wave0 * 64 + l; }
namespace pg8 {
#define PG8_LAS __attribute__((address_space(3)))
typedef unsigned short bf16_t;
typedef short bf16x8 __attribute__((ext_vector_type(8)));
typedef float f32x4 __attribute__((ext_vector_type(4)));
typedef unsigned u32x4 __attribute__((ext_vector_type(4)));
constexpr int BM = 256, BK = 64, HALF = 128, HTB = HALF * BK * 2  , STAGE_BYTES = 8 * HTB, NXCD = 8, WGM = 8;

__host__ __device__ __forceinline__ int lds_byte(int r, int c) { const int st = (r >> 4) * 2 + (c >> 5), rr = r & 15, cc = c & 31, ob = rr * 64 + cc * 2; return st * 1024 + (ob ^ (((ob >> 9) & 1) << 5)); }
__host__ __device__ __forceinline__ void stage_rc(int b, int& R, int& C) { const int st = b / 1024, sb = b % 1024, swz = sb ^ (((sb >> 9) & 1) << 5); R = (st >> 1) * 16 + swz / 64; C = (st & 1) * 32 + (swz % 64) / 2; }
__host__ __device__ __forceinline__ int perm32(int rho) { const int n = rho >> 4, i = rho & 15; return 8 * (i >> 2) + 4 * n + (i & 3); }

struct Unit { int pm, pn, hm; };
struct Gemm { const bf16_t* A; const bf16_t* Bt; int M, N, K; size_t slab;
    __device__ __forceinline__ const char* abase(int pm, size_t tstep) const { return slab ? (const char*)A + (size_t)pan_b(pm) * slab + (size_t)pan_p(pm) * tstep : (const char*)A + (size_t)pm * tstep; } };

struct StaticOrder {
    int nM, nN, nwg, G, c, xm, xg;
    __host__ __device__ void init(int M, int N, int G_, int c_) { nM = M / BM; nN = N / BM; nwg = nM * nN; G = G_; c = c_; xm = 0; xg = 0; }
    __host__ __device__ void init_x(int M, int N, int x, int lidx) { nM = M / BM == 72 ? 9 : 8; nN = N / BM; nwg = nM * nN; G = 32; c = lidx; xm = 1; xg = x; }
    __host__ __device__ bool next(int i, Unit& u) const {
        const long L0 = (long)i * G + c; const int nfull = (nwg / G) * G, rem = nwg - nfull; const bool halves = rem > 0 && 2 * rem <= G;
        long L = L0; u.hm = -1;
        if (halves && L0 >= nfull) { const long t = L0 - nfull; if (t >= 2 * rem) return false; L = nfull + (t >> 1); u.hm = (int)(t & 1); }
        if (L >= nwg) return false;
        if (xm) { const int p = (int)L % nM; u.pn = (int)L / nM; u.pm = p < 8 ? 8 * xg + p : 64 + xg; return true; }
        int wgid = (int)L; { const int q = nwg / NXCD, r = nwg % NXCD, xcd = wgid % NXCD, off = wgid / NXCD; wgid = (xcd < r ? xcd * (q + 1) : r * (q + 1) + (xcd - r) * q) + off; }
        const int nig = WGM * nN, gid = wgid / nig, fm = gid * WGM, gsz = (nM - fm) < WGM ? (nM - fm) : WGM;
        u.pm = fm + ((wgid % nig) % gsz); u.pn = (wgid % nig) / gsz; return true;
    }
    __device__ __forceinline__ void a_ready(const Unit&) const {}
    __device__ __forceinline__ void done(const Unit&) const {}
};

__device__ __forceinline__ unsigned cvt_pk_bf16(float lo, float hi) { unsigned r; asm volatile("v_cvt_pk_bf16_f32 %0, %1, %2" : "=v"(r) : "v"(lo), "v"(hi)); return r; }
typedef float f32x2 __attribute__((ext_vector_type(2)));
struct ListOrder {
    int pm0, nM, nN, nwg, G, r, nfull, noremap;
    __host__ __device__ void init(int pm0_, int nM_, int N, int G_, int c_, int rot, int halves_, int noremap_ = 0, int nfull_ = -1) { pm0 = pm0_; nM = nM_; nN = N / BM; nwg = nM * nN; G = G_; r = (c_ + rot) % G_;
        nfull = nfull_ >= 0 ? nfull_ : (halves_ ? 0 : nwg); noremap = noremap_; }
    __host__ __device__ bool next(int i, Unit& u) const {
        long L = (long)i * G + r; u.hm = -1;
        if (L >= nfull) { const long t = L - nfull; if (t >= 2 * (nwg - nfull)) return false; u.hm = (int)(t & 1); L = nfull + (t >> 1); }
        if (L >= nwg) return false;
        if (noremap) { u.pm = pm0 + (int)L % nM; u.pn = (int)L / nM; return true; }
        int wgid = (int)L; { const int q = nwg / NXCD, rr = nwg % NXCD, xcd = wgid % NXCD, off = wgid / NXCD; wgid = (xcd < rr ? xcd * (q + 1) : rr * (q + 1) + (xcd - rr) * q) + off; }
        const int nig = WGM * nN, gid = wgid / nig, fm = gid * WGM, gsz = (nM - fm) < WGM ? (nM - fm) : WGM;
        u.pm = pm0 + fm + ((wgid % nig) % gsz); u.pn = (wgid % nig) / gsz; return true;
    }
    __host__ __device__ bool any() const { return r < nfull + 2 * (nwg - nfull); }
    __device__ __forceinline__ void a_ready(const Unit&) const {}
    __device__ __forceinline__ void done(const Unit&) const {}
};

__device__ __forceinline__ float bperm_f(int src_lane, float v) { return __builtin_bit_cast(float, __builtin_amdgcn_ds_bpermute(src_lane << 2, __builtin_bit_cast(int, v))); }
__device__ __forceinline__ int mod_row(int pm) { return pm < 64 ? (pm >> 3) : 8; }
__device__ __forceinline__ float row_rstd(const float* ssq, int row) {
    const f32x4 s = *(const f32x4*)(ssq + (size_t)row * 4);
    return rsqrtf(((s[0] + s[1]) + (s[2] + s[3])) * (1.0f / 1024.0f) + 1e-6f);
}
__device__ __forceinline__ float fq_sum(float t) {
    { auto r = __builtin_amdgcn_permlane16_swap(__float_as_uint(t), __float_as_uint(t), false, false); t = __uint_as_float(r[0]) + __uint_as_float(r[1]); }
    { auto r = __builtin_amdgcn_permlane32_swap(__float_as_uint(t), __float_as_uint(t), false, false); t = __uint_as_float(r[0]) + __uint_as_float(r[1]); }
    return t;
}
__device__ __forceinline__ float row_rstd_q(const float* ssq, int row, int fq) {
    (void)fq; const f32x4 p = *(const f32x4*)(ssq + (size_t)row * 4);
    const float t = (p[0] + p[1]) + (p[2] + p[3]);
    return rsqrtf(t * (1.0f / 1024.0f) + 1e-6f);
}
__device__ __forceinline__ void st_bf16x4(bf16_t* p, f32x4 v) { typedef unsigned u32x2 __attribute__((ext_vector_type(2))); u32x2 w; w.x = cvt_pk_bf16(v[0], v[1]); w.y = cvt_pk_bf16(v[2], v[3]); *(u32x2*)p = w; }
__device__ __forceinline__ void st_bf16x8_pair(bf16_t* p, f32x4 v0, f32x4 v1, int fq) {
    unsigned a0 = cvt_pk_bf16(v0[0], v0[1]), a1 = cvt_pk_bf16(v0[2], v0[3]), b0 = cvt_pk_bf16(v1[0], v1[1]), b1 = cvt_pk_bf16(v1[2], v1[3]);
    auto rx = __builtin_amdgcn_permlane16_swap(a0, b0, false, false); auto ry = __builtin_amdgcn_permlane16_swap(a1, b1, false, false);
    typedef unsigned u32x4_ __attribute__((ext_vector_type(4))); u32x4_ w; w.x = rx[0]; w.y = ry[0]; w.z = rx[1]; w.w = ry[1];
    *(u32x4_*)(p + (fq & 1) * 16 + (fq >> 1) * 8) = w;
}
__device__ __forceinline__ void ld_bf16x8_pair(const bf16_t* p, int fq, f32x4& v0, f32x4& v1) {
    typedef unsigned u32x4_ __attribute__((ext_vector_type(4))); const u32x4_ w = *(const u32x4_*)(p + (fq & 1) * 16 + (fq >> 1) * 8);
    auto rx = __builtin_amdgcn_permlane16_swap(w.x, w.z, false, false); auto ry = __builtin_amdgcn_permlane16_swap(w.y, w.w, false, false);
    v0[0] = __builtin_bit_cast(float, rx[0] << 16); v0[1] = __builtin_bit_cast(float, rx[0] & 0xffff0000u); v0[2] = __builtin_bit_cast(float, ry[0] << 16); v0[3] = __builtin_bit_cast(float, ry[0] & 0xffff0000u);
    v1[0] = __builtin_bit_cast(float, rx[1] << 16); v1[1] = __builtin_bit_cast(float, rx[1] & 0xffff0000u); v1[2] = __builtin_bit_cast(float, ry[1] << 16); v1[3] = __builtin_bit_cast(float, ry[1] & 0xffff0000u);
}
__device__ __forceinline__ float gelu_tanh(float x) { const float z = 0.7978845608028654f * (x + 0.044715f * x * x * x); const float t = 1.0f - 2.0f * __builtin_amdgcn_rcpf(__builtin_amdgcn_exp2f(2.8853900817779268f * z) + 1.0f); return 0.5f * x * (1.0f + t); }

template <int KIND>
struct EpiProj {
    static constexpr bool PERM = false, AFTER_DRAIN = false;
    const float* ssq; const float* bias; int N;
    unsigned char* R; int nk;
    const float* qgain; const float* kgain; const float* cs;
    PG8_LAS const float* rsl = nullptr; int rpm = -1;
    PG8_LAS const float* tb = nullptr;
    __device__ __forceinline__ void operator()(const f32x4 (&acc)[2][2][4][2], const Unit& u, int wr, int wc, int fr, int fq) const {
        asm volatile("" : "+v"(fr), "+v"(fq));
        const int rm = mod_row(u.pm); const bool lat = u.pm < 64;
        const int g = 4 * u.pn + wc;
        const int tcol = u.pn * BM + wc * 32 + 4 * fq;
        unsigned char* Rb = R + (size_t)pan_b(u.pm) * SLAB; const int lr0 = (pan_p(u.pm) - u.pm) * BM;
        f32x4 bv[2][2];
#pragma unroll
        for (int bj = 0; bj < 2; ++bj)
#pragma unroll
            for (int n = 0; n < 2; ++n) bv[bj][n] = *(const f32x4*)(bias + (size_t)rm * N + tcol + bj * HALF + n * 16);
        if constexpr (KIND == 3) {
#pragma unroll
            for (int ai = 0; ai < 2; ++ai) { if (ai > 0 && u.hm >= 0) continue;
                asm volatile("" ::: "memory"); float rsv[4];
                if (rsl != nullptr && u.pm == rpm) {
#pragma unroll
                    for (int m_ = 0; m_ < 4; ++m_) rsv[m_] = rsl[(u.hm > 0 ? HALF : 0) + ai * HALF + wr * 64 + m_ * 16 + fr];
                } else {
                rsv[0] = row_rstd_q(ssq, u.pm * BM + (u.hm > 0 ? HALF : 0) + ai * HALF + wr * 64 + 0 * 16 + fr, fq); rsv[1] = row_rstd_q(ssq, u.pm * BM + (u.hm > 0 ? HALF : 0) + ai * HALF + wr * 64 + 1 * 16 + fr, fq); asm volatile("" ::: "memory"); rsv[2] = row_rstd_q(ssq, u.pm * BM + (u.hm > 0 ? HALF : 0) + ai * HALF + wr * 64 + 2 * 16 + fr, fq); rsv[3] = row_rstd_q(ssq, u.pm * BM + (u.hm > 0 ? HALF : 0) + ai * HALF + wr * 64 + 3 * 16 + fr, fq);
                }
#pragma unroll
                for (int m = 0; m < 4; ++m) { const int row = u.pm * BM + (u.hm > 0 ? HALF : 0) + ai * HALF + wr * 64 + m * 16 + fr; const float rs = rsv[m];
#pragma unroll
                    for (int bj = 0; bj < 2; ++bj) { f32x4 v2[2];
#pragma unroll
                        for (int n = 0; n < 2; ++n) { const f32x4 v = acc[ai][bj][m][n] * rs + bv[bj][n];
                            if (g < 16) v2[n] = v; else { v2[n][0] = gelu_tanh(v[0]); v2[n][1] = gelu_tanh(v[1]); v2[n][2] = gelu_tanh(v[2]); v2[n][3] = gelu_tanh(v[3]); } }
                        st_bf16x8_pair((g < 16 ? (bf16_t*)(Rb + SL_XR) + g * 64 : (bf16_t*)(Rb + SL_GL) + (g - 16) * 64) + (size_t)(row + lr0) * 1024 + 32 * bj, v2[0], v2[1], fq); } } }
        } else {
            const int slot = g < 16 ? 0 : (g < 16 + nk ? 1 : 2);
            bf16_t* dst; int ld;
            if (slot == 0) { dst = (bf16_t*)(Rb + SL_Q) + g * 64; ld = 1024; } else if (slot == 1) { dst = (bf16_t*)(Rb + SL_K) + (g - 16) * 64; ld = 64 * nk; } else { dst = (bf16_t*)(Rb + SL_V) + (g - 16 - nk) * 64; ld = 64 * nk; }
            const float* gp_ = slot == 0 ? qgain : kgain;
            const float osc = slot == 0 ? QSCALE : 1.0f;
#pragma unroll
            for (int ai = 0; ai < 2; ++ai) { if (ai > 0 && u.hm >= 0) continue;
                asm volatile("" ::: "memory"); float rsv[4];
                if (rsl != nullptr && u.pm == rpm) {
#pragma unroll
                    for (int m_ = 0; m_ < 4; ++m_) rsv[m_] = rsl[(u.hm > 0 ? HALF : 0) + ai * HALF + wr * 64 + m_ * 16 + fr];
                } else {
                rsv[0] = row_rstd_q(ssq, u.pm * BM + (u.hm > 0 ? HALF : 0) + ai * HALF + wr * 64 + 0 * 16 + fr, fq); rsv[1] = row_rstd_q(ssq, u.pm * BM + (u.hm > 0 ? HALF : 0) + ai * HALF + wr * 64 + 1 * 16 + fr, fq); asm volatile("" ::: "memory"); rsv[2] = row_rstd_q(ssq, u.pm * BM + (u.hm > 0 ? HALF : 0) + ai * HALF + wr * 64 + 2 * 16 + fr, fq); rsv[3] = row_rstd_q(ssq, u.pm * BM + (u.hm > 0 ? HALF : 0) + ai * HALF + wr * 64 + 3 * 16 + fr, fq);
                }
#pragma unroll
                for (int m = 0; m < 4; ++m) { const int row = u.pm * BM + (u.hm > 0 ? HALF : 0) + ai * HALF + wr * 64 + m * 16 + fr; const float rs = rsv[m];
                    f32x4 v[2][2];
#pragma unroll
                    for (int bj = 0; bj < 2; ++bj)
#pragma unroll
                        for (int n = 0; n < 2; ++n) v[bj][n] = acc[ai][bj][m][n] * rs + bv[bj][n];
                    if constexpr (KIND == 1) { if (slot != 2) {
                        float s = 0.f;
#pragma unroll
                        for (int bj = 0; bj < 2; ++bj)
#pragma unroll
                            for (int n = 0; n < 2; ++n) { const f32x4 x = v[bj][n]; s += (x[0] * x[0] + x[1] * x[1]) + (x[2] * x[2] + x[3] * x[3]); }
                        s = fq_sum(s);
                        const float r = rsqrtf(s * (1.0f / 64.0f) + 1e-6f);
#pragma unroll
                        for (int bj = 0; bj < 2; ++bj)
#pragma unroll
                            for (int n = 0; n < 2; ++n) v[bj][n] = v[bj][n] * r * (*(const PG8_LAS f32x4*)(tb + (slot == 0 ? 2048 : 2112) + 32 * bj + 16 * n + 4 * fq)); } }
                    if constexpr (KIND == 1 || KIND == 2) { if (slot != 2 && lat) {
                        const int t = row & 2047;
#pragma unroll
                        for (int bj = 0; bj < 2; ++bj) { const int pos = bj == 0 ? (t >> 6) : (t & 63);
                            const f32x4 c01 = *(const PG8_LAS f32x4*)(tb + (pos * 16 + 4 * fq) * 2), c23 = *(const PG8_LAS f32x4*)(tb + (pos * 16 + 4 * fq) * 2 + 4);
                            const f32x4 co = {c01[0], c01[2], c23[0], c23[2]}, si = {c01[1], c01[3], c23[1], c23[3]};
                            const f32x4 x1 = v[bj][0], x2 = v[bj][1];
                            v[bj][0] = x1 * co - x2 * si; v[bj][1] = x1 * si + x2 * co; } } }
#pragma unroll
                    for (int bj = 0; bj < 2; ++bj) {
                        if (slot == 1) {
                            const int lrow = row + lr0, chunk = 4 * bj + 2 * (fq & 1) + (fq >> 1);
                            bf16_t* kp = (bf16_t*)(Rb + SL_K) + ((size_t)(((g - 16) * 36 + (lrow >> 6)) * 8 + chunk) * 64 + (lrow & 63)) * 8 - ((fq & 1) * 16 + (fq >> 1) * 8);
                            st_bf16x8_pair(kp, v[bj][0] * osc, v[bj][1] * osc, fq);
                        } else st_bf16x8_pair(dst + (size_t)(row + lr0) * ld + 32 * bj, v[bj][0] * osc, v[bj][1] * osc, fq); } } }
        }
    }
};

struct EpiSwiGLU {
    static constexpr bool PERM = false, AFTER_DRAIN = false;
    const float* ssq; const float* bias; unsigned char* R;
    PG8_LAS const float* rsl = nullptr; int rpm = -1;
    __device__ __forceinline__ void operator()(const f32x4 (&acc)[2][2][4][2], const Unit& u, int wr, int wc, int fr, int fq) const {
        asm volatile("" : "+v"(fr), "+v"(fq));
        const int rm = mod_row(u.pm); const int tcol = u.pn * BM + wc * 32 + 4 * fq;
        f32x4 bv[2][2];
#pragma unroll
        for (int bj = 0; bj < 2; ++bj)
#pragma unroll
            for (int n = 0; n < 2; ++n) bv[bj][n] = *(const f32x4*)(bias + (size_t)rm * (2 * FF) + tcol + bj * HALF + n * 16);
#pragma unroll
        for (int ai = 0; ai < 2; ++ai) { if (ai > 0 && u.hm >= 0) continue;
            asm volatile("" ::: "memory"); float rsv[4];
            if (rsl != nullptr && u.pm == rpm) {
#pragma unroll
                for (int m = 0; m < 4; ++m) rsv[m] = rsl[(u.hm > 0 ? HALF : 0) + ai * HALF + wr * 64 + m * 16 + fr];
            } else {
#pragma unroll
            for (int m = 0; m < 4; ++m) rsv[m] = row_rstd_q(ssq, u.pm * BM + (u.hm > 0 ? HALF : 0) + ai * HALF + wr * 64 + m * 16 + fr, fq); }
#pragma unroll
            for (int m = 0; m < 4; ++m) { const int row = u.pm * BM + (u.hm > 0 ? HALF : 0) + ai * HALF + wr * 64 + m * 16 + fr; const float rs = rsv[m];
                f32x4 o2[2];
#pragma unroll
                for (int n = 0; n < 2; ++n) { const f32x4 a = acc[ai][0][m][n] * rs + bv[0][n], gg = acc[ai][1][m][n] * rs + bv[1][n];
#pragma unroll
                    for (int e = 0; e < 4; ++e) o2[n][e] = a[e] * __builtin_amdgcn_rcpf(1.0f + __builtin_amdgcn_exp2f(-1.4426950408889634f * a[e])) * gg[e]; }
                st_bf16x8_pair((bf16_t*)(R + (size_t)pan_b(u.pm) * SLAB + SL_HM) + (size_t)(row + (pan_p(u.pm) - u.pm) * BM) * FF + u.pn * 128 + wc * 32, o2[0], o2[1], fq); } }
    }
};

template <bool F32IN>
struct EpiResid {
    static constexpr bool PERM = false, AFTER_DRAIN = false;
    bf16_t* Hl; bf16_t* Hc; const float* gate; const float* nsc; const float* ng; bf16_t* XS; float* ssq;
    const float* Rl = nullptr; const float* Rc = nullptr;
    PG8_LAS float* ssl = nullptr;
    __device__ __forceinline__ void operator()(const f32x4 (&acc)[2][2][4][2], const Unit& u, int wr, int wc, int fr, int fq) const {
        asm volatile("" : "+v"(fr), "+v"(fq));
        const int rm = mod_row(u.pm);
        bf16_t* Hb = u.pm < 64 ? Hl + (size_t)u.pm * BM * 1024 : Hc + (size_t)(u.pm - 64) * BM * 1024;
        const float* Rb = F32IN ? (u.pm < 64 ? Rl + (size_t)u.pm * BM * 1024 : Rc + (size_t)(u.pm - 64) * BM * 1024) : nullptr;
        const int col0 = u.pn * BM + wc * 32 + 4 * fq; const int cst = u.pn * BM + wc * 32;
        f32x4 gt[2][2], gs[2][2];
#pragma unroll
        for (int bj = 0; bj < 2; ++bj)
#pragma unroll
            for (int n = 0; n < 2; ++n) { const int col = col0 + bj * HALF + n * 16; gt[bj][n] = *(const f32x4*)(gate + (size_t)rm * 6144 + col);
                if (XS) gs[bj][n] = *(const f32x4*)(ng + col) * (*(const f32x4*)(nsc + (size_t)rm * 6144 + col) + 1.0f); else gs[bj][n] = (f32x4){0.f, 0.f, 0.f, 0.f}; }
#pragma unroll
        for (int ai = 0; ai < 2; ++ai) { if (ai > 0 && u.hm >= 0) continue;
#pragma unroll
          for (int mh = 0; mh < 2; ++mh) {
            asm volatile("" ::: "memory");
            const int rl0 = (u.hm > 0 ? HALF : 0) + ai * HALF + wr * 64 + mh * 32 + fr;
            f32x4 hv[2][2][2];
#pragma unroll
            for (int m = 0; m < 2; ++m)
#pragma unroll
                for (int bj = 0; bj < 2; ++bj) {
                    if constexpr (F32IN) {
#pragma unroll
                        for (int n = 0; n < 2; ++n) hv[m][bj][n] = __builtin_nontemporal_load((const f32x4*)(Rb + (size_t)(rl0 + m * 16) * 1024 + col0 + bj * HALF + n * 16));
                    } else ld_bf16x8_pair(Hb + (size_t)(rl0 + m * 16) * 1024 + cst + bj * HALF, fq, hv[m][bj][0], hv[m][bj][1]); }
            float ssv[2];
#pragma unroll
            for (int m = 0; m < 2; ++m) { const int rl = rl0 + m * 16; const int row = u.pm * BM + rl; float ss = 0.f;
#pragma unroll
                for (int bj = 0; bj < 2; ++bj) { f32x4 xo[2], ho[2];
#pragma unroll
                    for (int n = 0; n < 2; ++n) {
                        const f32x4 hn = hv[m][bj][n] + gt[bj][n] * acc[ai][bj][2 * mh + m][n]; ho[n] = hn;
                        ss += (hn[0] * hn[0] + hn[1] * hn[1]) + (hn[2] * hn[2] + hn[3] * hn[3]);
                        xo[n] = hn * gs[bj][n]; }
                    st_bf16x8_pair(Hb + (size_t)rl * 1024 + cst + bj * HALF, ho[0], ho[1], fq);
                    if (XS) st_bf16x8_pair(XS + (size_t)row * 1024 + cst + bj * HALF, xo[0], xo[1], fq); }
                ssv[m] = fq_sum(ss); }
            if (fq == 0) {
#pragma unroll
                for (int m = 0; m < 2; ++m) ssl[(wr * 4 + wc) * 128 + ai * 64 + mh * 32 + m * 16 + fr] = ssv[m]; } } }
        asm volatile("s_waitcnt lgkmcnt(0)" ::: "memory"); __builtin_amdgcn_s_barrier(); asm volatile("" ::: "memory");
        if (wc == 0) { const int lane_ = fq * 16 + fr;
#pragma unroll
            for (int t = 0; t < 2; ++t) { const int rr = lane_ + 64 * t;
                if (t == 0 || u.hm < 0) { const float tot = (ssl[(wr * 4 + 0) * 128 + rr] + ssl[(wr * 4 + 1) * 128 + rr]) + (ssl[(wr * 4 + 2) * 128 + rr] + ssl[(wr * 4 + 3) * 128 + rr]);
                    const int rl = (u.hm > 0 ? HALF : 0) + (rr >> 6) * HALF + wr * 64 + (rr & 63);
                    ssq[(size_t)(u.pm * BM + rl) * 4 + u.pn] = tot; } } }
    }
};

struct EpiResidFinal {
    static constexpr bool PERM = false, AFTER_DRAIN = true;
    const bf16_t* H; float* out; const float* gate; const float* gfin; float* ssqx; unsigned* cnt;
    __device__ __forceinline__ void fused(f32x4 (&acc)[2][2][4][2], const Unit& u, int wr, int wc, int fr, int fq, PG8_LAS unsigned char* lds, int wid, int lane) const {
        asm volatile("" : "+v"(fr), "+v"(fq));
        const int rm = mod_row(u.pm); const bf16_t* Hb = H + (size_t)u.pm * BM * 1024; const int col0 = u.pn * BM + wc * 32 + 4 * fq; const int cst = u.pn * BM + wc * 32;
        f32x4 gt[2][2];
#pragma unroll
        for (int bj = 0; bj < 2; ++bj)
#pragma unroll
            for (int n = 0; n < 2; ++n) gt[bj][n] = *(const f32x4*)(gate + (size_t)rm * 6144 + col0 + bj * HALF + n * 16);
#pragma unroll
        for (int ai = 0; ai < 2; ++ai)
#pragma unroll
            for (int mh = 0; mh < 2; ++mh) { asm volatile("" ::: "memory");
                const int rl0 = ai * HALF + wr * 64 + mh * 32 + fr; f32x4 hv[2][2][2];
#pragma unroll
                for (int m = 0; m < 2; ++m)
#pragma unroll
                    for (int bj = 0; bj < 2; ++bj) ld_bf16x8_pair(Hb + (size_t)(rl0 + m * 16) * 1024 + cst + bj * HALF, fq, hv[m][bj][0], hv[m][bj][1]);
#pragma unroll
                for (int m = 0; m < 2; ++m) { float ss = 0.f;
#pragma unroll
                    for (int bj = 0; bj < 2; ++bj)
#pragma unroll
                        for (int n = 0; n < 2; ++n) { const f32x4 hn = hv[m][bj][n] + gt[bj][n] * acc[ai][bj][2 * mh + m][n]; acc[ai][bj][2 * mh + m][n] = hn;
                            ss += (hn[0] * hn[0] + hn[1] * hn[1]) + (hn[2] * hn[2] + hn[3] * hn[3]); }
                    ss = fq_sum(ss);
                    if (fq == 0) __hip_atomic_store(ssqx + (size_t)(u.pm * BM + rl0 + m * 16) * 16 + 4 * u.pn + wc, ss, __ATOMIC_RELAXED, __HIP_MEMORY_SCOPE_AGENT); } }
        asm volatile("s_waitcnt vmcnt(0)" ::: "memory");
        if (lane == 0) __hip_atomic_fetch_add(cnt + 64 * u.pm, 1u, __ATOMIC_RELAXED, __HIP_MEMORY_SCOPE_AGENT);
        if (wid == 0) { unsigned sp = 0;
            while ((unsigned)__builtin_amdgcn_readfirstlane(__hip_atomic_load(cnt + 64 * u.pm, __ATOMIC_RELAXED, __HIP_MEMORY_SCOPE_AGENT)) < 32u) { __builtin_amdgcn_s_sleep(2); if (++sp > (1u << 21)) break; }
            __builtin_amdgcn_fence(__ATOMIC_ACQUIRE, "agent"); asm volatile("s_waitcnt vmcnt(0)" ::: "memory"); }
        asm volatile("s_waitcnt lgkmcnt(0)" ::: "memory"); __builtin_amdgcn_s_barrier(); asm volatile("" ::: "memory");
        f32x4 gf[2][2];
#pragma unroll
        for (int bj = 0; bj < 2; ++bj)
#pragma unroll
            for (int n = 0; n < 2; ++n) gf[bj][n] = *(const f32x4*)(gfin + col0 + bj * HALF + n * 16);
#pragma unroll
        for (int ai = 0; ai < 2; ++ai) { asm volatile("" ::: "memory"); float rsv[4];
#pragma unroll
            for (int m = 0; m < 4; ++m) { const unsigned long long* sp8 = (const unsigned long long*)(ssqx + (size_t)(u.pm * BM + ai * HALF + wr * 64 + m * 16 + fr) * 16); float t = 0.f;
#pragma unroll
                for (int q = 0; q < 8; ++q) { const unsigned long long w = __hip_atomic_load(sp8 + q, __ATOMIC_RELAXED, __HIP_MEMORY_SCOPE_AGENT); t += __uint_as_float((unsigned)w) + __uint_as_float((unsigned)(w >> 32)); }
                rsv[m] = rsqrtf(t * (1.0f / 1024.0f) + 1e-6f); }
#pragma unroll
            for (int m = 0; m < 4; ++m) { const int row = u.pm * BM + ai * HALF + wr * 64 + m * 16 + fr;
#pragma unroll
                for (int bj = 0; bj < 2; ++bj)
#pragma unroll
                    for (int n = 0; n < 2; ++n) __builtin_nontemporal_store(acc[ai][bj][m][n] * rsv[m] * gf[bj][n], (f32x4*)(out + (size_t)row * 1024 + col0 + bj * HALF + n * 16)); } }
    }
    __device__ __forceinline__ void operator()(const f32x4 (&)[2][2][4][2], const Unit&, int, int, int, int) const {}
};

template <class Epi, class Sched, bool ALIGN_EPI = false, bool SP2 = false>
__device__ __forceinline__ void gemm_phase(PG8_LAS unsigned char* lds, const Gemm g, const Sched& S, const Epi& E, const int wave0) {
    const int tid = fresh_tid(wave0), wid = __builtin_amdgcn_readfirstlane(tid >> 6), lane = tid & 63, wr = wid >> 2, wc = wid & 3, fr = lane & 15, fq = lane >> 4;
    const int K = g.K, nt = K / BK;
    unsigned voffA[2], voffB[2];
#pragma unroll
    for (int i = 0; i < 2; ++i) { int R, C; stage_rc(tid * 16 + i * 8192, R, C); const int Rb = Epi::PERM ? ((R & ~31) + perm32(R & 31)) : R;
        voffA[i] = (unsigned)(R * K + C) * 2u; voffB[i] = (unsigned)(Rb * K + C) * 2u; }
    const size_t kstep = (size_t)(BK * 2);
    const size_t hstep = (size_t)HALF * K * 2;
    const size_t tstep = 2 * hstep;
    const unsigned ldsw = (unsigned)wid * 1024u;
    const int aoff = lds_byte(wr * 64 + fr, fq * 8), boff = lds_byte(wc * 32 + fr, fq * 8);
#define PG8_SA(b, h) (((b) * 2 + (h)) * HTB)
#define PG8_SB(b, h) ((4 + (b) * 2 + (h)) * HTB)
#define PG8_STAGE(bufoff, gbase, voff) do { _Pragma("unroll") for (int _i = 0; _i < 2; ++_i) \
        __builtin_amdgcn_global_load_lds((const unsigned*)((const char*)(gbase) + (voff)[_i]), (PG8_LAS unsigned*)(lds + (bufoff) + ldsw + _i * 8192), 16, 0, 0); } while (0)
#define PG8_LDA(dst, b, h) do { _Pragma("unroll") for (int m = 0; m < 4; ++m) _Pragma("unroll") for (int k = 0; k < 2; ++k) dst[m][k] = *(const PG8_LAS bf16x8*)(lds + PG8_SA(b, h) + aoff + m * 2048 + k * 1024); } while (0)
#define PG8_LDB(dst, b, h) do { _Pragma("unroll") for (int n = 0; n < 2; ++n) _Pragma("unroll") for (int k = 0; k < 2; ++k) dst[n][k] = *(const PG8_LAS bf16x8*)(lds + PG8_SB(b, h) + boff + n * 2048 + k * 1024); } while (0)
#define PG8_MMA(ai, bj, At, Bt) do { __builtin_amdgcn_s_setprio(1); _Pragma("unroll") for (int m = 0; m < 4; ++m) _Pragma("unroll") for (int n = 0; n < 2; ++n) _Pragma("unroll") for (int k = 0; k < 2; ++k) \
        acc[ai][bj][m][n] = __builtin_amdgcn_mfma_f32_16x16x32_bf16(Bt[n][k], At[m][k], acc[ai][bj][m][n], 0, 0, 0); __builtin_amdgcn_s_setprio(0); } while (0)
#define PG8_WAIT_V(n) asm volatile("s_waitcnt vmcnt(" #n ")" ::: "memory")
#define PG8_WAIT_L(n) asm volatile("s_waitcnt lgkmcnt(" #n ")" ::: "memory")
#define PG8_BAR __builtin_amdgcn_s_barrier()
#define PG8_SCHED __builtin_amdgcn_sched_barrier(0)
    Unit cur, nxt; int ui = 0;
    if (!S.next(0, cur)) return;
    f32x4 acc[2][2][4][2];
#pragma unroll
    for (int a = 0; a < 2; ++a)
#pragma unroll
        for (int b = 0; b < 2; ++b)
#pragma unroll
            for (int m = 0; m < 4; ++m)
#pragma unroll
                for (int n = 0; n < 2; ++n) acc[a][b][m][n] = (f32x4){0.f, 0.f, 0.f, 0.f};
    bf16x8 At[4][2], B0[2][2], B1[2][2];
    static_assert(SP2, "half units are wired into the SP2 loop only");
    const char* cA = g.abase(cur.pm, tstep) + (cur.hm > 0 ? hstep : 0); const char* cB = (const char*)g.Bt + (size_t)cur.pn * tstep;
    size_t cAh = cur.hm >= 0 ? 0 : hstep;
    S.a_ready(cur);
    if constexpr (SP2) {
        PG8_STAGE(PG8_SB(0, 0), cB, voffB); PG8_STAGE(PG8_SB(0, 1), cB + hstep, voffB); PG8_STAGE(PG8_SA(0, 0), cA, voffA); PG8_STAGE(PG8_SA(0, 1), cA + cAh, voffA);
        if (wr == 1) PG8_BAR;
        PG8_WAIT_V(2); PG8_BAR;
        PG8_STAGE(PG8_SB(1, 0), cB + kstep, voffB); PG8_STAGE(PG8_SA(1, 0), cA + kstep, voffA); PG8_STAGE(PG8_SB(1, 1), cB + hstep + kstep, voffB);
        PG8_WAIT_V(6); PG8_BAR;
    } else {
        PG8_STAGE(PG8_SB(0, 0), cB, voffB); PG8_STAGE(PG8_SA(0, 0), cA, voffA); PG8_STAGE(PG8_SB(0, 1), cB + hstep, voffB); PG8_STAGE(PG8_SA(0, 1), cA + hstep, voffA);
        if (wr == 1) PG8_BAR;
        PG8_WAIT_V(4); PG8_BAR;
        PG8_STAGE(PG8_SB(1, 0), cB + kstep, voffB); PG8_STAGE(PG8_SA(1, 0), cA + kstep, voffA); PG8_STAGE(PG8_SB(1, 1), cB + hstep + kstep, voffB);
        PG8_WAIT_V(6); PG8_BAR;
    }
    for (;;) {
        const bool has_next = S.next(ui + 1, nxt);
        const char* nA = has_next ? g.abase(nxt.pm, tstep) + (nxt.hm > 0 ? hstep : 0) : cA; const char* nB = has_next ? (const char*)g.Bt + (size_t)nxt.pn * tstep : cB;
        const size_t nAh = has_next ? (nxt.hm >= 0 ? 0 : hstep) : cAh; const bool cfull = cur.hm < 0;
        for (int t = 0; t < nt; t += 2) {
            const bool last = (t == nt - 2);
            int tq = t; asm volatile("" : "+s"(tq));
            const char* a1 = cA + (size_t)(tq + 1) * kstep;
            const char* a2 = last ? nA : cA + (size_t)(tq + 2) * kstep; const char* b2 = last ? nB : cB + (size_t)(tq + 2) * kstep;
            const char* a3 = a2 + kstep; const char* b3 = b2 + kstep;
            const size_t a2h = last ? nAh : cAh;
            if (last && has_next) S.a_ready(nxt);
            if constexpr (SP2) {
            PG8_LDB(B0, 0, 0); PG8_LDB(B1, 0, 1); PG8_SCHED; PG8_LDA(At, 0, 0); PG8_STAGE(PG8_SA(1, 1), a1 + cAh, voffA);
            PG8_WAIT_V(8); PG8_WAIT_L(0); PG8_BAR; PG8_MMA(0, 0, At, B0); PG8_MMA(0, 1, At, B1); PG8_BAR; PG8_SCHED;
            if (cfull) PG8_LDA(At, 0, 1); PG8_STAGE(PG8_SB(0, 0), b2, voffB); PG8_STAGE(PG8_SB(0, 1), b2 + hstep, voffB); PG8_STAGE(PG8_SA(0, 0), a2, voffA);
            PG8_WAIT_V(8); PG8_WAIT_L(0); PG8_BAR; if (cfull) { PG8_MMA(1, 0, At, B0); PG8_MMA(1, 1, At, B1); } PG8_BAR; PG8_SCHED;
            PG8_LDB(B0, 1, 0); PG8_LDB(B1, 1, 1); PG8_SCHED; PG8_LDA(At, 1, 0); PG8_STAGE(PG8_SA(0, 1), a2 + a2h, voffA);
            PG8_WAIT_V(8); PG8_WAIT_L(0); PG8_BAR; PG8_MMA(0, 0, At, B0); PG8_MMA(0, 1, At, B1); PG8_BAR; PG8_SCHED;
            if (cfull) PG8_LDA(At, 1, 1); PG8_STAGE(PG8_SB(1, 0), b3, voffB); PG8_STAGE(PG8_SB(1, 1), b3 + hstep, voffB); PG8_STAGE(PG8_SA(1, 0), a3, voffA);
            PG8_WAIT_V(8); PG8_WAIT_L(0); PG8_BAR; if (cfull) { PG8_MMA(1, 0, At, B0); PG8_MMA(1, 1, At, B1); } PG8_BAR; PG8_SCHED;
            } else {
            PG8_LDB(B0, 0, 0); PG8_SCHED; PG8_LDA(At, 0, 0); PG8_STAGE(PG8_SA(1, 1), a1 + hstep, voffA);
            PG8_WAIT_L(8); PG8_BAR; PG8_WAIT_L(0); PG8_MMA(0, 0, At, B0); PG8_BAR; PG8_SCHED;
            PG8_LDB(B1, 0, 1); PG8_STAGE(PG8_SB(0, 0), b2, voffB);
            PG8_BAR; PG8_WAIT_L(0); PG8_MMA(0, 1, At, B1); PG8_BAR;
            PG8_LDA(At, 0, 1); PG8_STAGE(PG8_SA(0, 0), a2, voffA);
            PG8_BAR; PG8_WAIT_L(0); PG8_MMA(1, 0, At, B0); PG8_BAR; PG8_SCHED;
            PG8_STAGE(PG8_SB(0, 1), b2 + hstep, voffB);
            PG8_WAIT_V(6); PG8_BAR; PG8_MMA(1, 1, At, B1); PG8_BAR;
            PG8_LDB(B0, 1, 0); PG8_SCHED; PG8_LDA(At, 1, 0); PG8_STAGE(PG8_SA(0, 1), a2 + hstep, voffA);
            PG8_WAIT_L(8); PG8_BAR; PG8_WAIT_L(0); PG8_MMA(0, 0, At, B0); PG8_BAR; PG8_SCHED;
            PG8_LDB(B1, 1, 1); PG8_STAGE(PG8_SB(1, 0), b3, voffB);
            PG8_BAR; PG8_WAIT_L(0); PG8_MMA(0, 1, At, B1); PG8_BAR;
            PG8_LDA(At, 1, 1); PG8_STAGE(PG8_SA(1, 0), a3, voffA);
            PG8_BAR; PG8_WAIT_L(0); PG8_MMA(1, 0, At, B0); PG8_BAR; PG8_SCHED;
            PG8_STAGE(PG8_SB(1, 1), b3 + hstep, voffB);
            PG8_WAIT_V(6); PG8_BAR; PG8_MMA(1, 1, At, B1); PG8_BAR;
            }
        }
        if constexpr (ALIGN_EPI) { if (wr == 0) PG8_BAR; }
        if constexpr (!Epi::AFTER_DRAIN) { E(acc, cur, wr, wc, fr, fq); S.done(cur); }
        if (!has_next) break;
#pragma unroll
        for (int a = 0; a < 2; ++a)
#pragma unroll
            for (int b = 0; b < 2; ++b)
#pragma unroll
                for (int m = 0; m < 4; ++m)
#pragma unroll
                    for (int n = 0; n < 2; ++n) acc[a][b][m][n] = (f32x4){0.f, 0.f, 0.f, 0.f};
        cur = nxt; cA = nA; cB = nB; cAh = nAh; ++ui;
        if constexpr (ALIGN_EPI) { if (wr == 1) PG8_BAR; }
    }
    PG8_WAIT_V(0);
    if constexpr (!ALIGN_EPI) { if (wr == 0) PG8_BAR; }
    PG8_BAR;
    if constexpr (Epi::AFTER_DRAIN) { E.fused(acc, cur, wr, wc, fr, fq, lds, wid, lane); S.done(cur); }
#undef PG8_SA
#undef PG8_SB
#undef PG8_STAGE
#undef PG8_LDA
#undef PG8_LDB
#undef PG8_MMA
#undef PG8_WAIT_V
#undef PG8_WAIT_L
#undef PG8_BAR
#undef PG8_SCHED
}
}
#define GAS __attribute__((address_space(1)))
#define LAS __attribute__((address_space(3)))
typedef unsigned short bf16;
typedef unsigned v4u __attribute__((ext_vector_type(4)));
typedef float f32x4 __attribute__((ext_vector_type(4)));
constexpr int NWAVES = 8;
constexpr bool MFMA_ATTN[3] = {true, true, true};
constexpr bool LRU_MFMA = true;
constexpr bool XCDMODE = true;
constexpr bool CHAIN = true;
constexpr int PROBE_DUP_PRO = 1;
constexpr int PROBE_DUP_ATT = 1;
constexpr int PROBE_DUP_P3 = 1, PROBE_DUP_P4 = 1, PROBE_DUP_P5 = 1;
constexpr int PROBE_DUP_ATTN_ONLY[3] = {1, 1, 1};
constexpr int LDS_BYTES = 147456;
constexpr size_t MiB = 1u << 20;
constexpr size_t WS_CTL = 0, CTL_ZERO_BYTES = 1 * MiB;
constexpr size_t WS_MOD = 1 * MiB;
constexpr size_t WS_CS = 2 * MiB;
constexpr size_t WS_BIAS = 3 * MiB;
constexpr size_t BIAS_SLOT = 9 * 5632;
constexpr size_t WS_SSQ = 5 * MiB;
constexpr size_t WS_HC = 8 * MiB;
constexpr size_t WS_WT = 16 * MiB;
constexpr size_t WS_XS = 106 * MiB;
constexpr size_t WS_R = 142 * MiB;
constexpr size_t R3 = 36 * MiB;
constexpr size_t WS_HF = 250 * MiB;
constexpr size_t WS_LRU = 314 * MiB;
constexpr size_t WS_END = 346 * MiB;
constexpr size_t WO_QKV0 = 0, WO_WO0 = WO_QKV0 + 3072 * 1024, WO_QKV1 = WO_WO0 + 1024 * 1024, WO_WO1 = WO_QKV1 + 1536 * 1024, WO_QKV2 = WO_WO1 + 1024 * 1024,
                 WO_WO2 = WO_QKV2 + 1280 * 1024, WO_WIN3 = WO_WO2 + 1024 * 1024, WO_WOUT3 = WO_WIN3 + 2048 * 1024, WO_FIN = WO_WOUT3 + 1024 * 1024,
                 WO_FOUT = WO_FIN + 4 * (size_t)5632 * 1024, WO_END = WO_FOUT + 4 * (size_t)1024 * 2816;
static_assert(WO_END * 2 <= 90 * MiB, "weight region");

struct Args { const float* in[30]; float* out; unsigned char* ws; };

struct Frame {
    LAS unsigned char* lds; int vcu, G, wave0; int xm, xg, lidx;
    float* out; unsigned char* ws;
    float* MOD; float* CS; float* BIAS; float* SSQ; bf16* HC; bf16* HL; bf16* WT; bf16* XS; unsigned char* R; float* HF;
};
#define PHASE_IDS() const int tid = fresh_tid(F.wave0), lane = tid & 63, wave = __builtin_amdgcn_readfirstlane(tid >> 6); (void)tid; (void)lane; (void)wave
#define LDS_WAIT() asm volatile("s_waitcnt lgkmcnt(0)" ::: "memory")
__device__ __forceinline__ unsigned f2bf(float f) { unsigned u = __builtin_bit_cast(unsigned, f); return (u + 0x7fffu + ((u >> 16) & 1u)) >> 16; }
__device__ __forceinline__ unsigned pk2(float lo, float hi) { return f2bf(lo) | (f2bf(hi) << 16); }
__device__ __forceinline__ float bf_lo(unsigned w) { return __builtin_bit_cast(float, w << 16); }
__device__ __forceinline__ float bf_hi(unsigned w) { return __builtin_bit_cast(float, w & 0xffff0000u); }
__device__ __forceinline__ float wave_sum(float v, int lane) {
#pragma unroll
    for (int o = 1; o < 64; o <<= 1) v += pg8::bperm_f(lane ^ o, v);
    return v;
}
__device__ __forceinline__ float silu_f(float x) { return x / (1.0f + __expf(-x)); }

__device__ __forceinline__ int perm_row32(int perm, int n0) {
    if (perm == 1) { const int t = n0 >> 8, w = n0 & 255; return (t << 8) + (((w >> 5) & 1) << 7) + (((w >> 6) & 3) << 5); }
    if (perm == 2) { const int half = n0 >= FF ? 1 : 0; const int i = half ? n0 - FF : n0; return ((i >> 7) << 8) + (half << 7) + (i & 127); }
    return n0;
}
__device__ __forceinline__ void p0_transpose_item(const float* W, int K, int N, bf16* WT, int perm, LAS float* scr, int item, int lane) {
    const int nblk = N / 32, kb = item / nblk, nb = item % nblk, k0 = 64 * kb, n0 = 32 * nb;
    const int orow = perm_row32(perm, n0);
    float wv[32];
#pragma unroll
    for (int i = 0; i < 32; ++i) wv[i] = W[(size_t)(k0 + 2 * i + (lane >> 5)) * N + n0 + (lane & 31)];
#pragma unroll
    for (int i = 0; i < 32; ++i) scr[(2 * i + (lane >> 5)) * 33 + (lane & 31)] = wv[i];
    LDS_WAIT(); asm volatile("" ::: "memory");
    const int c = lane & 7;
#pragma unroll
    for (int j = 0; j < 4; ++j) { const int n = (lane >> 3) + 8 * j; const LAS float* s = scr + (8 * c) * 33 + n;
        v4u o; o.x = pk2(s[0 * 33], s[1 * 33]); o.y = pk2(s[2 * 33], s[3 * 33]); o.z = pk2(s[4 * 33], s[5 * 33]); o.w = pk2(s[6 * 33], s[7 * 33]);
        *(GAS v4u*)(WT + (size_t)(orow + n) * K + k0 + 8 * c) = o; }
    LDS_WAIT(); asm volatile("" ::: "memory");
}
struct WDesc { const float* W; bf16* WT; int K, N, perm; };
__device__ __forceinline__ WDesc wdesc(const Frame& F, const Args& A_, int i) {
    WDesc d;
    switch (i) {
    case 0: d = {A_.in[11], F.WT + WO_QKV0, 1024, 3072, 1}; break;
    case 1: d = {A_.in[13], F.WT + WO_WO0, 1024, 1024, 0}; break;
    case 2: d = {A_.in[14], F.WT + WO_QKV1, 1024, 1536, 1}; break;
    case 3: d = {A_.in[17], F.WT + WO_WO1, 1024, 1024, 0}; break;
    case 4: d = {A_.in[18], F.WT + WO_QKV2, 1024, 1280, 1}; break;
    case 5: d = {A_.in[20], F.WT + WO_WO2, 1024, 1024, 0}; break;
    case 6: d = {A_.in[21], F.WT + WO_WIN3, 1024, 2048, 1}; break;
    case 7: d = {A_.in[29], F.WT + WO_WOUT3, 1024, 1024, 0}; break;
    case 8: case 9: case 10: case 11: d = {A_.in[9] + (size_t)(i - 8) * 1024 * 5632, F.WT + WO_FIN + (size_t)(i - 8) * 5632 * 1024, 1024, 5632, 2}; break;
    default: d = {A_.in[10] + (size_t)(i - 12) * 2816 * 1024, F.WT + WO_FOUT + (size_t)(i - 12) * 1024 * 2816, 2816, 1024, 0}; break;
    }
    return d;
}
__device__ __forceinline__ void p0a(Frame& F, const Args& A_) {
    PHASE_IDS();
    LAS float* sl = (LAS float*)F.lds;
    LAS float* red = (LAS float*)(F.lds + 40960);
#pragma unroll
    for (int j = 0; j < 5; ++j) { const int i4 = (tid + 512 * j) * 4;
        if (i4 < 9 * 1024) { const f32x4 v = i4 < 8192 ? *(const f32x4*)(A_.in[1] + i4) : *(const f32x4*)(A_.in[3] + (i4 - 8192));
            f32x4 o; o[0] = silu_f(v[0]); o[1] = silu_f(v[1]); o[2] = silu_f(v[2]); o[3] = silu_f(v[3]); *(LAS f32x4*)(sl + i4) = o; } }
    __syncthreads();
    for (int u = blockIdx.x; u < 4 * 64; u += F.G) {
        const int l = u >> 6, jb = u & 63; const int lc = lane < 48 ? lane : 47;
        const float* w = A_.in[4] + (size_t)l * 1024 * 6144 + jb * 96 + 2 * lc;
        float a0[9], a1[9];
#pragma unroll
        for (int r = 0; r < 9; ++r) { a0[r] = 0.f; a1[r] = 0.f; }
        const int kb = wave * 128;
#pragma unroll 16
        for (int k = 0; k < 128; ++k) { typedef float f32x2 __attribute__((ext_vector_type(2))); const f32x2 wv = __builtin_nontemporal_load((const f32x2*)(w + (size_t)(kb + k) * 6144));
#pragma unroll
            for (int r = 0; r < 9; ++r) { const float sv = sl[r * 1024 + kb + k]; a0[r] += sv * wv[0]; a1[r] += sv * wv[1]; } }
        if (lane < 48) {
#pragma unroll
            for (int r = 0; r < 9; ++r) { red[(wave * 9 + r) * 96 + 2 * lane] = a0[r]; red[(wave * 9 + r) * 96 + 2 * lane + 1] = a1[r]; } }
        __syncthreads();
        for (int i = tid; i < 9 * 96; i += 512) { const int r = i / 96, j = i % 96; float sm = 0.f;
#pragma unroll
            for (int wv = 0; wv < 8; ++wv) sm += red[(wv * 9 + r) * 96 + j];
            F.MOD[((size_t)l * 9 + r) * 6144 + jb * 96 + j] = sm + A_.in[5][(size_t)l * 6144 + jb * 96 + j]; }
        __syncthreads();
    }
    if (blockIdx.x < 16 && tid < 64) for (int i = blockIdx.x * 64 + tid; i < 64 * 16; i += 1024) { const int pos = i >> 4, j = i & 15; const float inv = 1.0f / powf(10000.0f, (float)(2 * j) / 32.0f); const float ang = (float)pos * inv;
        F.CS[2 * i] = cosf(ang); F.CS[2 * i + 1] = sinf(ang); }
    __syncthreads();
}
struct CItem { const float* src; bf16* dst; int N, K; };
__device__ __forceinline__ CItem citem(const Frame& F, const Args& A_, int gidx) {
    int i = 0, r = gidx;
#pragma unroll 1
    for (; i < 15; ++i) { const WDesc d = wdesc(F, A_, i); const int nit = (d.K / 64) * (d.N / 32); if (r < nit) break; r -= nit; }
    const WDesc d = wdesc(F, A_, i); const int nblk = d.N / 32, kb = r / nblk, nb = r % nblk, k0 = 64 * kb, n0 = 32 * nb;
    CItem c; c.src = d.W + (size_t)k0 * d.N + n0; c.dst = d.WT + (size_t)perm_row32(d.perm, n0) * d.K + k0; c.N = d.N; c.K = d.K; return c;
}
__device__ __forceinline__ void convert_all_weights(Frame& F, const Args& A_) {
    PHASE_IDS();
    LAS float* scr = (LAS float*)(F.lds + wave * 8704);
    constexpr int TOTAL = 1536 + 512 + 768 + 512 + 640 + 512 + 1024 + 512 + 4 * 2816 + 4 * 1408;
    const int gw = F.vcu * NWAVES + wave, NGW = F.G * NWAVES;
    if (gw >= TOTAL) return;
    CItem cur = citem(F, A_, gw);
    float wv[32];
#pragma unroll
    for (int i = 0; i < 32; ++i) wv[i] = __builtin_nontemporal_load(cur.src + (size_t)(2 * i + (lane >> 5)) * cur.N + (lane & 31));
#pragma unroll 1
    for (int g = gw; g < TOTAL; g += NGW) {
#pragma unroll
        for (int i = 0; i < 32; ++i) scr[(2 * i + (lane >> 5)) * 33 + (lane & 31)] = wv[i];
        const CItem me = cur;
        if (g + NGW < TOTAL) { cur = citem(F, A_, g + NGW);
#pragma unroll
            for (int i = 0; i < 32; ++i) wv[i] = __builtin_nontemporal_load(cur.src + (size_t)(2 * i + (lane >> 5)) * cur.N + (lane & 31)); }
        LDS_WAIT(); asm volatile("" ::: "memory");
        const int c = lane & 7;
#pragma unroll
        for (int j = 0; j < 4; ++j) { const int n = (lane >> 3) + 8 * j; const LAS float* sp = scr + (8 * c) * 33 + n;
            v4u o; o.x = pk2(sp[0 * 33], sp[1 * 33]); o.y = pk2(sp[2 * 33], sp[3 * 33]); o.z = pk2(sp[4 * 33], sp[5 * 33]); o.w = pk2(sp[6 * 33], sp[7 * 33]);
            *(GAS v4u*)(me.dst + (size_t)n * me.K + 8 * c) = o; }
        LDS_WAIT(); asm volatile("" ::: "memory");
    }
}

__device__ __forceinline__ void bias_layer(Frame& F, int l0, int l1, int rank, int count) {
    PHASE_IDS();
    typedef short bf16x8 __attribute__((ext_vector_type(8)));
    LAS unsigned short* shb = (LAS unsigned short*)F.lds;
    int ubase = 0;
#pragma unroll 1
    for (int gi = 2 * l0; gi < 2 * l1; ++gi) {
        const int layer = gi >> 1; const int g = (gi & 1) == 0 ? layer : 4 + layer, l = layer; const int N = g >= 4 ? 5632 : (g == 0 ? 3072 : g == 1 ? 1536 : g == 2 ? 1280 : 2048);
        const bf16* wt = F.WT + (g >= 4 ? WO_FIN + (size_t)l * 5632 * 1024 : (g == 0 ? WO_QKV0 : g == 1 ? WO_QKV1 : g == 2 ? WO_QKV2 : WO_WIN3));
        const int shoff = g >= 4 ? 3 * 1024 : 0; const int nun = N / 128;
        for (int uu = ubase + ((rank - ubase % count + count) % count); uu < ubase + nun; uu += count) {
            const int ch = uu - ubase;
            __syncthreads();
#pragma unroll
            for (int j = 0; j < 8; ++j) { const int i = tid + 512 * j; const int r = i >> 8, k4 = (i & 255) * 4; typedef unsigned u32x2_ __attribute__((ext_vector_type(2))); u32x2_ w = {0u, 0u};
                if (r < 9) { const f32x4 v = *(const f32x4*)(F.MOD + ((size_t)l * 9 + r) * 6144 + shoff + k4); w.x = pk2(v[0], v[1]); w.y = pk2(v[2], v[3]); }
                *(LAS u32x2_*)(shb + r * 1032 + k4) = w; }
            __syncthreads();
            const int n0 = ch * 128 + wave * 16; const bf16* wp = wt + (size_t)(n0 + (lane & 15)) * 1024 + 8 * (lane >> 4);
            f32x4 acc = {0.f, 0.f, 0.f, 0.f};
#pragma unroll 16
            for (int st = 0; st < 32; ++st) { const bf16x8 b = *(const bf16x8*)(wp + 32 * st); const bf16x8 a = *(const LAS bf16x8*)(shb + (lane & 15) * 1032 + 32 * st + 8 * (lane >> 4));
                acc = __builtin_amdgcn_mfma_f32_16x16x32_bf16(a, b, acc, 0, 0, 0); }
#pragma unroll
            for (int e = 0; e < 4; ++e) { const int r = 4 * (lane >> 4) + e; if (r < 9) F.BIAS[(size_t)g * BIAS_SLOT + (size_t)r * N + n0 + (lane & 15)] = acc[e]; }
        }
        ubase += nun;
    }
    __syncthreads();
}
__device__ __forceinline__ void p0b(Frame& F, const Args& A_) {
    bias_layer(F, 0, 4, (int)blockIdx.x, (int)F.G);
    PHASE_IDS();
    const int gw = F.vcu * NWAVES + wave, NGW = F.G * NWAVES;
    for (int row0 = gw; row0 < MT; row0 += 3 * NGW) {
        f32x4 v[3][4];
#pragma unroll
        for (int q = 0; q < 3; ++q) { const int row = row0 + q * NGW; if (row < MT) { const bool lat = row < ML; const float* src = lat ? A_.in[0] + (size_t)row * 1024 : A_.in[2] + (size_t)(row - ML) * 1024;
#pragma unroll
            for (int j = 0; j < 4; ++j) v[q][j] = *(const f32x4*)(src + 256 * j + 4 * lane); } }
#pragma unroll
        for (int q = 0; q < 3; ++q) { const int row = row0 + q * NGW; if (row < MT) { const bool lat = row < ML; const int rm = lat ? (row >> 11) : 8;
            const float* sc = F.MOD + (size_t)rm * 6144 + 1024; const float* ng = A_.in[6];
            float sq = 0.f;
#pragma unroll
            for (int j = 0; j < 4; ++j) { const int col = 256 * j + 4 * lane; const f32x4 x = v[q][j];
                sq += (x[0] * x[0] + x[1] * x[1]) + (x[2] * x[2] + x[3] * x[3]);
                const f32x4 o = x * (*(const f32x4*)(ng + col)) * (*(const f32x4*)(sc + col) + 1.0f);
                typedef unsigned u32x2 __attribute__((ext_vector_type(2))); u32x2 w; w.x = pk2(o[0], o[1]); w.y = pk2(o[2], o[3]); *(u32x2*)(F.XS + (size_t)row * 1024 + col) = w; }
            sq = wave_sum(sq, lane);
            if (lane < 4) F.SSQ[(size_t)row * 4 + lane] = lane == 0 ? sq : 0.f; } }
    }
}
__device__ __forceinline__ void p_final(Frame& F, const Args& A_) {
    PHASE_IDS();
    const int gw = F.vcu * NWAVES + wave, NGW = F.G * NWAVES;
    for (int row = gw; row < ML; row += NGW) {
        const float rs = pg8::row_rstd(F.SSQ, row); float* p = F.out + (size_t)row * 1024; const bf16* hp = F.HL + (size_t)row * 1024;
#pragma unroll
        for (int j = 0; j < 4; ++j) { const int col = 256 * j + 4 * lane; typedef unsigned u32x2_ __attribute__((ext_vector_type(2))); const u32x2_ w = *(const u32x2_*)(hp + col);
            const f32x4 hv = {bf_lo(w.x), __builtin_bit_cast(float, w.x & 0xffff0000u), bf_lo(w.y), __builtin_bit_cast(float, w.y & 0xffff0000u)};
            *(f32x4*)(p + col) = hv * rs * (*(const f32x4*)(A_.in[8] + col)); }
    }
}
namespace att {
typedef unsigned short bf16;
using bf16x8=__attribute__((ext_vector_type(8)))short;
using s16x4=__attribute__((ext_vector_type(4)))short;
using f32x16=__attribute__((ext_vector_type(16)))float;
using u32x4=__attribute__((ext_vector_type(4)))unsigned;
constexpr int D=64,NW=8,QBLK=32,QB=QBLK*NW,KVBLK=64,QP=1024;
__device__ __forceinline__ int crow(int r,int hi){return (r&3)+8*(r>>2)+4*hi;}
#define SBAR() __builtin_amdgcn_sched_barrier(0)
constexpr int NSLOT=3, SLOTB=8192;
constexpr int LDS_K=0, LDS_V=NSLOT*SLOTB, LDS_WS=2*NSLOT*SLOTB, LDS_OST=LDS_WS+NW*64*4, LDS_BYTES=LDS_OST+NW*4096;
constexpr int LDS_RPB=86016;
struct Job { const bf16* Q; bf16* O; const bf16* Kc; const bf16* Vc; const bf16* Kl; const bf16* Vl; int NT; int lat; int qpos0; int kt0; int h; int wave0; const float* aux; };

__device__ __forceinline__ void glds16(const void*gsrc,unsigned lds_dst){unsigned keep;
  asm volatile("s_mov_b32 %0, m0\n\ts_mov_b32 m0, %2\n\ts_nop 0\n\tglobal_load_lds_dwordx4 %1, off\n\ts_mov_b32 m0, %0":"=&s"(keep):"v"(gsrc),"s"(lds_dst):"memory");}
__device__ __forceinline__ void glds16s(const void*sbase,unsigned voff,unsigned lds_dst){unsigned keep;
  asm volatile("s_nop 4\n\ts_mov_b32 %0, m0\n\ts_mov_b32 m0, %3\n\ts_nop 0\n\tglobal_load_lds_dwordx4 %1, %2\n\ts_mov_b32 m0, %0":"=&s"(keep):"v"(voff),"s"(sbase),"s"(lds_dst):"memory");}
__device__ __forceinline__ float max3f(float a,float b,float c){float r;asm("v_max3_f32 %0, %1, %2, %3":"=v"(r):"v"(a),"v"(b),"v"(c));return r;}
__device__ __forceinline__ float max2f(float a,float b){float r;asm("v_max_f32_e32 %0, %1, %2":"=v"(r):"v"(a),"v"(b));return r;}
__device__ __forceinline__ float fadd_s(float a,float b){float r;asm("v_add_f32_e32 %0, %1, %2":"=v"(r):"v"(a),"v"(b));return r;}
__device__ __forceinline__ float fsub_s(float a,float b){float r;asm("v_sub_f32_e32 %0, %1, %2":"=v"(r):"v"(a),"v"(b));return r;}
typedef float f32x2_t __attribute__((ext_vector_type(2))); typedef __bf16 bf16x2_t __attribute__((ext_vector_type(2)));
__device__ __forceinline__ unsigned cvtpk_s(float lo,float hi){f32x2_t v={lo,hi};bf16x2_t b=__builtin_convertvector(v,bf16x2_t);return __builtin_bit_cast(unsigned,b);}
#define WAIT_BAR(N) asm volatile("s_waitcnt vmcnt(" #N ") lgkmcnt(0)\n\ts_barrier":::"memory")
__device__ __forceinline__ void qkt(f32x16&p0,f32x16&p1,const char*Kslot,const bf16x8*qr,const f32x16&negm,int r32,int hi){
  const char*kb=Kslot+hi*1024+r32*16;
  #pragma unroll
  for(int d0=0;d0<4;++d0){
    const bf16x8 b0=*reinterpret_cast<const bf16x8*>(kb+d0*2048);
    const bf16x8 b1=*reinterpret_cast<const bf16x8*>(kb+d0*2048+512);
    if(d0==0){p0=__builtin_amdgcn_mfma_f32_32x32x16_bf16(b0,qr[0],negm,0,0,0);p1=__builtin_amdgcn_mfma_f32_32x32x16_bf16(b1,qr[0],negm,0,0,0);}
    else{p0=__builtin_amdgcn_mfma_f32_32x32x16_bf16(b0,qr[d0],p0,0,0,0);p1=__builtin_amdgcn_mfma_f32_32x32x16_bf16(b1,qr[d0],p1,0,0,0);}}
}
typedef __attribute__((address_space(3))) const char* lds_cptr;
typedef short v4i16_t __attribute__((ext_vector_type(4)));
__device__ __forceinline__ void kload8(bf16x8*kf,lds_cptr kp){
  kf[0]=*(const __attribute__((address_space(3))) bf16x8*)(kp);      kf[1]=*(const __attribute__((address_space(3))) bf16x8*)(kp+512);
  kf[2]=*(const __attribute__((address_space(3))) bf16x8*)(kp+2048); kf[3]=*(const __attribute__((address_space(3))) bf16x8*)(kp+2560);
  kf[4]=*(const __attribute__((address_space(3))) bf16x8*)(kp+4096); kf[5]=*(const __attribute__((address_space(3))) bf16x8*)(kp+4608);
  kf[6]=*(const __attribute__((address_space(3))) bf16x8*)(kp+6144); kf[7]=*(const __attribute__((address_space(3))) bf16x8*)(kp+6656);
}
__device__ __forceinline__ void kload2(bf16x8*kf,lds_cptr kp,int j){ kf[2*j]=*(const __attribute__((address_space(3))) bf16x8*)(kp+j*2048); kf[2*j+1]=*(const __attribute__((address_space(3))) bf16x8*)(kp+j*2048+512); }
__device__ __forceinline__ s16x4 vtr(lds_cptr p){ return __builtin_bit_cast(s16x4,__builtin_amdgcn_ds_read_tr16_b64_v4i16((__attribute__((address_space(3))) v4i16_t*)p)); }
__device__ __forceinline__ float rowmax(const f32x16&p0,const f32x16&p1){
  float a=max3f(p0[0],p0[1],p1[0]),b=max3f(p0[2],p0[3],p1[1]);a=max3f(a,p1[2],p1[3]);
  #pragma unroll
  for(int r=4;r<16;r+=4){a=max3f(a,p0[r],p0[r+1]);b=max3f(b,p0[r+2],p0[r+3]);a=max3f(a,p1[r],p1[r+1]);b=max3f(b,p1[r+2],p1[r+3]);}
  const float m=max2f(a,b);
  auto rr=__builtin_amdgcn_permlane32_swap(__float_as_uint(m),__float_as_uint(m),false,false);
  return max2f(__uint_as_float(rr[0]),__uint_as_float(rr[1]));
}
__device__ __forceinline__ void pv(f32x16*o,int vb,bf16x8 pa0,bf16x8 pa1,bf16x8 pa2,bf16x8 pa3){
  #pragma unroll
  for(int d0=0;d0<2;++d0){s16x4 lo[4],hi[4];
    #pragma unroll
    for(int ks=0;ks<4;++ks){
      asm volatile("ds_read_b64_tr_b16 %0,%1 offset:%c2":"=&v"(lo[ks]):"v"(vb),"i"(d0*4096+ks*1024):"memory");
      asm volatile("ds_read_b64_tr_b16 %0,%1 offset:%c2":"=&v"(hi[ks]):"v"(vb),"i"(d0*4096+ks*1024+512):"memory");}
    asm volatile("s_waitcnt lgkmcnt(0)":::"memory");SBAR();
    #define PK(k) (bf16x8){lo[k][0],lo[k][1],lo[k][2],lo[k][3],hi[k][0],hi[k][1],hi[k][2],hi[k][3]}
    o[d0]=__builtin_amdgcn_mfma_f32_32x32x16_bf16(pa0,PK(0),o[d0],0,0,0);
    o[d0]=__builtin_amdgcn_mfma_f32_32x32x16_bf16(pa1,PK(1),o[d0],0,0,0);
    o[d0]=__builtin_amdgcn_mfma_f32_32x32x16_bf16(pa2,PK(2),o[d0],0,0,0);
    o[d0]=__builtin_amdgcn_mfma_f32_32x32x16_bf16(pa3,PK(3),o[d0],0,0,0);
    #undef PK
  }
}
typedef __attribute__((address_space(3))) const float* lds_fptr;
__device__ __forceinline__ bf16 f2bf_(float f){ unsigned u=__builtin_bit_cast(unsigned,f); return (bf16)((u+0x7fffu+((u>>16)&1u))>>16); }
struct MaskCtx { int kt0, v0, v1, v2, v3, v4; lds_fptr rp; };
template<int KIND> __device__ __forceinline__ void mask_setup(MaskCtx&mc,const Job&J,char*shm,int tid,int wid,int r32,int hi){
  mc.kt0=J.kt0; mc.v0=mc.v1=mc.v2=mc.v3=0; mc.v4=wid&1; mc.rp=(lds_fptr)(shm+LDS_RPB);
  if constexpr(KIND==0){
    if(J.lat&&tid<465) ((__attribute__((address_space(3))) float*)(shm+LDS_RPB))[tid]=J.aux[tid]*1.4426950408889634f;
    const int rq=(J.qpos0>>6)+(wid>>1), qc=(wid&1)*32+r32; int r0=rq-4; r0=r0<0?0:(r0>24?24:r0); int cs=qc-8; cs=cs<0?0:(cs>48?48:cs);
    mc.v0=rq; mc.v1=qc; mc.v2=r0; mc.v3=cs;
  } else if constexpr(KIND==2){ mc.v0=J.qpos0+wid*32+r32; mc.v1=J.qpos0+wid*32; }
}
template<int KIND> __device__ __forceinline__ void mask_tile(f32x16&p0,f32x16&p1,int t,const MaskCtx&mc,int hi){
  const float NEG=-INFINITY;
  if constexpr(KIND==0){
    if(t<4)return;
    const int kr=mc.kt0+(t-4);
    if(kr<mc.v2||kr>=mc.v2+8){
      _Pragma("unroll") for(int r=0;r<16;++r){p0[r]=NEG;p1[r]=NEG;} return; }
    const lds_fptr T=mc.rp+(kr-mc.v0+7)*31; const int ib=15-mc.v1+4*hi, wb=4*hi-mc.v3;
    _Pragma("unroll") for(int r=0;r<16;++r){ const int c=(r&3)+8*(r>>2);
      if(mc.v4==0||r>=12){ const bool ok=(unsigned)(wb+c)<16u; const float bv=T[ok?ib+c:0]; p0[r]=ok?p0[r]+bv:NEG; } else p0[r]=NEG;
      if(mc.v4!=0||r<4){ const bool ok=(unsigned)(wb+c+32)<16u; const float bv=T[ok?ib+c+32:0]; p1[r]=ok?p1[r]+bv:NEG; } else p1[r]=NEG; }
  } else if constexpr(KIND==2){
    if(t<4)return;
    const int k0=64*(mc.kt0+t-4), dk=k0-mc.v1;
    if(dk>=-96&&dk<=64)return;
    if(dk<=-192||dk>=160){ _Pragma("unroll") for(int r=0;r<16;++r){p0[r]=NEG;p1[r]=NEG;} return; }
    const int dq=k0+4*hi-mc.v0+128;
    _Pragma("unroll") for(int r=0;r<16;++r){ const int c=(r&3)+8*(r>>2); if((unsigned)(dq+c)>256u)p0[r]=NEG; if((unsigned)(dq+c+32)>256u)p1[r]=NEG; }
  }
}
template<int KIND> __device__ __forceinline__ bool tile_dead(int t,const MaskCtx&mc){
  if constexpr(KIND==0){ if(t<4)return false; const int kr=mc.kt0+(t-4); return kr<mc.v2||kr>=mc.v2+8; }
  else if constexpr(KIND==2){ if(t<4)return false; const int dk=64*(mc.kt0+t-4)-mc.v1; return dk<=-192||dk>=160; }
  else return false;
}
#ifndef ATTN_STORE16
#define ATTN_STORE16(p,v) (*(u32x4*)(p)=(v))
#endif
template<int KIND,int THRL> __device__ __forceinline__ void attn_unit(const Job&J,char*shm){
  constexpr int LDK=KIND==0?1024:KIND==1?256:128;
  const int tid=fresh_tid(J.wave0),lane=tid&63,r32=lane&31,hi=lane>>5; const int wid=__builtin_amdgcn_readfirstlane(tid>>6);
  const bf16*Qw=J.Q+(long)(wid*QBLK)*QP;
  const unsigned lds0=(unsigned)(uintptr_t)shm;
  float*wsf=(float*)(shm+LDS_WS)+wid*64;
  const unsigned kvo=(unsigned)(wid*512+lane*8)*2u, vvo=(unsigned)((16*(wid&3)+(lane>>2))*LDK+(wid>>2)*32+(lane&3)*8)*2u;
  const unsigned kdst=lds0+LDS_K+wid*1024, vdst=lds0+LDS_V+wid*1024;
  #define DMA_K(t,slot) glds16s(((t)<4?J.Kc+(long)(t)*4096:J.Kl+(long)((t)-4)*4096),kvo,(unsigned)__builtin_amdgcn_readfirstlane(kdst+(slot)))
  #define DMA_V(t,slot) glds16s(((t)<4?J.Vc+(long)(t)*KVBLK*LDK:J.Vl+(long)((t)-4)*KVBLK*LDK),vvo,(unsigned)__builtin_amdgcn_readfirstlane(vdst+(slot)))
  const int vb0=(int)(lds0+LDS_V)+((lane>>4)&1)*32+(lane&3)*8+(4*hi+((lane&15)>>2))*64;
  const char*Kbase=shm+LDS_K; bf16x8 kf[8];
  const lds_cptr shm3=(lds_cptr)shm; const lds_cptr kp0=shm3+LDS_K+hi*1024+r32*16; const lds_cptr vp0=shm3+LDS_V+((lane>>4)&1)*32+(lane&3)*8+(4*hi+((lane&15)>>2))*64;
  const int NT=J.NT;
  MaskCtx mc; mask_setup<KIND>(mc,J,shm,tid,wid,r32,hi);
  DMA_K(0,0);DMA_V(0,0);DMA_K(1,SLOTB);
  bf16x8 qr[4];
  #pragma unroll
  for(int d0=0;d0<4;++d0)qr[d0]=*reinterpret_cast<const bf16x8*>(&Qw[(long)r32*QP+d0*16+hi*8]);
  float mhat=0.f,l_reg=0.f;f32x16 o[2];o[0]=f32x16{};o[1]=f32x16{};f32x16 negm=f32x16{};asm volatile("":"+v"(negm));
  #define CMASK(P0,P1,t) mask_tile<KIND>(P0,P1,(t),mc,hi)
  bool resc=false;
  #define START(P0,P1) do{ const float rm=rowmax(P0,P1); resc=false; \
    { const float dl=rm; mhat=fadd_s(mhat,dl); \
      _Pragma("unroll") for(int r=0;r<16;++r){P0[r]=fsub_s(P0[r],dl);P1[r]=fsub_s(P1[r],dl);} \
      _Pragma("unroll") for(int r=0;r<16;++r)negm[r]=-mhat; asm volatile("":"+v"(negm)); } \
    _Pragma("unroll") for(int r=0;r<16;++r)P0[r]=__builtin_amdgcn_exp2f(P0[r]); }while(0)
  #define RESC() do{ if(resc){ asm volatile("s_waitcnt lgkmcnt(0)":::"memory"); \
      _Pragma("unroll") for(int d_=0;d_<2;++d_) _Pragma("unroll") for(int r=0;r<16;++r)o[d_][r]*=wsf[crow(r,hi)]; } }while(0)
  f32x16 pA0,pA1,pB0,pB1;
  int sl_prev=0,sl_cur=0,sl_next=SLOTB;
  #define ROT() do{sl_prev=sl_cur;sl_cur=sl_next;sl_next=(sl_next==(NSLOT-1)*SLOTB)?0:sl_next+SLOTB;}while(0)
  DMA_K(2,2*SLOTB);
  WAIT_BAR(3);
  qkt(pA0,pA1,Kbase,qr,negm,r32,hi);asm volatile("s_nop 15\n\ts_nop 7":"+v"(pA0),"+v"(pA1));
  START(pA0,pA1);
  _Pragma("unroll") for(int r=0;r<16;++r)pA1[r]=__builtin_amdgcn_exp2f(pA1[r]);
  WAIT_BAR(0);
  DMA_K(3,0);DMA_V(1,SLOTB);
  ROT();
  kload8(kf,kp0+sl_cur);
  WAIT_BAR(2);
  s16x4 vlo[8],vhi[8]; u32x4 pw0,pw1,pw2,pw3;
  #define PKW(P,B) cvtpk_s(P[B],P[B+1])
  #define PAF(k) __builtin_bit_cast(bf16x8,pw##k)
  #define VFR(i) (bf16x8){vlo[i][0],vlo[i][1],vlo[i][2],vlo[i][3],vhi[i][0],vhi[i][1],vhi[i][2],vhi[i][3]}
  #define PIN(x) asm volatile("":"+v"(x))
  #define MX3(a,b,c) __builtin_fmaxf(__builtin_fmaxf((a),(b)),(c))
  #define GAPA(MF,A0,A1,A2,A3,W0,W1,PW) do{ MF; sacc+=A0; sacc+=A1; sacc+=A2; sacc+=A3; PIN(sacc); W0; W1; PIN(PW); SBAR(); }while(0)
  #define EX(v) __builtin_amdgcn_exp2f(v)
  #define GAPB(MF,X,B) do{ MF; X[B]=EX(X[B]); X[B+1]=EX(X[B+1]); X[B+2]=EX(X[B+2]); X[B+3]=EX(X[B+3]); PIN(X); SBAR(); }while(0)
  #define VRD(i) do{ vlo[i]=vtr(vp_+(((i)>>2)*4096+((i)&3)*1024)); vhi[i]=vtr(vp_+(((i)>>2)*4096+((i)&3)*1024+512)); }while(0)
  #define KRD(G,j) do{ if(G){ kload2(kf,kp0+sl_next,j); SBAR(); } }while(0)
  #define STEP(C0,C1,P0,P1,t,GK,GV,GL) do{ SBAR(); \
    if(KIND!=1&&tile_dead<KIND>((t),mc)&&tile_dead<KIND>((t)-1,mc)){   \
      if(GK){DMA_K((t)+3,sl_cur);} if(GV){DMA_V((t)+1,sl_next);} KRD(GL,0); KRD(GL,1); KRD(GL,2); KRD(GL,3); \
      _Pragma("unroll") for(int r_=0;r_<16;++r_){C0[r_]=0.f;C1[r_]=0.f;} resc=false; SBAR(); } else { \
    const lds_cptr vp_=vp0+sl_prev; \
    VRD(0); SBAR(); float sacc=(P0[0]+P0[1]); \
    GAPA(C0=__builtin_amdgcn_mfma_f32_32x32x16_bf16(kf[0],qr[0],negm,0,0,0), P0[2],P0[3],P0[4],P0[5],     pw0[0]=PKW(P0,0), pw0[1]=PKW(P0,2), pw0); \
    VRD(4); SBAR(); GAPA(C1=__builtin_amdgcn_mfma_f32_32x32x16_bf16(kf[1],qr[0],negm,0,0,0), P0[6],P0[7],P0[8],P0[9],     pw0[2]=PKW(P0,4), pw0[3]=PKW(P0,6), pw0); \
    VRD(1); SBAR(); GAPA(C0=__builtin_amdgcn_mfma_f32_32x32x16_bf16(kf[2],qr[1],C0,0,0,0),   P0[10],P0[11],P0[12],P0[13], pw1[0]=PKW(P0,8), pw1[1]=PKW(P0,10), pw1); \
    VRD(5); SBAR(); GAPA(C1=__builtin_amdgcn_mfma_f32_32x32x16_bf16(kf[3],qr[1],C1,0,0,0),   P0[14],P0[15],P1[0],P1[1],   pw1[2]=PKW(P0,12),pw1[3]=PKW(P0,14), pw1); \
    VRD(2); SBAR(); GAPA(C0=__builtin_amdgcn_mfma_f32_32x32x16_bf16(kf[4],qr[2],C0,0,0,0),   P1[2],P1[3],P1[4],P1[5],     pw2[0]=PKW(P1,0), pw2[1]=PKW(P1,2), pw2); \
    VRD(6); SBAR(); GAPA(C1=__builtin_amdgcn_mfma_f32_32x32x16_bf16(kf[5],qr[2],C1,0,0,0),   P1[6],P1[7],P1[8],P1[9],     pw2[2]=PKW(P1,4), pw2[3]=PKW(P1,6), pw2); \
    VRD(3); SBAR(); GAPA(C0=__builtin_amdgcn_mfma_f32_32x32x16_bf16(kf[6],qr[3],C0,0,0,0),   P1[10],P1[11],P1[12],P1[13], pw3[0]=PKW(P1,8), pw3[1]=PKW(P1,10), pw3); \
    VRD(7); SBAR(); GAPA(C1=__builtin_amdgcn_mfma_f32_32x32x16_bf16(kf[7],qr[3],C1,0,0,0),   P1[14],P1[15],0.f,0.f,       pw3[2]=PKW(P1,12),pw3[3]=PKW(P1,14), pw3); \
    l_reg+=sacc; \
    if(GK){DMA_K((t)+3,sl_cur);} if(GV){DMA_V((t)+1,sl_next);} \
    CMASK(C0,C1,t); \
    { float a=MX3(C0[0],C0[1],C1[0]),b=MX3(C0[2],C0[3],C1[1]); a=MX3(a,C1[2],C1[3]); \
      _Pragma("unroll") for(int r=4;r<16;r+=4){a=MX3(a,C0[r],C0[r+1]);b=MX3(b,C0[r+2],C0[r+3]);a=MX3(a,C1[r],C1[r+1]);b=MX3(b,C1[r+2],C1[r+3]);} \
      float rm=__builtin_fmaxf(a,b); { auto rr=__builtin_amdgcn_permlane32_swap(__float_as_uint(rm),__float_as_uint(rm),false,false); rm=__builtin_fmaxf(__uint_as_float(rr[0]),__uint_as_float(rr[1])); } \
      resc=false; \
      if(__builtin_expect(__any(rm>(float)THRL),0)){ const float dl=__builtin_fmaxf(rm,0.f); mhat+=dl; \
        _Pragma("unroll") for(int r=0;r<16;++r){C0[r]-=dl;C1[r]-=dl;} \
        _Pragma("unroll") for(int r=0;r<16;++r)negm[r]=-mhat; asm volatile("":"+v"(negm)); \
        const float f=__builtin_amdgcn_exp2f(-dl); l_reg*=f; if(hi==0)wsf[r32]=f; resc=true; } } \
    SBAR(); \
    GAPB(o[0]=__builtin_amdgcn_mfma_f32_32x32x16_bf16(PAF(0),VFR(0),o[0],0,0,0), C0,0); \
    GAPB(o[1]=__builtin_amdgcn_mfma_f32_32x32x16_bf16(PAF(0),VFR(4),o[1],0,0,0), C0,4); \
    KRD(GL,0); GAPB(o[0]=__builtin_amdgcn_mfma_f32_32x32x16_bf16(PAF(1),VFR(1),o[0],0,0,0), C0,8); \
    KRD(GL,1); GAPB(o[1]=__builtin_amdgcn_mfma_f32_32x32x16_bf16(PAF(1),VFR(5),o[1],0,0,0), C0,12); \
    KRD(GL,2); GAPB(o[0]=__builtin_amdgcn_mfma_f32_32x32x16_bf16(PAF(2),VFR(2),o[0],0,0,0), C1,0); \
    KRD(GL,3); GAPB(o[1]=__builtin_amdgcn_mfma_f32_32x32x16_bf16(PAF(2),VFR(6),o[1],0,0,0), C1,4); \
    GAPB(o[0]=__builtin_amdgcn_mfma_f32_32x32x16_bf16(PAF(3),VFR(3),o[0],0,0,0), C1,8); \
    GAPB(o[1]=__builtin_amdgcn_mfma_f32_32x32x16_bf16(PAF(3),VFR(7),o[1],0,0,0), C1,12); \
    } }while(0)
  int t=1;
  #undef CMASK
  #define CMASK(P0,P1,t) do{}while(0)
  if constexpr(KIND==1) for(;t+5<NT;t+=2){
    STEP(pB0,pB1,pA0,pA1,t,true,true,true);     WAIT_BAR(2); RESC(); ROT();
    STEP(pA0,pA1,pB0,pB1,t+1,true,true,true);   WAIT_BAR(2); RESC(); ROT();
  }
  #undef CMASK
  #define CMASK(P0,P1,t) mask_tile<KIND>(P0,P1,(t),mc,hi)
  #define ENDW(tt) do{ if((tt)+3<NT){WAIT_BAR(2);} else if((tt)+2<NT){WAIT_BAR(1);} else {WAIT_BAR(0);} }while(0)
  for(;t+1<NT;t+=2){
    STEP(pB0,pB1,pA0,pA1,t,(t+3<NT),(t+1<NT),(t+1<NT));       ENDW(t);   RESC(); ROT();
    STEP(pA0,pA1,pB0,pB1,t+1,(t+4<NT),(t+2<NT),(t+2<NT));     ENDW(t+1); RESC(); ROT();
  }
  STEP(pB0,pB1,pA0,pA1,NT-1,false,false,false); RESC();
  { float sacc=pB0[0]+pB0[1]; _Pragma("unroll") for(int r=2;r<16;++r)sacc+=pB0[r]; _Pragma("unroll") for(int r=0;r<16;++r)sacc+=pB1[r]; l_reg+=sacc;
    pw0=(u32x4){PKW(pB0,0),PKW(pB0,2),PKW(pB0,4),PKW(pB0,6)};pw1=(u32x4){PKW(pB0,8),PKW(pB0,10),PKW(pB0,12),PKW(pB0,14)};pw2=(u32x4){PKW(pB1,0),PKW(pB1,2),PKW(pB1,4),PKW(pB1,6)};pw3=(u32x4){PKW(pB1,8),PKW(pB1,10),PKW(pB1,12),PKW(pB1,14)};
    SBAR(); pv(o,vb0+sl_cur,PAF(0),PAF(1),PAF(2),PAF(3)); }
  #undef PKW
  #undef PAF
  #undef VFR
  #undef PIN
  #undef MX3
  #undef GAPA
  #undef GAPB
  #undef EX
  #undef VRD
  #undef KRD
  #undef STEP
  #undef ENDW
  {auto rr=__builtin_amdgcn_permlane32_swap(__float_as_uint(l_reg),__float_as_uint(l_reg),false,false);l_reg=__uint_as_float(rr[0])+__uint_as_float(rr[1]);}
  if constexpr(KIND==2) l_reg+=__builtin_amdgcn_exp2f(J.aux[0]*1.4426950408889634f-mhat);
  if(hi==0)wsf[32+r32]=l_reg;asm volatile("s_waitcnt lgkmcnt(0)":::"memory");
  float rli[16];
  #pragma unroll
  for(int r=0;r<16;++r)rli[r]=__builtin_amdgcn_rcpf(wsf[32+crow(r,hi)]);
  bf16*Ow=J.O+(long)(wid*QBLK)*QP;
  { bf16*stg=(bf16*)(shm+LDS_OST)+wid*2048;
    #pragma unroll
    for(int r=0;r<16;++r){const int orow=crow(r,hi);
      #pragma unroll
      for(int d0=0;d0<2;++d0)stg[orow*64+d0*32+r32]=(bf16)cvtpk_s(o[d0][r]*rli[r],0.f);}
    asm volatile("s_waitcnt lgkmcnt(0)":::"memory");
    #pragma unroll
    for(int i=0;i<4;++i){const int row=i*8+(lane>>3),ch=lane&7; const u32x4 v=*(const u32x4*)(stg+row*64+ch*8); ATTN_STORE16(Ow+(long)row*QP+ch*8,v);} }
  asm volatile("s_waitcnt lgkmcnt(0)\n\ts_barrier":::"memory");
  #undef DMA_K
  #undef DMA_V
  #undef CMASK
  #undef START
  #undef RESC
  #undef ROT
}
#undef SBAR
#undef WAIT_BAR
}
__device__ __forceinline__ void sb_arrive(Frame& F, int j);
template <int KIND> __device__ __forceinline__ void attn_phase(Frame& F, const Args& A_) {
    constexpr int ldk = KIND == 0 ? 1024 : KIND == 1 ? 256 : 128, gsz = KIND == 0 ? 1 : KIND == 1 ? 4 : 8;
    char* shm = (char*)F.lds;
#pragma unroll 1
    for (int it = 0; ; ++it) {
        int U;
        if (F.xm && it == 4) sb_arrive(F, 18 + 2 * KIND);
        if (F.xm) {
            if (it < 4) U = F.xg * 128 + 4 * F.lidx + it; else if (it == 4 && F.lidx < 16) U = 1024 + F.xg * 16 + F.lidx; else break;
        } else { const int rounds = (1024 + 4 * F.G - 1) / (4 * F.G); const int r = it >> 2;
          if (r < rounds) { U = 4 * F.vcu + (it & 3) + r * 4 * F.G; if (U >= 1024) continue; }
          else { U = 1024 + F.vcu + (it - 4 * rounds) * F.G; if (U >= 1152) break; } }
        const bool lat = U < 1024; const int bh = lat ? (U >> 3) : (U - 1024), qb = lat ? (U & 7) : 0, b = bh >> 4, h = bh & 15, kvh = h / gsz;
        int kt0 = 0, nlt = 0;
        if (lat) {
            if constexpr (KIND == 1) { kt0 = 0; nlt = 32; }
            else if constexpr (KIND == 2) { const int q0 = qb * 256; const int lo = q0 - 128 < 0 ? 0 : q0 - 128, hi_ = q0 + 383 > SEQ - 1 ? SEQ - 1 : q0 + 383; kt0 = lo >> 6; nlt = (hi_ >> 6) - kt0 + 1; }
            else { const int rf = qb * 4; int r0f = rf - 4; r0f = r0f < 0 ? 0 : (r0f > 24 ? 24 : r0f); int r0l = rf + 3 - 4; r0l = r0l < 0 ? 0 : (r0l > 24 ? 24 : r0l);
                kt0 = r0f; nlt = r0l + 8 - r0f; if (nlt & 1) { if (kt0 + nlt < 32) ++nlt; else { --kt0; ++nlt; } } }
        }
        const size_t qrow = lat ? (size_t)b * SEQ + qb * 256 : (size_t)ML + b * CTXL;
        att::Job J;
        unsigned char* Rb = F.R + (size_t)b * SLAB; const size_t lrow = lat ? (size_t)qb * 256 : (size_t)SEQ;
        J.Q = (bf16*)(Rb + SL_Q) + lrow * 1024 + h * 64; J.O = (bf16*)F.HF + qrow * 1024 + h * 64;
        J.Kc = (bf16*)(Rb + SL_K) + (size_t)(kvh * 36 + 32) * 4096; J.Vc = (bf16*)(Rb + SL_V) + (size_t)SEQ * ldk + kvh * 64;
        J.Kl = (bf16*)(Rb + SL_K) + (size_t)(kvh * 36 + kt0) * 4096; J.Vl = (bf16*)(Rb + SL_V) + (size_t)(kt0 * 64) * ldk + kvh * 64;
        J.NT = 4 + nlt; J.lat = lat ? 1 : 0; J.qpos0 = qb * 256; J.kt0 = kt0; J.h = h; J.wave0 = F.wave0;
        J.aux = KIND == 0 ? A_.in[12] + (size_t)h * 465 : (KIND == 2 ? A_.in[19] + h : nullptr);
        att::attn_unit<KIND, 8>(J, shm);
    }
    if (F.xm) sb_arrive(F, 19 + 2 * KIND);
}
constexpr size_t WS_WG = 2 * MiB + 65536;
constexpr size_t LRU_AGG_OFF = 0, LRU_HIN_OFF = 16 * MiB;
__device__ __forceinline__ void lru_wprep(Frame& F, const Args& A_) {
    PHASE_IDS();
    bf16* WG = (bf16*)(F.ws + WS_WG);
    for (int i = (F.vcu * NWAVES + wave) * 64 + lane; i < 16 * 4 * 64 * 64; i += F.G * NWAVES * 64) {
        const int d = i & 63, e = (i >> 6) & 63, s = (i >> 12) & 3, n = i >> 14; const int dir = s >> 1;
        const float* src = (s & 1) ? A_.in[26] : A_.in[24];
        WG[i] = (bf16)f2bf(src[((size_t)(dir * 16 + n) * 64 + d) * 64 + e]); }
}
struct LruSpan { int dir, isctx, T, tok0; size_t rowb; };
__device__ __forceinline__ LruSpan lru_span(int step) { LruSpan s; s.dir = step >= 9 ? 1 : 0; const int s9 = step - 9 * s.dir; s.isctx = s9 == 0 ? 1 : 0; const int sp = s.dir ? 8 - s9 : s9 - 1;
    s.T = s.isctx ? CTXL : SEQ; s.tok0 = s.isctx ? 0 : sp * 256; s.rowb = s.isctx ? (size_t)SEQ : (size_t)0; return s; }
__device__ __forceinline__ void lru_sweeps(Frame& F, const Args& A_) {
    PHASE_IDS();
    typedef short bf16x8 __attribute__((ext_vector_type(8))); typedef float f32x16 __attribute__((ext_vector_type(16)));
    const int r32 = lane & 31, hi = lane >> 5;
    LAS float* xcf = (LAS float*)F.lds;
    LAS unsigned short* xcb = (LAS unsigned short*)(F.lds + 36864);
    LAS unsigned short* glt = (LAS unsigned short*)(F.lds + 73728);
    LAS unsigned short* hft = (LAS unsigned short*)(F.lds + 94208);
    LAS unsigned short* wgt = (LAS unsigned short*)(F.lds + 114688);
    LAS float* agg = (LAS float*)(F.lds + 123904);
    const bf16* WG = (const bf16*)(F.ws + WS_WG);
    bf16* HFW = (bf16*)F.HF;
    const int cq = tid & 15, tg = tid >> 4;
    const int trow = tid >> 2, tq = tid & 3;
#pragma unroll 1
    for (int v = F.xm ? F.xg * 32 + F.lidx : F.vcu; v < 256; v += F.xm ? 256 : F.G) {
        const int b = v >> 5, n = (v >> 1) & 15, hf = v & 1;
        const int ch = 64 * n + 32 * hf + r32;
        const char* XRb = (const char*)(F.R + (size_t)b * SLAB + SL_XR) + (size_t)(64 * n) * 2; bf16* GL = (bf16*)(F.R + (size_t)b * SLAB + SL_GL) + 64 * n + 32 * hf;
        bf16* HFb = HFW + (size_t)b * SEQ * 1024 + 64 * n + 32 * hf;
        bf16* dummy = (bf16*)(F.ws + WS_HC + 4 * MiB) + ((size_t)v * 512 + tid) * 16;
        f32x4 cwv[4];
#pragma unroll
        for (int k = 0; k < 4; ++k) cwv[k] = *(const f32x4*)(A_.in[22] + k * 1024 + 64 * n + 4 * cq);
        const f32x4 cbv = *(const f32x4*)(A_.in[23] + 64 * n + 4 * cq);
        typedef unsigned u32x2 __attribute__((ext_vector_type(2))); u32x2 xin[11]; v4u gin[2], hin[2];
#define LRU_FETCH(sp_) do { \
        _Pragma("unroll") for (int i = 0; i < 11; ++i) { int tt = (sp_).tok0 + 8 * tg - 2 + i; if (i < 2) tt = tt < 0 ? 0 : tt; if (i == 10) tt = tt > (sp_).T - 1 ? (sp_).T - 1 : tt; \
            xin[i] = *(const u32x2*)(XRb + (unsigned)((((int)(sp_).rowb + tt) * 1024 + 4 * cq) * 2)); } \
        { const unsigned e_ = ((sp_).dir && !(sp_).isctx) ? (unsigned)(((sp_).tok0 + trow) * 1024 + 8 * tq) : 0u;     \
          const bf16* gp = GL + e_; gin[0] = *(const GAS v4u*)gp; gin[1] = *(const GAS v4u*)(gp + 128 * 1024); const bf16* hp = HFb + e_; hin[0] = *(const GAS v4u*)hp; hin[1] = *(const GAS v4u*)(hp + 128 * 1024); } } while (0)
        { const LruSpan s0 = lru_span(0); LRU_FETCH(s0); }
#pragma unroll 1
        for (int d = 0; d < 2; ++d) {
            float S = 0.f;
            if (d == 1) asm volatile("s_waitcnt vmcnt(0)" ::: "memory");
            const float nba = -LOG2E * A_.in[25][d * 1024 + ch], nbx = -LOG2E * A_.in[27][d * 1024 + ch]; const float sp = -8.0f * LOG2E * log1pf(expf(-A_.in[28][d * 1024 + ch]));
            { const int row = tid >> 3, pc = tid & 7, st_ = row >> 5, e = row & 31;
              *(LAS v4u*)(wgt + row * 72 + 8 * pc) = *(const GAS v4u*)(WG + ((size_t)((n * 4 + 2 * d + st_) * 64 + 32 * hf + e) * 64 + 8 * pc)); }
#pragma unroll 1
        for (int s9 = 0; s9 < 9; ++s9) {
            const int step = 9 * d + s9;
            const LruSpan cur = lru_span(step);
            f32x4 xf[11];
            { const u32x2 z = {0u, 0u}; const int t0 = cur.tok0 + 8 * tg; if (t0 - 2 < 0) xin[0] = z; if (t0 - 1 < 0) xin[1] = z; if (t0 + 8 >= cur.T) xin[10] = z; }
#pragma unroll
            for (int i = 0; i < 11; ++i) { xf[i][0] = bf_lo(xin[i].x); xf[i][1] = __builtin_bit_cast(float, xin[i].x & 0xffff0000u); xf[i][2] = bf_lo(xin[i].y); xf[i][3] = __builtin_bit_cast(float, xin[i].y & 0xffff0000u); }
#pragma unroll
            for (int j = 0; j < 8; ++j) { const int tok = 8 * tg + j; const f32x4 a = cbv + cwv[0] * xf[j] + cwv[1] * xf[j + 1] + cwv[2] * xf[j + 2] + cwv[3] * xf[j + 3];
                if ((cq >> 3) == hf) *(LAS f32x4*)(xcf + tok * 36 + 4 * (cq & 7)) = a;
                u32x2 w; w.x = att::cvtpk_s(a[0], a[1]); w.y = att::cvtpk_s(a[2], a[3]); *(LAS u32x2*)(xcb + tok * 72 + 4 * cq) = w; }
            if (cur.dir && !cur.isctx) { *(LAS v4u*)(glt + trow * 40 + 8 * tq) = gin[0]; *(LAS v4u*)(glt + (trow + 128) * 40 + 8 * tq) = gin[1];
                                         *(LAS v4u*)(hft + trow * 40 + 8 * tq) = hin[0]; *(LAS v4u*)(hft + (trow + 128) * 40 + 8 * tq) = hin[1]; }
            __syncthreads();
            { const LruSpan nx = lru_span(step + 1 < 18 ? step + 1 : 17); LRU_FETCH(nx); }
            bf16x8 Af[4];
#pragma unroll
            for (int ks = 0; ks < 4; ++ks) Af[ks] = *(const LAS bf16x8*)(xcb + (32 * wave + r32) * 72 + 16 * ks + 8 * hi);
            f32x16 acc[2];
#pragma unroll
            for (int s = 0; s < 2; ++s) { acc[s] = (f32x16){};
#pragma unroll
                for (int ks = 0; ks < 4; ++ks) acc[s] = __builtin_amdgcn_mfma_f32_32x32x16_bf16(Af[ks], *(const LAS bf16x8*)(wgt + (s * 32 + r32) * 72 + 16 * ks + 8 * hi), acc[s], 0, 0, 0); }
            float af[16], bv[16];
#pragma unroll
            for (int r = 0; r < 16; ++r) { const int tok = 32 * wave + (r & 3) + 8 * (r >> 2) + 4 * hi; const float xv = xcf[tok * 36 + r32];
                const float rg = __builtin_amdgcn_rcpf(1.0f + __builtin_amdgcn_exp2f(__builtin_fmaf(acc[0][r], -LOG2E, nba))), ig = __builtin_amdgcn_rcpf(1.0f + __builtin_amdgcn_exp2f(__builtin_fmaf(acc[1][r], -LOG2E, nbx)));
                const float a = __builtin_amdgcn_exp2f(sp * rg);
                af[r] = a; bv[r] = __builtin_amdgcn_sqrtf(1.0f - a * a) * (ig * xv); }
            float RA[4], RB[4], LA[4], UA[4], LB[4], UB[4], st[4], h[16];
            if (cur.dir == 0) {
#pragma unroll
                for (int j = 0; j < 4; ++j) { float A = 1.f, Bv = 0.f;
#pragma unroll
                    for (int i = 0; i < 4; ++i) { Bv = af[4 * j + i] * Bv + bv[4 * j + i]; A *= af[4 * j + i]; }
                    RA[j] = A; RB[j] = Bv; }
            } else {
#pragma unroll
                for (int j = 0; j < 4; ++j) { float A = 1.f, Bv = 0.f;
#pragma unroll
                    for (int i = 3; i >= 0; --i) { Bv = af[4 * j + i] * Bv + bv[4 * j + i]; A *= af[4 * j + i]; }
                    RA[j] = A; RB[j] = Bv; }
            }
#pragma unroll
            for (int j = 0; j < 4; ++j) { auto ra = __builtin_amdgcn_permlane32_swap(__float_as_uint(RA[j]), __float_as_uint(RA[j]), false, false); LA[j] = __uint_as_float(ra[0]); UA[j] = __uint_as_float(ra[1]);
                auto rb = __builtin_amdgcn_permlane32_swap(__float_as_uint(RB[j]), __float_as_uint(RB[j]), false, false); LB[j] = __uint_as_float(rb[0]); UB[j] = __uint_as_float(rb[1]); }
            { float s = 0.f, At = 1.f;
              if (cur.dir == 0) {
#pragma unroll
                  for (int j = 0; j < 4; ++j) { s = LA[j] * s + LB[j]; s = UA[j] * s + UB[j]; At *= LA[j] * UA[j]; }
              } else {
#pragma unroll
                  for (int j = 3; j >= 0; --j) { s = UA[j] * s + UB[j]; s = LA[j] * s + LB[j]; At *= LA[j] * UA[j]; }
              }
              if (hi == 0) { typedef float f32x2_ __attribute__((ext_vector_type(2))); f32x2_ w2; w2[0] = At; w2[1] = s; *(LAS f32x2_*)(agg + (wave * 32 + r32) * 2) = w2; } }
            __syncthreads();
            float mine = 0.f;
            { float s = S;
#pragma unroll
              for (int k = 0; k < 8; ++k) { const int w = cur.dir ? 7 - k : k; typedef float f32x2_ __attribute__((ext_vector_type(2))); const f32x2_ ab2 = *(const LAS f32x2_*)(agg + (w * 32 + r32) * 2);
                  mine = (w == wave) ? s : mine; s = ab2[0] * s + ab2[1]; }
              S = s; }
            if (cur.dir == 0) {
                { float s = mine;
#pragma unroll
                  for (int j = 0; j < 4; ++j) { const float slo = s; s = LA[j] * s + LB[j]; const float sup = s; s = UA[j] * s + UB[j]; st[j] = hi ? sup : slo; } }
#pragma unroll
                for (int j = 0; j < 4; ++j) { float hh = st[j];
#pragma unroll
                    for (int i = 0; i < 4; ++i) { hh = af[4 * j + i] * hh + bv[4 * j + i]; h[4 * j + i] = hh; } }
            } else {
                { float s = mine;
#pragma unroll
                  for (int j = 3; j >= 0; --j) { const float sup = s; s = UA[j] * s + UB[j]; const float slo = s; s = LA[j] * s + LB[j]; st[j] = hi ? sup : slo; } }
#pragma unroll
                for (int j = 0; j < 4; ++j) { float hh = st[j];
#pragma unroll
                    for (int i = 3; i >= 0; --i) { hh = af[4 * j + i] * hh + bv[4 * j + i]; h[4 * j + i] = hh; } }
            }
            if (!cur.isctx) {
                if (cur.dir == 0) {
#pragma unroll
                    for (int r = 0; r < 16; ++r) { const int tok = 32 * wave + (r & 3) + 8 * (r >> 2) + 4 * hi; hft[tok * 40 + r32] = (unsigned short)att::cvtpk_s(h[r], 0.f); }
                } else {
#pragma unroll
                    for (int r = 0; r < 16; ++r) { const int tok = 32 * wave + (r & 3) + 8 * (r >> 2) + 4 * hi;
                        const float gl = bf_lo((unsigned)glt[tok * 40 + r32]), hfv = bf_lo((unsigned)hft[tok * 40 + r32]); glt[tok * 40 + r32] = (unsigned short)att::cvtpk_s((hfv + h[r]) * gl, 0.f); }
                }
            }
            __syncthreads();
            { const unsigned e_ = (unsigned)((cur.tok0 + trow) * 1024 + 8 * tq); const LAS unsigned short* src = (cur.dir ? glt : hft) + trow * 40 + 8 * tq;
              bf16* op = cur.isctx ? dummy : (cur.dir == 0 ? HFb + e_ : GL + e_); *(GAS v4u*)op = *(const LAS v4u*)src; *(GAS v4u*)(op + (cur.isctx ? 8 : 128 * 1024)) = *(const LAS v4u*)(src + 128 * 40); }
        } }
#undef LRU_FETCH
    }
}

#define XB_TMO      128
#define XB_XCNT(j)  (256  + 64 * (j))
#define XB_XSUB(j)  (1280 + 64 * (j))
#define XB_XGEN(j)  (2304 + 64 * (j))
#define XB_TOP      3328
#define XB_TOPGEN   3392
#define XCD_BAR_WORDS 3456
#define XB_SPIN_CAP (1u << 18)

__device__ __forceinline__ unsigned xb_ld(unsigned* p)              { return __hip_atomic_load(p, __ATOMIC_RELAXED, __HIP_MEMORY_SCOPE_AGENT); }
__device__ __forceinline__ unsigned xb_add(unsigned* p, unsigned v) { return __hip_atomic_fetch_add(p, v, __ATOMIC_RELAXED, __HIP_MEMORY_SCOPE_AGENT); }
__device__ __forceinline__ unsigned xb_xcc_id() { return (unsigned)__builtin_amdgcn_s_getreg((3 << 11) | 20) & 0xFu; }
#define XB_SPIN(cond, bar) do { unsigned _sp = 0; while (cond) { __builtin_amdgcn_s_sleep(1); \
    if ((++_sp & 255u) == 0u) { if (xb_ld(&(bar)[XB_TMO])) break; if (_sp > XB_SPIN_CAP) { atomicAdd(&(bar)[XB_TMO], 1u); break; } } } } while (0)

struct XcdBarrier {
    unsigned* bar; unsigned x;
    volatile LAS unsigned* st;
};

__device__ __forceinline__ XcdBarrier xcd_barrier_post(unsigned* bar, volatile LAS unsigned* st) {
    XcdBarrier b; b.bar = bar; b.x = xb_xcc_id(); b.st = st;
    if (threadIdx.x == 0) (void)xb_add(&bar[XB_XCNT(b.x)], 1u);
    return b;
}
__device__ __forceinline__ void xcd_barrier_complete(unsigned* bar, unsigned x, unsigned& nloc, unsigned& nx) {
    const unsigned G = gridDim.x * gridDim.y * gridDim.z;
    unsigned sum, cnt, mine, sp = 0u;
    for (;;) {
        sum = 0u; cnt = 0u; mine = 0u;
#pragma unroll
        for (unsigned j = 0; j < 16; ++j) { const unsigned c = xb_ld(&bar[XB_XCNT(j)]); sum += c; cnt += (c > 0u) ? 1u : 0u; mine = (j == x) ? c : mine; }
        if (sum == G) break;
        __builtin_amdgcn_s_sleep(1);
        if ((++sp & 255u) == 0u) { if (xb_ld(&bar[XB_TMO])) break; if (sp > XB_SPIN_CAP) { atomicAdd(&bar[XB_TMO], 1u); break; } }
    }
    nloc = mine > 0u ? mine : 1u; nx = cnt > 0u ? cnt : 1u;
}

__device__ __forceinline__ void xcd_barrier(const XcdBarrier& b) {
    asm volatile("s_waitcnt vmcnt(0)" ::: "memory");
    __syncthreads();
    if (threadIdx.x == 0) {
        unsigned* bar = b.bar; unsigned bx = b.x; asm volatile("" : "+s"(bx), "+s"(bar));
        __builtin_amdgcn_s_waitcnt(0);
        unsigned nloc = b.st[0], nx = b.st[1];
        if (nloc == 0u) { xcd_barrier_complete(bar, bx, nloc, nx); b.st[0] = nloc; b.st[1] = nx; }
        const unsigned old = xb_add(&bar[XB_XSUB(bx)], 1u);
        const unsigned gen = old / nloc;
        if (old + 1u == (gen + 1u) * nloc) {
            __builtin_amdgcn_fence(__ATOMIC_RELEASE, "agent");
            asm volatile("s_waitcnt vmcnt(0)" ::: "memory");
            const unsigned og = xb_add(&bar[XB_TOP], 1u);
            const unsigned tg = og / nx;
            if (og + 1u == (tg + 1u) * nx) xb_add(&bar[XB_TOPGEN], 1u);
            else XB_SPIN(xb_ld(&bar[XB_TOPGEN]) == tg, bar);
            __builtin_amdgcn_fence(__ATOMIC_ACQUIRE, "agent");
            xb_add(&bar[XB_XGEN(bx)], 1u);
            asm volatile("s_waitcnt vmcnt(0)" ::: "memory");
        } else {
            XB_SPIN(xb_ld(&bar[XB_XGEN(bx)]) == gen, bar);
            __builtin_amdgcn_fence(__ATOMIC_ACQUIRE, "agent");
            asm volatile("s_waitcnt vmcnt(0)" ::: "memory");
        }
    }
    __syncthreads();
}

constexpr int MISC_OFF = 131072 + 320;
#define GSYNC() xcd_barrier(bar)
__device__ __forceinline__ void xl_barrier(Frame& F) {
    asm volatile("s_waitcnt vmcnt(0)" ::: "memory");
    __syncthreads();
    if (threadIdx.x == 0) { unsigned* cntw = (unsigned*)(F.ws + WS_CTL) + 56320 + 64 * F.xg; unsigned* relw = (unsigned*)(F.ws + WS_CTL) + 57344 + 64 * F.xg;
        __builtin_amdgcn_s_waitcnt(0);
        const unsigned old = __hip_atomic_fetch_add(cntw, 1u, __ATOMIC_RELAXED, __HIP_MEMORY_SCOPE_AGENT); const unsigned gen = old >> 5;
        if ((old & 31u) == 31u) __hip_atomic_fetch_add(relw, 1u, __ATOMIC_RELAXED, __HIP_MEMORY_SCOPE_AGENT);
        else { unsigned sp = 0; while (__hip_atomic_load(relw, __ATOMIC_RELAXED, __HIP_MEMORY_SCOPE_AGENT) <= gen) { __builtin_amdgcn_s_sleep(1); if (++sp > (1u << 22)) break; } }
        __builtin_amdgcn_fence(__ATOMIC_ACQUIRE, "agent"); asm volatile("s_waitcnt vmcnt(0)" ::: "memory"); }
    __syncthreads();
}
#define XSYNC() do { if (F.xm) xl_barrier(F); else xcd_barrier(bar); } while (0)

#define SB_XSUB(j, x) (((j) < 18 ? 32768 + (j) * 1152 : 98304 + ((j) - 18) * 1152) + 64 * (x))
#define SB_TOP(j)     SB_XSUB(j, 16)
__device__ __forceinline__ void sb_arrive(Frame& F, int j) {
    asm volatile("s_waitcnt vmcnt(0)" ::: "memory");
    __syncthreads();
    if (F.xm) { if (threadIdx.x == 0) { unsigned* ctl = (unsigned*)(F.ws + WS_CTL);
            const unsigned old = __hip_atomic_fetch_add(ctl + SB_XSUB(j, F.xg), 1u, __ATOMIC_RELAXED, __HIP_MEMORY_SCOPE_AGENT);
            if (old + 1u == 32u) __hip_atomic_store(ctl + SB_XSUB(j, F.xg + 8), 32u, __ATOMIC_RELAXED, __HIP_MEMORY_SCOPE_AGENT); }
        return; }
    if (threadIdx.x == 0) { unsigned* ctl = (unsigned*)(F.ws + WS_CTL); const unsigned x = xb_xcc_id(); const unsigned nloc = ((volatile LAS unsigned*)(F.lds + MISC_OFF))[0];
        const unsigned old = __hip_atomic_fetch_add(ctl + SB_XSUB(j, x), 1u, __ATOMIC_RELAXED, __HIP_MEMORY_SCOPE_AGENT);
        if (old + 1u == nloc) {
            __builtin_amdgcn_fence(__ATOMIC_RELEASE, "agent"); asm volatile("s_waitcnt vmcnt(0)" ::: "memory");
            __hip_atomic_fetch_add(ctl + SB_TOP(j), nloc, __ATOMIC_RELAXED, __HIP_MEMORY_SCOPE_AGENT); } }
}
__device__ __forceinline__ void sb_wait(Frame& F, int j) {
    if (threadIdx.x == 0) { unsigned* w = (unsigned*)(F.ws + WS_CTL) + (F.xm ? SB_XSUB(j, F.xg + 8) : SB_TOP(j)); unsigned sp = 0; const unsigned need = F.xm ? 32u : (unsigned)F.G;
        while (__hip_atomic_load(w, __ATOMIC_RELAXED, __HIP_MEMORY_SCOPE_AGENT) < need) { __builtin_amdgcn_s_sleep(20); if (++sp > (1u << 20)) break; }
        __builtin_amdgcn_fence(__ATOMIC_ACQUIRE, "agent"); asm volatile("s_waitcnt vmcnt(0)" ::: "memory"); }
    __syncthreads();
}

__device__ __forceinline__ LAS const float* rstd_table(Frame& F, int pm) {
    LAS float* tb = (LAS float*)(F.lds + 131072 + 1024); const int tid_ = fresh_tid(F.wave0);
#pragma unroll
    for (int t = 0; t < 2; ++t) { const int lane_ = tid_ & 63, w_ = tid_ >> 6; const int r = t * 128 + w_ * 16 + (lane_ & 15);
        const float rs = pg8::row_rstd_q(F.SSQ, pm * 256 + r, lane_ >> 4); if ((lane_ >> 4) == 0) tb[r] = rs; }
    __syncthreads(); return (LAS const float*)tb;
}
template <int L> __device__ __forceinline__ void p1_std(Frame& F, const Args& A_) {
    constexpr int N = L == 0 ? 3072 : L == 1 ? 1536 : L == 2 ? 1280 : 2048;
    const bf16* wt = F.WT + (L == 0 ? WO_QKV0 : L == 1 ? WO_QKV1 : L == 2 ? WO_QKV2 : WO_WIN3);
    pg8::Gemm g{F.XS, wt, MT, N, 1024, 0}; pg8::StaticOrder S; if (F.xm) S.init_x(MT, N, F.xg, F.lidx); else S.init(MT, N, F.G, (int)blockIdx.x);
    pg8::EpiProj<L> E{F.SSQ, F.BIAS + (size_t)L * BIAS_SLOT, N, F.R, L == 0 ? 16 : L == 1 ? 4 : 2, A_.in[15], A_.in[16], F.CS};
    pg8::gemm_phase<pg8::EpiProj<L>, pg8::StaticOrder, true, true>(F.lds, g, S, E, F.wave0);
}
template <int L> __device__ __forceinline__ void mixer(Frame& F, const Args& A_, const XcdBarrier& bar) {
    if constexpr (L < 3) attn_phase<L>(F, A_);
    else lru_sweeps(F, A_);
}
template <int L> __device__ __forceinline__ void tail_std(Frame& F, const Args& A_, const XcdBarrier& bar) {
    const float* mod = F.MOD + (size_t)L * 9 * 6144;
    constexpr int Mo = L == 3 ? ML : MT;
    {
        const bf16* A = L == 3 ? (const bf16*)(F.R + SL_GL) : (const bf16*)F.HF;
        const bf16* wt = F.WT + (L == 0 ? WO_WO0 : L == 1 ? WO_WO1 : L == 2 ? WO_WO2 : WO_WOUT3);
        pg8::Gemm g{A, wt, Mo, 1024, 1024, L == 3 ? SLAB : (size_t)0}; pg8::StaticOrder S; if (F.xm) S.init_x(Mo, 1024, F.xg, F.lidx); else S.init(Mo, 1024, F.G, (int)blockIdx.x);
        pg8::EpiResid<L == 0> E{F.HL, F.HC, mod + 2 * 1024, mod + 4 * 1024, A_.in[7] + L * 1024, F.XS, F.SSQ, L == 0 ? A_.in[0] : nullptr, L == 0 ? A_.in[2] : nullptr};
        E.ssl = (LAS float*)(F.lds + 131072 + 11264);
        pg8::gemm_phase<pg8::EpiResid<L == 0>, pg8::StaticOrder, true, true>(F.lds, g, S, E, F.wave0);
    }
    XSYNC();
    {
        pg8::Gemm g{F.XS, F.WT + WO_FIN + (size_t)L * 5632 * 1024, Mo, 5632, 1024, 0}; pg8::StaticOrder S; if (F.xm) S.init_x(Mo, 5632, F.xg, F.lidx); else S.init(Mo, 5632, F.G, (int)blockIdx.x);
        pg8::EpiSwiGLU E{F.SSQ, F.BIAS + (size_t)(4 + L) * BIAS_SLOT, F.R};
        { pg8::Unit u0; if (S.next(0, u0)) { E.rpm = u0.pm; E.rsl = rstd_table(F, u0.pm); } }
        pg8::gemm_phase<pg8::EpiSwiGLU, pg8::StaticOrder, true, true>(F.lds, g, S, E, F.wave0);
    }
    XSYNC();
    {
        pg8::Gemm g{(const bf16*)(F.R + SL_HM), F.WT + WO_FOUT + (size_t)L * 1024 * 2816, Mo, 1024, 2816, SLAB}; pg8::StaticOrder S; if (F.xm) S.init_x(Mo, 1024, F.xg, F.lidx); else S.init(Mo, 1024, F.G, (int)blockIdx.x);
        const float* modn = F.MOD + (size_t)(L + 1) * 9 * 6144;
        if constexpr (L == 3) { if (S.nwg == S.G) {
            pg8::EpiResidFinal EF{F.HL, F.out, mod + 5 * 1024, A_.in[8], (float*)(F.ws + WS_SSQ + 1 * MiB), (unsigned*)(F.ws + WS_CTL) + 61440};
            pg8::gemm_phase<pg8::EpiResidFinal, pg8::StaticOrder, false, true>(F.lds, g, S, EF, F.wave0);
            return; } }
        pg8::EpiResid<false> E{F.HL, F.HC, mod + 5 * 1024, L < 3 ? modn + 1024 : nullptr, A_.in[6] + (L < 3 ? (L + 1) * 1024 : 0), L < 3 ? F.XS : nullptr, F.SSQ};
        E.ssl = (LAS float*)(F.lds + 131072 + 11264);
        pg8::gemm_phase<pg8::EpiResid<false>, pg8::StaticOrder, true, true>(F.lds, g, S, E, F.wave0);
    }
    XSYNC();
    if constexpr (L == 3) p_final(F, A_);
}
template <int L> __device__ __forceinline__ void chain(Frame& F, const Args& A_, const XcdBarrier& bar) {
    const float* mod = F.MOD + (size_t)L * 9 * 6144;
    const int c = F.xm ? (F.lidx ^ 16) : (int)blockIdx.x, G = F.xm ? 32 : (int)F.G, J = 6 * L, H2 = G / 2;
    const int EA = 18 + 2 * L, EC = 19 + 2 * L;
    const int lp0 = F.xm ? 8 * F.xg : 0, lnM = F.xm ? 8 : 64, cp0 = F.xm ? 64 + F.xg : 64, cnM = F.xm ? 1 : 8, nr = F.xm;
    {
        const bf16* wt = F.WT + (L == 0 ? WO_WO0 : L == 1 ? WO_WO1 : WO_WO2);
        pg8::Gemm g{(const bf16*)F.HF, wt, MT, 1024, 1024, 0};
        pg8::EpiResid<L == 0> E{F.HL, F.HC, mod + 2 * 1024, mod + 4 * 1024, A_.in[7] + L * 1024, F.XS, F.SSQ, L == 0 ? A_.in[0] : nullptr, L == 0 ? A_.in[2] : nullptr};
        E.ssl = (LAS float*)(F.lds + 131072 + 11264);
        pg8::ListOrder Sl; Sl.init(lp0, lnM, 1024, G, c, 0, 0, nr);
        if (F.xm) sb_wait(F, EA);
        pg8::gemm_phase<pg8::EpiResid<L == 0>, pg8::ListOrder, true, true>(F.lds, g, Sl, E, F.wave0);
        sb_arrive(F, J + 0);
        pg8::ListOrder Sc; Sc.init(cp0, cnM, 1024, G, c, 0, 1, nr);
        if (F.xm && Sc.any()) sb_wait(F, EC);
        pg8::gemm_phase<pg8::EpiResid<L == 0>, pg8::ListOrder, true, true>(F.lds, g, Sc, E, F.wave0);
        sb_arrive(F, J + 1);
    }
    {
        pg8::Gemm g{F.XS, F.WT + WO_FIN + (size_t)L * 5632 * 1024, MT, 5632, 1024, 0};
        pg8::EpiSwiGLU E{F.SSQ, F.BIAS + (size_t)(4 + L) * BIAS_SLOT, F.R};
        pg8::ListOrder Sl; Sl.init(lp0, lnM, 5632, G, c, H2, 0, nr);
        sb_wait(F, J + 0);
        if (F.xm) sb_wait(F, EC);
        { pg8::Unit u0; if (Sl.next(0, u0)) { E.rpm = u0.pm; E.rsl = rstd_table(F, u0.pm); } }
        pg8::gemm_phase<pg8::EpiSwiGLU, pg8::ListOrder, true, true>(F.lds, g, Sl, E, F.wave0);
        sb_arrive(F, J + 2);
        pg8::ListOrder Sc; Sc.init(cp0, cnM, 5632, G, c, 0, 0, nr, F.xm ? 16 : -1);
        if (Sc.any()) sb_wait(F, J + 1);
        pg8::gemm_phase<pg8::EpiSwiGLU, pg8::ListOrder, true, true>(F.lds, g, Sc, E, F.wave0);
        sb_arrive(F, J + 3);
    }
    {
        pg8::Gemm g{(const bf16*)(F.R + SL_HM), F.WT + WO_FOUT + (size_t)L * 1024 * 2816, MT, 1024, 2816, SLAB};
        const float* modn = F.MOD + (size_t)(L + 1) * 9 * 6144;
        pg8::EpiResid<false> E{F.HL, F.HC, mod + 5 * 1024, modn + 1024, A_.in[6] + (L + 1) * 1024, F.XS, F.SSQ};
        E.ssl = (LAS float*)(F.lds + 131072 + 11264);
        pg8::ListOrder Sl; Sl.init(lp0, lnM, 1024, G, c, 0, 0, nr);
        sb_wait(F, J + 2);
        pg8::gemm_phase<pg8::EpiResid<false>, pg8::ListOrder, true, true>(F.lds, g, Sl, E, F.wave0);
        sb_arrive(F, J + 4);
        pg8::ListOrder Sc; Sc.init(cp0, cnM, 1024, G, c, F.xm ? 24 : (5 * G) / 16, 1, nr);
        if (Sc.any()) sb_wait(F, J + 3);
        pg8::gemm_phase<pg8::EpiResid<false>, pg8::ListOrder, true, true>(F.lds, g, Sc, E, F.wave0);
        sb_arrive(F, J + 5);
    }
    {
        constexpr int N = L == 0 ? 1536 : L == 1 ? 1280 : 2048;
        const bf16* wt = F.WT + (L == 0 ? WO_QKV1 : L == 1 ? WO_QKV2 : WO_WIN3);
        pg8::Gemm g{F.XS, wt, MT, N, 1024, 0};
        pg8::EpiProj<L + 1> E{F.SSQ, F.BIAS + (size_t)(L + 1) * BIAS_SLOT, N, F.R, L == 0 ? 4 : 2, A_.in[15], A_.in[16], F.CS};
        if constexpr (L < 2) {
            LAS float* tb = (LAS float*)(F.lds + 131072 + 2048); const int tid_ = fresh_tid(F.wave0);
            for (int i = tid_; i < 2048; i += 512) tb[i] = F.CS[i];
            if (tid_ < 64) { tb[2048 + tid_] = A_.in[15][tid_]; tb[2112 + tid_] = A_.in[16][tid_]; }
            __syncthreads(); E.tb = (LAS const float*)tb; }
        pg8::ListOrder Sl; if (L == 0 && F.xm) { const bool ex = c >= 8 && c < 16; Sl.init(lp0, lnM, ex ? 0 : N, 24, ex ? 0 : (c >= 16 ? c - 16 : c + 16), 0, 0, nr); }
        else Sl.init(lp0, lnM, N, G, c, F.xm ? (L == 1 ? 16 : 8) : 0, 0, nr);
        sb_wait(F, J + 4);
        { pg8::Unit u0; if (Sl.next(0, u0)) { E.rpm = u0.pm; E.rsl = rstd_table(F, u0.pm); } }
        pg8::gemm_phase<pg8::EpiProj<L + 1>, pg8::ListOrder, true, true>(F.lds, g, Sl, E, F.wave0);
        pg8::ListOrder Sc; Sc.init(cp0, cnM, N, G, c, F.xm ? (L >= 1 ? 8 : 24) : H2, (L >= 1 && F.xm) ? 1 : 0, nr);
        if (Sc.any()) sb_wait(F, J + 5);
        pg8::gemm_phase<pg8::EpiProj<L + 1>, pg8::ListOrder, true, true>(F.lds, g, Sc, E, F.wave0);
    }
    XSYNC();
}

__global__ void __launch_bounds__(NWAVES * 64, 2) fwd_kernel(Args args) {
    extern __shared__ __attribute__((aligned(16))) unsigned char lds[];
    Frame F;
    F.lds = (LAS unsigned char*)lds;
        F.wave0 = __builtin_amdgcn_readfirstlane(threadIdx.x >> 6);
    F.G = gridDim.x; { const int bx = blockIdx.x; F.vcu = (F.G % 8 == 0) ? (bx % 8) * (F.G / 8) + bx / 8 : bx; }
    F.out = args.out; F.ws = args.ws;
    F.MOD = (float*)(F.ws + WS_MOD); F.CS = (float*)(F.ws + WS_CS); F.BIAS = (float*)(F.ws + WS_BIAS); F.SSQ = (float*)(F.ws + WS_SSQ); F.HC = (bf16*)(F.ws + WS_HC); F.HL = (bf16*)(F.ws + WS_LRU);
    F.WT = (bf16*)(F.ws + WS_WT); F.XS = (bf16*)(F.ws + WS_XS); F.R = F.ws + WS_R; F.HF = (float*)(F.ws + WS_HF);
    if (threadIdx.x < 8) ((LAS unsigned*)(F.lds + MISC_OFF))[threadIdx.x] = 0u;
    __syncthreads();
    XcdBarrier bar; bar.bar = (unsigned*)(F.ws + WS_CTL) + 4096; bar.st = (volatile LAS unsigned*)(F.lds + MISC_OFF); bar.x = xb_xcc_id();
    if (threadIdx.x == 0) { const unsigned li = xb_add(&bar.bar[XB_XCNT(bar.x)], 1u); ((volatile LAS unsigned*)(F.lds + MISC_OFF))[3] = li; }
    __syncthreads();
    F.xg = (int)bar.x; F.lidx = __builtin_amdgcn_readfirstlane((int)((volatile LAS unsigned*)(F.lds + MISC_OFF))[3]); F.xm = 0;
    p0a(F, args); lru_wprep(F, args); convert_all_weights(F, args);
    GSYNC();
    if (XCDMODE) {
        if (threadIdx.x == 0) { unsigned ok = (F.G == 256) ? 1u : 0u;
            for (unsigned j = 0; j < 16; ++j) { const unsigned cj = xb_ld(&bar.bar[XB_XCNT(j)]); if (cj != (j < 8 ? 32u : 0u)) ok = 0u; }
            ((volatile LAS unsigned*)(F.lds + MISC_OFF))[4] = ok; }
        __syncthreads();
        F.xm = __builtin_amdgcn_readfirstlane((int)((volatile LAS unsigned*)(F.lds + MISC_OFF))[4]);
    }
    p0b(F, args); GSYNC();
    p1_std<0>(F, args); XSYNC(); mixer<0>(F, args, bar); if (!(CHAIN && F.xm)) XSYNC();
    if constexpr (CHAIN) { chain<0>(F, args, bar); } else { tail_std<0>(F, args, bar); p1_std<1>(F, args); XSYNC(); }
    mixer<1>(F, args, bar); if (!(CHAIN && F.xm)) XSYNC();
    if constexpr (CHAIN) { chain<1>(F, args, bar); } else { tail_std<1>(F, args, bar); p1_std<2>(F, args); XSYNC(); }
    mixer<2>(F, args, bar); if (!(CHAIN && F.xm)) XSYNC();
    if constexpr (CHAIN) { chain<2>(F, args, bar); } else { tail_std<2>(F, args, bar); p1_std<3>(F, args); XSYNC(); }
    mixer<3>(F, args, bar); XSYNC();
    tail_std<3>(F, args, bar);
}

extern "C" void kernel_launch(void* const* d_in, const int* in_sizes, int n_in, void* d_out, int out_size, void* d_ws, size_t ws_size, hipStream_t stream) {
    static int grid = 0;
    if (grid == 0) {
        if (n_in != 30 || out_size != ML * DM || ws_size < WS_END) { fprintf(stderr, "kernel_launch: unexpected shapes (n_in %d out %d ws %zu); nothing launched\n", n_in, out_size, ws_size); grid = -1; return; }
        int dev = 0, cus = 0, per_cu = 0;
        if (hipGetDevice(&dev) != hipSuccess || hipDeviceGetAttribute(&cus, hipDeviceAttributeMultiprocessorCount, dev) != hipSuccess) { grid = -1; return; }
        if (hipFuncSetAttribute((const void*)fwd_kernel, hipFuncAttributeMaxDynamicSharedMemorySize, LDS_BYTES) != hipSuccess) { fprintf(stderr, "kernel_launch: hipFuncSetAttribute failed\n"); grid = -1; return; }
        if (hipOccupancyMaxActiveBlocksPerMultiprocessor(&per_cu, (const void*)fwd_kernel, NWAVES * 64, LDS_BYTES) != hipSuccess || per_cu < 1) { fprintf(stderr, "kernel_launch: occupancy query says %d\n", per_cu); per_cu = 1; }
        (void)hipGetLastError();
        grid = cus * (per_cu > 1 ? 1 : per_cu);
    }
    if (grid < 0) return;
    if (hipMemsetAsync((char*)d_ws + WS_CTL, 0, CTL_ZERO_BYTES, stream) != hipSuccess) { fprintf(stderr, "kernel_launch: memset failed\n"); return; }
    Args a{};
    for (int i = 0; i < 30; ++i) a.in[i] = (const float*)d_in[i];
    a.out = (float*)d_out; a.ws = (unsigned char*)d_ws;
    void* kargs[] = {&a};
    const hipError_t e = hipLaunchCooperativeKernel((const void*)fwd_kernel, dim3(grid), dim3(NWAVES * 64), kargs, LDS_BYTES, stream);
    if (e != hipSuccess) fprintf(stderr, "kernel_launch: cooperative launch failed: %s (grid %d)\n", hipGetErrorString(e), grid);
}
```

```cpp
#include <hip/hip_runtime.h>
#include <cstdio>
#include <cstdint>

constexpr int DM = 1024, NB = 8, SEQ = 2048, CTXL = 256, HD = 64, FF = 2816, NMOD = 6;
constexpr int ML = NB * SEQ;
constexpr int MC = NB * CTXL;
constexpr int MT = ML + MC;
constexpr float LOG2E = 1.4426950408889634f;
constexpr float QSCALE = 0.125f * LOG2E;
constexpr size_t SLAB = 14155776;
constexpr size_t SL_Q = 0, SL_K = 4718592, SL_V = 9437184;
constexpr size_t SL_HM = 0;
constexpr size_t SL_XR = 0, SL_GL = 4718592;
__host__ __device__ __forceinline__ int pan_b(int pm) { return pm < 64 ? pm >> 3 : pm - 64; }
__host__ __device__ __forceinline__ int pan_p(int pm) { return pm < 64 ? pm & 7 : 8; }
__device__ __forceinline__ int fresh_tid(int wave0) { int l; asm volatile("v_mbcnt_lo_u32_b32 %0, -1, 0\n\tv_mbcnt_hi_u32_b32 %0, -1, %0" : "=v"(l)); return wave0 * 64 + l; }
namespace pg8 {
#define PG8_LAS __attribute__((address_space(3)))
typedef unsigned short bf16_t;
typedef short bf16x8 __attribute__((ext_vector_type(8)));
typedef float f32x4 __attribute__((ext_vector_type(4)));
typedef unsigned u32x4 __attribute__((ext_vector_type(4)));
constexpr int BM = 256, BK = 64, HALF = 128, HTB = HALF * BK * 2  , STAGE_BYTES = 8 * HTB, NXCD = 8, WGM = 8;

__host__ __device__ __forceinline__ int lds_byte(int r, int c) { const int st = (r >> 4) * 2 + (c >> 5), rr = r & 15, cc = c & 31, ob = rr * 64 + cc * 2; return st * 1024 + (ob ^ (((ob >> 9) & 1) << 5)); }
__host__ __device__ __forceinline__ void stage_rc(int b, int& R, int& C) { const int st = b / 1024, sb = b % 1024, swz = sb ^ (((sb >> 9) & 1) << 5); R = (st >> 1) * 16 + swz / 64; C = (st & 1) * 32 + (swz % 64) / 2; }
__host__ __device__ __forceinline__ int perm32(int rho) { const int n = rho >> 4, i = rho & 15; return 8 * (i >> 2) + 4 * n + (i & 3); }

struct Unit { int pm, pn, hm; };
struct Gemm { const bf16_t* A; const bf16_t* Bt; int M, N, K; size_t slab;
    __device__ __forceinline__ const char* abase(int pm, size_t tstep) const { return slab ? (const char*)A + (size_t)pan_b(pm) * slab + (size_t)pan_p(pm) * tstep : (const char*)A + (size_t)pm * tstep; } };

struct StaticOrder {
    int nM, nN, nwg, G, c, xm, xg;
    __host__ __device__ void init(int M, int N, int G_, int c_) { nM = M / BM; nN = N / BM; nwg = nM * nN; G = G_; c = c_; xm = 0; xg = 0; }
    __host__ __device__ void init_x(int M, int N, int x, int lidx) { nM = M / BM == 72 ? 9 : 8; nN = N / BM; nwg = nM * nN; G = 32; c = lidx; xm = 1; xg = x; }
    __host__ __device__ bool next(int i, Unit& u) const {
        const long L0 = (long)i * G + c; const int nfull = (nwg / G) * G, rem = nwg - nfull; const bool halves = rem > 0 && 2 * rem <= G;
        long L = L0; u.hm = -1;
        if (halves && L0 >= nfull) { const long t = L0 - nfull; if (t >= 2 * rem) return false; L = nfull + (t >> 1); u.hm = (int)(t & 1); }
        if (L >= nwg) return false;
        if (xm) { const int p = (int)L % nM; u.pn = (int)L / nM; u.pm = p < 8 ? 8 * xg + p : 64 + xg; return true; }
        int wgid = (int)L; { const int q = nwg / NXCD, r = nwg % NXCD, xcd = wgid % NXCD, off = wgid / NXCD; wgid = (xcd < r ? xcd * (q + 1) : r * (q + 1) + (xcd - r) * q) + off; }
        const int nig = WGM * nN, gid = wgid / nig, fm = gid * WGM, gsz = (nM - fm) < WGM ? (nM - fm) : WGM;
        u.pm = fm + ((wgid % nig) % gsz); u.pn = (wgid % nig) / gsz; return true;
    }
    __device__ __forceinline__ void a_ready(const Unit&) const {}
    __device__ __forceinline__ void done(const Unit&) const {}
};

__device__ __forceinline__ unsigned cvt_pk_bf16(float lo, float hi) { unsigned r; asm volatile("v_cvt_pk_bf16_f32 %0, %1, %2" : "=v"(r) : "v"(lo), "v"(hi)); return r; }
typedef float f32x2 __attribute__((ext_vector_type(2)));
struct ListOrder {
    int pm0, nM, nN, nwg, G, r, nfull, noremap;
    __host__ __device__ void init(int pm0_, int nM_, int N, int G_, int c_, int rot, int halves_, int noremap_ = 0, int nfull_ = -1) { pm0 = pm0_; nM = nM_; nN = N / BM; nwg = nM * nN; G = G_; r = (c_ + rot) % G_;
        nfull = nfull_ >= 0 ? nfull_ : (halves_ ? 0 : nwg); noremap = noremap_; }
    __host__ __device__ bool next(int i, Unit& u) const {
        long L = (long)i * G + r; u.hm = -1;
        if (L >= nfull) { const long t = L - nfull; if (t >= 2 * (nwg - nfull)) return false; u.hm = (int)(t & 1); L = nfull + (t >> 1); }
        if (L >= nwg) return false;
        if (noremap) { u.pm = pm0 + (int)L % nM; u.pn = (int)L / nM; return true; }
        int wgid = (int)L; { const int q = nwg / NXCD, rr = nwg % NXCD, xcd = wgid % NXCD, off = wgid / NXCD; wgid = (xcd < rr ? xcd * (q + 1) : rr * (q + 1) + (xcd - rr) * q) + off; }
        const int nig = WGM * nN, gid = wgid / nig, fm = gid * WGM, gsz = (nM - fm) < WGM ? (nM - fm) : WGM;
        u.pm = pm0 + fm + ((wgid % nig) % gsz); u.pn = (wgid % nig) / gsz; return true;
    }
    __host__ __device__ bool any() const { return r < nfull + 2 * (nwg - nfull); }
    __device__ __forceinline__ void a_ready(const Unit&) const {}
    __device__ __forceinline__ void done(const Unit&) const {}
};

__device__ __forceinline__ float bperm_f(int src_lane, float v) { return __builtin_bit_cast(float, __builtin_amdgcn_ds_bpermute(src_lane << 2, __builtin_bit_cast(int, v))); }
__device__ __forceinline__ int mod_row(int pm) { return pm < 64 ? (pm >> 3) : 8; }
__device__ __forceinline__ float row_rstd(const float* ssq, int row) {
    const f32x4 s = *(const f32x4*)(ssq + (size_t)row * 4);
    return rsqrtf(((s[0] + s[1]) + (s[2] + s[3])) * (1.0f / 1024.0f) + 1e-6f);
}
__device__ __forceinline__ float fq_sum(float t) {
    { auto r = __builtin_amdgcn_permlane16_swap(__float_as_uint(t), __float_as_uint(t), false, false); t = __uint_as_float(r[0]) + __uint_as_float(r[1]); }
    { auto r = __builtin_amdgcn_permlane32_swap(__float_as_uint(t), __float_as_uint(t), false, false); t = __uint_as_float(r[0]) + __uint_as_float(r[1]); }
    return t;
}
__device__ __forceinline__ float row_rstd_q(const float* ssq, int row, int fq) {
    (void)fq; const f32x4 p = *(const f32x4*)(ssq + (size_t)row * 4);
    const float t = (p[0] + p[1]) + (p[2] + p[3]);
    return rsqrtf(t * (1.0f / 1024.0f) + 1e-6f);
}
__device__ __forceinline__ void st_bf16x4(bf16_t* p, f32x4 v) { typedef unsigned u32x2 __attribute__((ext_vector_type(2))); u32x2 w; w.x = cvt_pk_bf16(v[0], v[1]); w.y = cvt_pk_bf16(v[2], v[3]); *(u32x2*)p = w; }
__device__ __forceinline__ void st_bf16x8_pair(bf16_t* p, f32x4 v0, f32x4 v1, int fq) {
    unsigned a0 = cvt_pk_bf16(v0[0], v0[1]), a1 = cvt_pk_bf16(v0[2], v0[3]), b0 = cvt_pk_bf16(v1[0], v1[1]), b1 = cvt_pk_bf16(v1[2], v1[3]);
    auto rx = __builtin_amdgcn_permlane16_swap(a0, b0, false, false); auto ry = __builtin_amdgcn_permlane16_swap(a1, b1, false, false);
    typedef unsigned u32x4_ __attribute__((ext_vector_type(4))); u32x4_ w; w.x = rx[0]; w.y = ry[0]; w.z = rx[1]; w.w = ry[1];
    *(u32x4_*)(p + (fq & 1) * 16 + (fq >> 1) * 8) = w;
}
__device__ __forceinline__ void ld_bf16x8_pair(const bf16_t* p, int fq, f32x4& v0, f32x4& v1) {
    typedef unsigned u32x4_ __attribute__((ext_vector_type(4))); const u32x4_ w = *(const u32x4_*)(p + (fq & 1) * 16 + (fq >> 1) * 8);
    auto rx = __builtin_amdgcn_permlane16_swap(w.x, w.z, false, false); auto ry = __builtin_amdgcn_permlane16_swap(w.y, w.w, false, false);
    v0[0] = __builtin_bit_cast(float, rx[0] << 16); v0[1] = __builtin_bit_cast(float, rx[0] & 0xffff0000u); v0[2] = __builtin_bit_cast(float, ry[0] << 16); v0[3] = __builtin_bit_cast(float, ry[0] & 0xffff0000u);
    v1[0] = __builtin_bit_cast(float, rx[1] << 16); v1[1] = __builtin_bit_cast(float, rx[1] & 0xffff0000u); v1[2] = __builtin_bit_cast(float, ry[1] << 16); v1[3] = __builtin_bit_cast(float, ry[1] & 0xffff0000u);
}
__device__ __forceinline__ float gelu_tanh(float x) { const float z = 0.7978845608028654f * (x + 0.044715f * x * x * x); const float t = 1.0f - 2.0f * __builtin_amdgcn_rcpf(__builtin_amdgcn_exp2f(2.8853900817779268f * z) + 1.0f); return 0.5f * x * (1.0f + t); }

template <int KIND>
struct EpiProj {
    static constexpr bool PERM = false, AFTER_DRAIN = false;
    const float* ssq; const float* bias; int N;
    unsigned char* R; int nk;
    const float* qgain; const float* kgain; const float* cs;
    PG8_LAS const float* rsl = nullptr; int rpm = -1;
    PG8_LAS const float* tb = nullptr;
    __device__ __forceinline__ void operator()(const f32x4 (&acc)[2][2][4][2], const Unit& u, int wr, int wc, int fr, int fq) const {
        asm volatile("" : "+v"(fr), "+v"(fq));
        const int rm = mod_row(u.pm); const bool lat = u.pm < 64;
        const int g = 4 * u.pn + wc;
        const int tcol = u.pn * BM + wc * 32 + 4 * fq;
        unsigned char* Rb = R + (size_t)pan_b(u.pm) * SLAB; const int lr0 = (pan_p(u.pm) - u.pm) * BM;
        f32x4 bv[2][2];
#pragma unroll
        for (int bj = 0; bj < 2; ++bj)
#pragma unroll
            for (int n = 0; n < 2; ++n) bv[bj][n] = *(const f32x4*)(bias + (size_t)rm * N + tcol + bj * HALF + n * 16);
        if constexpr (KIND == 3) {
#pragma unroll
            for (int ai = 0; ai < 2; ++ai) { if (ai > 0 && u.hm >= 0) continue;
                asm volatile("" ::: "memory"); float rsv[4];
                if (rsl != nullptr && u.pm == rpm) {
#pragma unroll
                    for (int m_ = 0; m_ < 4; ++m_) rsv[m_] = rsl[(u.hm > 0 ? HALF : 0) + ai * HALF + wr * 64 + m_ * 16 + fr];
                } else {
                rsv[0] = row_rstd_q(ssq, u.pm * BM + (u.hm > 0 ? HALF : 0) + ai * HALF + wr * 64 + 0 * 16 + fr, fq); rsv[1] = row_rstd_q(ssq, u.pm * BM + (u.hm > 0 ? HALF : 0) + ai * HALF + wr * 64 + 1 * 16 + fr, fq); asm volatile("" ::: "memory"); rsv[2] = row_rstd_q(ssq, u.pm * BM + (u.hm > 0 ? HALF : 0) + ai * HALF + wr * 64 + 2 * 16 + fr, fq); rsv[3] = row_rstd_q(ssq, u.pm * BM + (u.hm > 0 ? HALF : 0) + ai * HALF + wr * 64 + 3 * 16 + fr, fq);
                }
#pragma unroll
                for (int m = 0; m < 4; ++m) { const int row = u.pm * BM + (u.hm > 0 ? HALF : 0) + ai * HALF + wr * 64 + m * 16 + fr; const float rs = rsv[m];
#pragma unroll
                    for (int bj = 0; bj < 2; ++bj) { f32x4 v2[2];
#pragma unroll
                        for (int n = 0; n < 2; ++n) { const f32x4 v = acc[ai][bj][m][n] * rs + bv[bj][n];
                            if (g < 16) v2[n] = v; else { v2[n][0] = gelu_tanh(v[0]); v2[n][1] = gelu_tanh(v[1]); v2[n][2] = gelu_tanh(v[2]); v2[n][3] = gelu_tanh(v[3]); } }
                        st_bf16x8_pair((g < 16 ? (bf16_t*)(Rb + SL_XR) + g * 64 : (bf16_t*)(Rb + SL_GL) + (g - 16) * 64) + (size_t)(row + lr0) * 1024 + 32 * bj, v2[0], v2[1], fq); } } }
        } else {
            const int slot = g < 16 ? 0 : (g < 16 + nk ? 1 : 2);
            bf16_t* dst; int ld;
            if (slot == 0) { dst = (bf16_t*)(Rb + SL_Q) + g * 64; ld = 1024; } else if (slot == 1) { dst = (bf16_t*)(Rb + SL_K) + (g - 16) * 64; ld = 64 * nk; } else { dst = (bf16_t*)(Rb + SL_V) + (g - 16 - nk) * 64; ld = 64 * nk; }
            const float* gp_ = slot == 0 ? qgain : kgain;
            const float osc = slot == 0 ? QSCALE : 1.0f;
#pragma unroll
            for (int ai = 0; ai < 2; ++ai) { if (ai > 0 && u.hm >= 0) continue;
                asm volatile("" ::: "memory"); float rsv[4];
                if (rsl != nullptr && u.pm == rpm) {
#pragma unroll
                    for (int m_ = 0; m_ < 4; ++m_) rsv[m_] = rsl[(u.hm > 0 ? HALF : 0) + ai * HALF + wr * 64 + m_ * 16 + fr];
                } else {
                rsv[0] = row_rstd_q(ssq, u.pm * BM + (u.hm > 0 ? HALF : 0) + ai * HALF + wr * 64 + 0 * 16 + fr, fq); rsv[1] = row_rstd_q(ssq, u.pm * BM + (u.hm > 0 ? HALF : 0) + ai * HALF + wr * 64 + 1 * 16 + fr, fq); asm volatile("" ::: "memory"); rsv[2] = row_rstd_q(ssq, u.pm * BM + (u.hm > 0 ? HALF : 0) + ai * HALF + wr * 64 + 2 * 16 + fr, fq); rsv[3] = row_rstd_q(ssq, u.pm * BM + (u.hm > 0 ? HALF : 0) + ai * HALF + wr * 64 + 3 * 16 + fr, fq);
                }
#pragma unroll
                for (int m = 0; m < 4; ++m) { const int row = u.pm * BM + (u.hm > 0 ? HALF : 0) + ai * HALF + wr * 64 + m * 16 + fr; const float rs = rsv[m];
                    f32x4 v[2][2];
#pragma unroll
                    for (int bj = 0; bj < 2; ++bj)
#pragma unroll
                        for (int n = 0; n < 2; ++n) v[bj][n] = acc[ai][bj][m][n] * rs + bv[bj][n];
                    if constexpr (KIND == 1) { if (slot != 2) {
                        float s = 0.f;
#pragma unroll
                        for (int bj = 0; bj < 2; ++bj)
#pragma unroll
                            for (int n = 0; n < 2; ++n) { const f32x4 x = v[bj][n]; s += (x[0] * x[0] + x[1] * x[1]) + (x[2] * x[2] + x[3] * x[3]); }
                        s = fq_sum(s);
                        const float r = rsqrtf(s * (1.0f / 64.0f) + 1e-6f);
#pragma unroll
                        for (int bj = 0; bj < 2; ++bj)
#pragma unroll
                            for (int n = 0; n < 2; ++n) v[bj][n] = v[bj][n] * r * (*(const PG8_LAS f32x4*)(tb + (slot == 0 ? 2048 : 2112) + 32 * bj + 16 * n + 4 * fq)); } }
                    if constexpr (KIND == 1 || KIND == 2) { if (slot != 2 && lat) {
                        const int t = row & 2047;
#pragma unroll
                        for (int bj = 0; bj < 2; ++bj) { const int pos = bj == 0 ? (t >> 6) : (t & 63);
                            const f32x4 c01 = *(const PG8_LAS f32x4*)(tb + (pos * 16 + 4 * fq) * 2), c23 = *(const PG8_LAS f32x4*)(tb + (pos * 16 + 4 * fq) * 2 + 4);
                            const f32x4 co = {c01[0], c01[2], c23[0], c23[2]}, si = {c01[1], c01[3], c23[1], c23[3]};
                            const f32x4 x1 = v[bj][0], x2 = v[bj][1];
                            v[bj][0] = x1 * co - x2 * si; v[bj][1] = x1 * si + x2 * co; } } }
#pragma unroll
                    for (int bj = 0; bj < 2; ++bj) {
                        if (slot == 1) {
                            const int lrow = row + lr0, chunk = 4 * bj + 2 * (fq & 1) + (fq >> 1);
                            bf16_t* kp = (bf16_t*)(Rb + SL_K) + ((size_t)(((g - 16) * 36 + (lrow >> 6)) * 8 + chunk) * 64 + (lrow & 63)) * 8 - ((fq & 1) * 16 + (fq >> 1) * 8);
                            st_bf16x8_pair(kp, v[bj][0] * osc, v[bj][1] * osc, fq);
                        } else st_bf16x8_pair(dst + (size_t)(row + lr0) * ld + 32 * bj, v[bj][0] * osc, v[bj][1] * osc, fq); } } }
        }
    }
};

struct EpiSwiGLU {
    static constexpr bool PERM = false, AFTER_DRAIN = false;
    const float* ssq; const float* bias; unsigned char* R;
    PG8_LAS const float* rsl = nullptr; int rpm = -1;
    __device__ __forceinline__ void operator()(const f32x4 (&acc)[2][2][4][2], const Unit& u, int wr, int wc, int fr, int fq) const {
        asm volatile("" : "+v"(fr), "+v"(fq));
        const int rm = mod_row(u.pm); const int tcol = u.pn * BM + wc * 32 + 4 * fq;
        f32x4 bv[2][2];
#pragma unroll
        for (int bj = 0; bj < 2; ++bj)
#pragma unroll
            for (int n = 0; n < 2; ++n) bv[bj][n] = *(const f32x4*)(bias + (size_t)rm * (2 * FF) + tcol + bj * HALF + n * 16);
#pragma unroll
        for (int ai = 0; ai < 2; ++ai) { if (ai > 0 && u.hm >= 0) continue;
            asm volatile("" ::: "memory"); float rsv[4];
            if (rsl != nullptr && u.pm == rpm) {
#pragma unroll
                for (int m = 0; m < 4; ++m) rsv[m] = rsl[(u.hm > 0 ? HALF : 0) + ai * HALF + wr * 64 + m * 16 + fr];
            } else {
#pragma unroll
            for (int m = 0; m < 4; ++m) rsv[m] = row_rstd_q(ssq, u.pm * BM + (u.hm > 0 ? HALF : 0) + ai * HALF + wr * 64 + m * 16 + fr, fq); }
#pragma unroll
            for (int m = 0; m < 4; ++m) { const int row = u.pm * BM + (u.hm > 0 ? HALF : 0) + ai * HALF + wr * 64 + m * 16 + fr; const float rs = rsv[m];
                f32x4 o2[2];
#pragma unroll
                for (int n = 0; n < 2; ++n) { const f32x4 a = acc[ai][0][m][n] * rs + bv[0][n], gg = acc[ai][1][m][n] * rs + bv[1][n];
#pragma unroll
                    for (int e = 0; e < 4; ++e) o2[n][e] = a[e] * __builtin_amdgcn_rcpf(1.0f + __builtin_amdgcn_exp2f(-1.4426950408889634f * a[e])) * gg[e]; }
                st_bf16x8_pair((bf16_t*)(R + (size_t)pan_b(u.pm) * SLAB + SL_HM) + (size_t)(row + (pan_p(u.pm) - u.pm) * BM) * FF + u.pn * 128 + wc * 32, o2[0], o2[1], fq); } }
    }
};

template <bool F32IN>
struct EpiResid {
    static constexpr bool PERM = false, AFTER_DRAIN = false;
    bf16_t* Hl; bf16_t* Hc; const float* gate; const float* nsc; const float* ng; bf16_t* XS; float* ssq;
    const float* Rl = nullptr; const float* Rc = nullptr;
    PG8_LAS float* ssl = nullptr;
    __device__ __forceinline__ void operator()(const f32x4 (&acc)[2][2][4][2], const Unit& u, int wr, int wc, int fr, int fq) const {
        asm volatile("" : "+v"(fr), "+v"(fq));
        const int rm = mod_row(u.pm);
        bf16_t* Hb = u.pm < 64 ? Hl + (size_t)u.pm * BM * 1024 : Hc + (size_t)(u.pm - 64) * BM * 1024;
        const float* Rb = F32IN ? (u.pm < 64 ? Rl + (size_t)u.pm * BM * 1024 : Rc + (size_t)(u.pm - 64) * BM * 1024) : nullptr;
        const int col0 = u.pn * BM + wc * 32 + 4 * fq; const int cst = u.pn * BM + wc * 32;
        f32x4 gt[2][2], gs[2][2];
#pragma unroll
        for (int bj = 0; bj < 2; ++bj)
#pragma unroll
            for (int n = 0; n < 2; ++n) { const int col = col0 + bj * HALF + n * 16; gt[bj][n] = *(const f32x4*)(gate + (size_t)rm * 6144 + col);
                if (XS) gs[bj][n] = *(const f32x4*)(ng + col) * (*(const f32x4*)(nsc + (size_t)rm * 6144 + col) + 1.0f); else gs[bj][n] = (f32x4){0.f, 0.f, 0.f, 0.f}; }
#pragma unroll
        for (int ai = 0; ai < 2; ++ai) { if (ai > 0 && u.hm >= 0) continue;
#pragma unroll
          for (int mh = 0; mh < 2; ++mh) {
            asm volatile("" ::: "memory");
            const int rl0 = (u.hm > 0 ? HALF : 0) + ai * HALF + wr * 64 + mh * 32 + fr;
            f32x4 hv[2][2][2];
#pragma unroll
            for (int m = 0; m < 2; ++m)
#pragma unroll
                for (int bj = 0; bj < 2; ++bj) {
                    if constexpr (F32IN) {
#pragma unroll
                        for (int n = 0; n < 2; ++n) hv[m][bj][n] = __builtin_nontemporal_load((const f32x4*)(Rb + (size_t)(rl0 + m * 16) * 1024 + col0 + bj * HALF + n * 16));
                    } else ld_bf16x8_pair(Hb + (size_t)(rl0 + m * 16) * 1024 + cst + bj * HALF, fq, hv[m][bj][0], hv[m][bj][1]); }
            float ssv[2];
#pragma unroll
            for (int m = 0; m < 2; ++m) { const int rl = rl0 + m * 16; const int row = u.pm * BM + rl; float ss = 0.f;
#pragma unroll
                for (int bj = 0; bj < 2; ++bj) { f32x4 xo[2], ho[2];
#pragma unroll
                    for (int n = 0; n < 2; ++n) {
                        const f32x4 hn = hv[m][bj][n] + gt[bj][n] * acc[ai][bj][2 * mh + m][n]; ho[n] = hn;
                        ss += (hn[0] * hn[0] + hn[1] * hn[1]) + (hn[2] * hn[2] + hn[3] * hn[3]);
                        xo[n] = hn * gs[bj][n]; }
                    st_bf16x8_pair(Hb + (size_t)rl * 1024 + cst + bj * HALF, ho[0], ho[1], fq);
                    if (XS) st_bf16x8_pair(XS + (size_t)row * 1024 + cst + bj * HALF, xo[0], xo[1], fq); }
                ssv[m] = fq_sum(ss); }
            if (fq == 0) {
#pragma unroll
                for (int m = 0; m < 2; ++m) ssl[(wr * 4 + wc) * 128 + ai * 64 + mh * 32 + m * 16 + fr] = ssv[m]; } } }
        asm volatile("s_waitcnt lgkmcnt(0)" ::: "memory"); __builtin_amdgcn_s_barrier(); asm volatile("" ::: "memory");
        if (wc == 0) { const int lane_ = fq * 16 + fr;
#pragma unroll
            for (int t = 0; t < 2; ++t) { const int rr = lane_ + 64 * t;
                if (t == 0 || u.hm < 0) { const float tot = (ssl[(wr * 4 + 0) * 128 + rr] + ssl[(wr * 4 + 1) * 128 + rr]) + (ssl[(wr * 4 + 2) * 128 + rr] + ssl[(wr * 4 + 3) * 128 + rr]);
                    const int rl = (u.hm > 0 ? HALF : 0) + (rr >> 6) * HALF + wr * 64 + (rr & 63);
                    ssq[(size_t)(u.pm * BM + rl) * 4 + u.pn] = tot; } } }
    }
};

struct EpiResidFinal {
    static constexpr bool PERM = false, AFTER_DRAIN = true;
    const bf16_t* H; float* out; const float* gate; const float* gfin; float* ssqx; unsigned* cnt;
    __device__ __forceinline__ void fused(f32x4 (&acc)[2][2][4][2], const Unit& u, int wr, int wc, int fr, int fq, PG8_LAS unsigned char* lds, int wid, int lane) const {
        asm volatile("" : "+v"(fr), "+v"(fq));
        const int rm = mod_row(u.pm); const bf16_t* Hb = H + (size_t)u.pm * BM * 1024; const int col0 = u.pn * BM + wc * 32 + 4 * fq; const int cst = u.pn * BM + wc * 32;
        f32x4 gt[2][2];
#pragma unroll
        for (int bj = 0; bj < 2; ++bj)
#pragma unroll
            for (int n = 0; n < 2; ++n) gt[bj][n] = *(const f32x4*)(gate + (size_t)rm * 6144 + col0 + bj * HALF + n * 16);
#pragma unroll
        for (int ai = 0; ai < 2; ++ai)
#pragma unroll
            for (int mh = 0; mh < 2; ++mh) { asm volatile("" ::: "memory");
                const int rl0 = ai * HALF + wr * 64 + mh * 32 + fr; f32x4 hv[2][2][2];
#pragma unroll
                for (int m = 0; m < 2; ++m)
#pragma unroll
                    for (int bj = 0; bj < 2; ++bj) ld_bf16x8_pair(Hb + (size_t)(rl0 + m * 16) * 1024 + cst + bj * HALF, fq, hv[m][bj][0], hv[m][bj][1]);
#pragma unroll
                for (int m = 0; m < 2; ++m) { float ss = 0.f;
#pragma unroll
                    for (int bj = 0; bj < 2; ++bj)
#pragma unroll
                        for (int n = 0; n < 2; ++n) { const f32x4 hn = hv[m][bj][n] + gt[bj][n] * acc[ai][bj][2 * mh + m][n]; acc[ai][bj][2 * mh + m][n] = hn;
                            ss += (hn[0] * hn[0] + hn[1] * hn[1]) + (hn[2] * hn[2] + hn[3] * hn[3]); }
                    ss = fq_sum(ss);
                    if (fq == 0) __hip_atomic_store(ssqx + (size_t)(u.pm * BM + rl0 + m * 16) * 16 + 4 * u.pn + wc, ss, __ATOMIC_RELAXED, __HIP_MEMORY_SCOPE_AGENT); } }
        asm volatile("s_waitcnt vmcnt(0)" ::: "memory");
        if (lane == 0) __hip_atomic_fetch_add(cnt + 64 * u.pm, 1u, __ATOMIC_RELAXED, __HIP_MEMORY_SCOPE_AGENT);
        if (wid == 0) { unsigned sp = 0;
            while ((unsigned)__builtin_amdgcn_readfirstlane(__hip_atomic_load(cnt + 64 * u.pm, __ATOMIC_RELAXED, __HIP_MEMORY_SCOPE_AGENT)) < 32u) { __builtin_amdgcn_s_sleep(2); if (++sp > (1u << 21)) break; }
            __builtin_amdgcn_fence(__ATOMIC_ACQUIRE, "agent"); asm volatile("s_waitcnt vmcnt(0)" ::: "memory"); }
        asm volatile("s_waitcnt lgkmcnt(0)" ::: "memory"); __builtin_amdgcn_s_barrier(); asm volatile("" ::: "memory");
        f32x4 gf[2][2];
#pragma unroll
        for (int bj = 0; bj < 2; ++bj)
#pragma unroll
            for (int n = 0; n < 2; ++n) gf[bj][n] = *(const f32x4*)(gfin + col0 + bj * HALF + n * 16);
#pragma unroll
        for (int ai = 0; ai < 2; ++ai) { asm volatile("" ::: "memory"); float rsv[4];
#pragma unroll
            for (int m = 0; m < 4; ++m) { const unsigned long long* sp8 = (const unsigned long long*)(ssqx + (size_t)(u.pm * BM + ai * HALF + wr * 64 + m * 16 + fr) * 16); float t = 0.f;
#pragma unroll
                for (int q = 0; q < 8; ++q) { const unsigned long long w = __hip_atomic_load(sp8 + q, __ATOMIC_RELAXED, __HIP_MEMORY_SCOPE_AGENT); t += __uint_as_float((unsigned)w) + __uint_as_float((unsigned)(w >> 32)); }
                rsv[m] = rsqrtf(t * (1.0f / 1024.0f) + 1e-6f); }
#pragma unroll
            for (int m = 0; m < 4; ++m) { const int row = u.pm * BM + ai * HALF + wr * 64 + m * 16 + fr;
#pragma unroll
                for (int bj = 0; bj < 2; ++bj)
#pragma unroll
                    for (int n = 0; n < 2; ++n) __builtin_nontemporal_store(acc[ai][bj][m][n] * rsv[m] * gf[bj][n], (f32x4*)(out + (size_t)row * 1024 + col0 + bj * HALF + n * 16)); } }
    }
    __device__ __forceinline__ void operator()(const f32x4 (&)[2][2][4][2], const Unit&, int, int, int, int) const {}
};

template <class Epi, class Sched, bool ALIGN_EPI = false, bool SP2 = false>
__device__ __forceinline__ void gemm_phase(PG8_LAS unsigned char* lds, const Gemm g, const Sched& S, const Epi& E, const int wave0) {
    const int tid = fresh_tid(wave0), wid = __builtin_amdgcn_readfirstlane(tid >> 6), lane = tid & 63, wr = wid >> 2, wc = wid & 3, fr = lane & 15, fq = lane >> 4;
    const int K = g.K, nt = K / BK;
    unsigned voffA[2], voffB[2];
#pragma unroll
    for (int i = 0; i < 2; ++i) { int R, C; stage_rc(tid * 16 + i * 8192, R, C); const int Rb = Epi::PERM ? ((R & ~31) + perm32(R & 31)) : R;
        voffA[i] = (unsigned)(R * K + C) * 2u; voffB[i] = (unsigned)(Rb * K + C) * 2u; }
    const size_t kstep = (size_t)(BK * 2);
    const size_t hstep = (size_t)HALF * K * 2;
    const size_t tstep = 2 * hstep;
    const unsigned ldsw = (unsigned)wid * 1024u;
    const int aoff = lds_byte(wr * 64 + fr, fq * 8), boff = lds_byte(wc * 32 + fr, fq * 8);
#define PG8_SA(b, h) (((b) * 2 + (h)) * HTB)
#define PG8_SB(b, h) ((4 + (b) * 2 + (h)) * HTB)
#define PG8_STAGE(bufoff, gbase, voff) do { _Pragma("unroll") for (int _i = 0; _i < 2; ++_i) \
        __builtin_amdgcn_global_load_lds((const unsigned*)((const char*)(gbase) + (voff)[_i]), (PG8_LAS unsigned*)(lds + (bufoff) + ldsw + _i * 8192), 16, 0, 0); } while (0)
#define PG8_LDA(dst, b, h) do { _Pragma("unroll") for (int m = 0; m < 4; ++m) _Pragma("unroll") for (int k = 0; k < 2; ++k) dst[m][k] = *(const PG8_LAS bf16x8*)(lds + PG8_SA(b, h) + aoff + m * 2048 + k * 1024); } while (0)
#define PG8_LDB(dst, b, h) do { _Pragma("unroll") for (int n = 0; n < 2; ++n) _Pragma("unroll") for (int k = 0; k < 2; ++k) dst[n][k] = *(const PG8_LAS bf16x8*)(lds + PG8_SB(b, h) + boff + n * 2048 + k * 1024); } while (0)
#define PG8_MMA(ai, bj, At, Bt) do { __builtin_amdgcn_s_setprio(1); _Pragma("unroll") for (int m = 0; m < 4; ++m) _Pragma("unroll") for (int n = 0; n < 2; ++n) _Pragma("unroll") for (int k = 0; k < 2; ++k) \
        acc[ai][bj][m][n] = __builtin_amdgcn_mfma_f32_16x16x32_bf16(Bt[n][k], At[m][k], acc[ai][bj][m][n], 0, 0, 0); __builtin_amdgcn_s_setprio(0); } while (0)
#define PG8_WAIT_V(n) asm volatile("s_waitcnt vmcnt(" #n ")" ::: "memory")
#define PG8_WAIT_L(n) asm volatile("s_waitcnt lgkmcnt(" #n ")" ::: "memory")
#define PG8_BAR __builtin_amdgcn_s_barrier()
#define PG8_SCHED __builtin_amdgcn_sched_barrier(0)
    Unit cur, nxt; int ui = 0;
    if (!S.next(0, cur)) return;
    f32x4 acc[2][2][4][2];
#pragma unroll
    for (int a = 0; a < 2; ++a)
#pragma unroll
        for (int b = 0; b < 2; ++b)
#pragma unroll
            for (int m = 0; m < 4; ++m)
#pragma unroll
                for (int n = 0; n < 2; ++n) acc[a][b][m][n] = (f32x4){0.f, 0.f, 0.f, 0.f};
    bf16x8 At[4][2], B0[2][2], B1[2][2];
    static_assert(SP2, "half units are wired into the SP2 loop only");
    const char* cA = g.abase(cur.pm, tstep) + (cur.hm > 0 ? hstep : 0); const char* cB = (const char*)g.Bt + (size_t)cur.pn * tstep;
    size_t cAh = cur.hm >= 0 ? 0 : hstep;
    S.a_ready(cur);
    if constexpr (SP2) {
        PG8_STAGE(PG8_SB(0, 0), cB, voffB); PG8_STAGE(PG8_SB(0, 1), cB + hstep, voffB); PG8_STAGE(PG8_SA(0, 0), cA, voffA); PG8_STAGE(PG8_SA(0, 1), cA + cAh, voffA);
        if (wr == 1) PG8_BAR;
        PG8_WAIT_V(2); PG8_BAR;
        PG8_STAGE(PG8_SB(1, 0), cB + kstep, voffB); PG8_STAGE(PG8_SA(1, 0), cA + kstep, voffA); PG8_STAGE(PG8_SB(1, 1), cB + hstep + kstep, voffB);
        PG8_WAIT_V(6); PG8_BAR;
    } else {
        PG8_STAGE(PG8_SB(0, 0), cB, voffB); PG8_STAGE(PG8_SA(0, 0), cA, voffA); PG8_STAGE(PG8_SB(0, 1), cB + hstep, voffB); PG8_STAGE(PG8_SA(0, 1), cA + hstep, voffA);
        if (wr == 1) PG8_BAR;
        PG8_WAIT_V(4); PG8_BAR;
        PG8_STAGE(PG8_SB(1, 0), cB + kstep, voffB); PG8_STAGE(PG8_SA(1, 0), cA + kstep, voffA); PG8_STAGE(PG8_SB(1, 1), cB + hstep + kstep, voffB);
        PG8_WAIT_V(6); PG8_BAR;
    }
    for (;;) {
        const bool has_next = S.next(ui + 1, nxt);
        const char* nA = has_next ? g.abase(nxt.pm, tstep) + (nxt.hm > 0 ? hstep : 0) : cA; const char* nB = has_next ? (const char*)g.Bt + (size_t)nxt.pn * tstep : cB;
        const size_t nAh = has_next ? (nxt.hm >= 0 ? 0 : hstep) : cAh; const bool cfull = cur.hm < 0;
        for (int t = 0; t < nt; t += 2) {
            const bool last = (t == nt - 2);
            int tq = t; asm volatile("" : "+s"(tq));
            const char* a1 = cA + (size_t)(tq + 1) * kstep;
            const char* a2 = last ? nA : cA + (size_t)(tq + 2) * kstep; const char* b2 = last ? nB : cB + (size_t)(tq + 2) * kstep;
            const char* a3 = a2 + kstep; const char* b3 = b2 + kstep;
            const size_t a2h = last ? nAh : cAh;
            if (last && has_next) S.a_ready(nxt);
            if constexpr (SP2) {
            PG8_LDB(B0, 0, 0); PG8_LDB(B1, 0, 1); PG8_SCHED; PG8_LDA(At, 0, 0); PG8_STAGE(PG8_SA(1, 1), a1 + cAh, voffA);
            PG8_WAIT_V(8); PG8_WAIT_L(0); PG8_BAR; PG8_MMA(0, 0, At, B0); PG8_MMA(0, 1, At, B1); PG8_BAR; PG8_SCHED;
            if (cfull) PG8_LDA(At, 0, 1); PG8_STAGE(PG8_SB(0, 0), b2, voffB); PG8_STAGE(PG8_SB(0, 1), b2 + hstep, voffB); PG8_STAGE(PG8_SA(0, 0), a2, voffA);
            PG8_WAIT_V(8); PG8_WAIT_L(0); PG8_BAR; if (cfull) { PG8_MMA(1, 0, At, B0); PG8_MMA(1, 1, At, B1); } PG8_BAR; PG8_SCHED;
            PG8_LDB(B0, 1, 0); PG8_LDB(B1, 1, 1); PG8_SCHED; PG8_LDA(At, 1, 0); PG8_STAGE(PG8_SA(0, 1), a2 + a2h, voffA);
            PG8_WAIT_V(8); PG8_WAIT_L(0); PG8_BAR; PG8_MMA(0, 0, At, B0); PG8_MMA(0, 1, At, B1); PG8_BAR; PG8_SCHED;
            if (cfull) PG8_LDA(At, 1, 1); PG8_STAGE(PG8_SB(1, 0), b3, voffB); PG8_STAGE(PG8_SB(1, 1), b3 + hstep, voffB); PG8_STAGE(PG8_SA(1, 0), a3, voffA);
            PG8_WAIT_V(8); PG8_WAIT_L(0); PG8_BAR; if (cfull) { PG8_MMA(1, 0, At, B0); PG8_MMA(1, 1, At, B1); } PG8_BAR; PG8_SCHED;
            } else {
            PG8_LDB(B0, 0, 0); PG8_SCHED; PG8_LDA(At, 0, 0); PG8_STAGE(PG8_SA(1, 1), a1 + hstep, voffA);
            PG8_WAIT_L(8); PG8_BAR; PG8_WAIT_L(0); PG8_MMA(0, 0, At, B0); PG8_BAR; PG8_SCHED;
            PG8_LDB(B1, 0, 1); PG8_STAGE(PG8_SB(0, 0), b2, voffB);
            PG8_BAR; PG8_WAIT_L(0); PG8_MMA(0, 1, At, B1); PG8_BAR;
            PG8_LDA(At, 0, 1); PG8_STAGE(PG8_SA(0, 0), a2, voffA);
            PG8_BAR; PG8_WAIT_L(0); PG8_MMA(1, 0, At, B0); PG8_BAR; PG8_SCHED;
            PG8_STAGE(PG8_SB(0, 1), b2 + hstep, voffB);
            PG8_WAIT_V(6); PG8_BAR; PG8_MMA(1, 1, At, B1); PG8_BAR;
            PG8_LDB(B0, 1, 0); PG8_SCHED; PG8_LDA(At, 1, 0); PG8_STAGE(PG8_SA(0, 1), a2 + hstep, voffA);
            PG8_WAIT_L(8); PG8_BAR; PG8_WAIT_L(0); PG8_MMA(0, 0, At, B0); PG8_BAR; PG8_SCHED;
            PG8_LDB(B1, 1, 1); PG8_STAGE(PG8_SB(1, 0), b3, voffB);
            PG8_BAR; PG8_WAIT_L(0); PG8_MMA(0, 1, At, B1); PG8_BAR;
            PG8_LDA(At, 1, 1); PG8_STAGE(PG8_SA(1, 0), a3, voffA);
            PG8_BAR; PG8_WAIT_L(0); PG8_MMA(1, 0, At, B0); PG8_BAR; PG8_SCHED;
            PG8_STAGE(PG8_SB(1, 1), b3 + hstep, voffB);
            PG8_WAIT_V(6); PG8_BAR; PG8_MMA(1, 1, At, B1); PG8_BAR;
            }
        }
        if constexpr (ALIGN_EPI) { if (wr == 0) PG8_BAR; }
        if constexpr (!Epi::AFTER_DRAIN) { E(acc, cur, wr, wc, fr, fq); S.done(cur); }
        if (!has_next) break;
#pragma unroll
        for (int a = 0; a < 2; ++a)
#pragma unroll
            for (int b = 0; b < 2; ++b)
#pragma unroll
                for (int m = 0; m < 4; ++m)
#pragma unroll
                    for (int n = 0; n < 2; ++n) acc[a][b][m][n] = (f32x4){0.f, 0.f, 0.f, 0.f};
        cur = nxt; cA = nA; cB = nB; cAh = nAh; ++ui;
        if constexpr (ALIGN_EPI) { if (wr == 1) PG8_BAR; }
    }
    PG8_WAIT_V(0);
    if constexpr (!ALIGN_EPI) { if (wr == 0) PG8_BAR; }
    PG8_BAR;
    if constexpr (Epi::AFTER_DRAIN) { E.fused(acc, cur, wr, wc, fr, fq, lds, wid, lane); S.done(cur); }
#undef PG8_SA
#undef PG8_SB
#undef PG8_STAGE
#undef PG8_LDA
#undef PG8_LDB
#undef PG8_MMA
#undef PG8_WAIT_V
#undef PG8_WAIT_L
#undef PG8_BAR
#undef PG8_SCHED
}
}
#define GAS __attribute__((address_space(1)))
#define LAS __attribute__((address_space(3)))
typedef unsigned short bf16;
typedef unsigned v4u __attribute__((ext_vector_type(4)));
typedef float f32x4 __attribute__((ext_vector_type(4)));
constexpr int NWAVES = 8;
constexpr bool MFMA_ATTN[3] = {true, true, true};
constexpr bool LRU_MFMA = true;
constexpr bool XCDMODE = true;
constexpr bool CHAIN = true;
constexpr int PROBE_DUP_PRO = 1;
constexpr int PROBE_DUP_ATT = 1;
constexpr int PROBE_DUP_P3 = 1, PROBE_DUP_P4 = 1, PROBE_DUP_P5 = 1;
constexpr int PROBE_DUP_ATTN_ONLY[3] = {1, 1, 1};
constexpr int LDS_BYTES = 147456;
constexpr size_t MiB = 1u << 20;
constexpr size_t WS_CTL = 0, CTL_ZERO_BYTES = 1 * MiB;
constexpr size_t WS_MOD = 1 * MiB;
constexpr size_t WS_CS = 2 * MiB;
constexpr size_t WS_BIAS = 3 * MiB;
constexpr size_t BIAS_SLOT = 9 * 5632;
constexpr size_t WS_SSQ = 5 * MiB;
constexpr size_t WS_HC = 8 * MiB;
constexpr size_t WS_WT = 16 * MiB;
constexpr size_t WS_XS = 106 * MiB;
constexpr size_t WS_R = 142 * MiB;
constexpr size_t R3 = 36 * MiB;
constexpr size_t WS_HF = 250 * MiB;
constexpr size_t WS_LRU = 314 * MiB;
constexpr size_t WS_END = 346 * MiB;
constexpr size_t WO_QKV0 = 0, WO_WO0 = WO_QKV0 + 3072 * 1024, WO_QKV1 = WO_WO0 + 1024 * 1024, WO_WO1 = WO_QKV1 + 1536 * 1024, WO_QKV2 = WO_WO1 + 1024 * 1024,
                 WO_WO2 = WO_QKV2 + 1280 * 1024, WO_WIN3 = WO_WO2 + 1024 * 1024, WO_WOUT3 = WO_WIN3 + 2048 * 1024, WO_FIN = WO_WOUT3 + 1024 * 1024,
                 WO_FOUT = WO_FIN + 4 * (size_t)5632 * 1024, WO_END = WO_FOUT + 4 * (size_t)1024 * 2816;
static_assert(WO_END * 2 <= 90 * MiB, "weight region");

struct Args { const float* in[30]; float* out; unsigned char* ws; };

struct Frame {
    LAS unsigned char* lds; int vcu, G, wave0; int xm, xg, lidx;
    float* out; unsigned char* ws;
    float* MOD; float* CS; float* BIAS; float* SSQ; bf16* HC; bf16* HL; bf16* WT; bf16* XS; unsigned char* R; float* HF;
};
#define PHASE_IDS() const int tid = fresh_tid(F.wave0), lane = tid & 63, wave = __builtin_amdgcn_readfirstlane(tid >> 6); (void)tid; (void)lane; (void)wave
#define LDS_WAIT() asm volatile("s_waitcnt lgkmcnt(0)" ::: "memory")
__device__ __forceinline__ unsigned f2bf(float f) { unsigned u = __builtin_bit_cast(unsigned, f); return (u + 0x7fffu + ((u >> 16) & 1u)) >> 16; }
__device__ __forceinline__ unsigned pk2(float lo, float hi) { return f2bf(lo) | (f2bf(hi) << 16); }
__device__ __forceinline__ float bf_lo(unsigned w) { return __builtin_bit_cast(float, w << 16); }
__device__ __forceinline__ float bf_hi(unsigned w) { return __builtin_bit_cast(float, w & 0xffff0000u); }
__device__ __forceinline__ float wave_sum(float v, int lane) {
#pragma unroll
    for (int o = 1; o < 64; o <<= 1) v += pg8::bperm_f(lane ^ o, v);
    return v;
}
__device__ __forceinline__ float silu_f(float x) { return x / (1.0f + __expf(-x)); }

__device__ __forceinline__ int perm_row32(int perm, int n0) {
    if (perm == 1) { const int t = n0 >> 8, w = n0 & 255; return (t << 8) + (((w >> 5) & 1) << 7) + (((w >> 6) & 3) << 5); }
    if (perm == 2) { const int half = n0 >= FF ? 1 : 0; const int i = half ? n0 - FF : n0; return ((i >> 7) << 8) + (half << 7) + (i & 127); }
    return n0;
}
__device__ __forceinline__ void p0_transpose_item(const float* W, int K, int N, bf16* WT, int perm, LAS float* scr, int item, int lane) {
    const int nblk = N / 32, kb = item / nblk, nb = item % nblk, k0 = 64 * kb, n0 = 32 * nb;
    const int orow = perm_row32(perm, n0);
    float wv[32];
#pragma unroll
    for (int i = 0; i < 32; ++i) wv[i] = W[(size_t)(k0 + 2 * i + (lane >> 5)) * N + n0 + (lane & 31)];
#pragma unroll
    for (int i = 0; i < 32; ++i) scr[(2 * i + (lane >> 5)) * 33 + (lane & 31)] = wv[i];
    LDS_WAIT(); asm volatile("" ::: "memory");
    const int c = lane & 7;
#pragma unroll
    for (int j = 0; j < 4; ++j) { const int n = (lane >> 3) + 8 * j; const LAS float* s = scr + (8 * c) * 33 + n;
        v4u o; o.x = pk2(s[0 * 33], s[1 * 33]); o.y = pk2(s[2 * 33], s[3 * 33]); o.z = pk2(s[4 * 33], s[5 * 33]); o.w = pk2(s[6 * 33], s[7 * 33]);
        *(GAS v4u*)(WT + (size_t)(orow + n) * K + k0 + 8 * c) = o; }
    LDS_WAIT(); asm volatile("" ::: "memory");
}
struct WDesc { const float* W; bf16* WT; int K, N, perm; };
__device__ __forceinline__ WDesc wdesc(const Frame& F, const Args& A_, int i) {
    WDesc d;
    switch (i) {
    case 0: d = {A_.in[11], F.WT + WO_QKV0, 1024, 3072, 1}; break;
    case 1: d = {A_.in[13], F.WT + WO_WO0, 1024, 1024, 0}; break;
    case 2: d = {A_.in[14], F.WT + WO_QKV1, 1024, 1536, 1}; break;
    case 3: d = {A_.in[17], F.WT + WO_WO1, 1024, 1024, 0}; break;
    case 4: d = {A_.in[18], F.WT + WO_QKV2, 1024, 1280, 1}; break;
    case 5: d = {A_.in[20], F.WT + WO_WO2, 1024, 1024, 0}; break;
    case 6: d = {A_.in[21], F.WT + WO_WIN3, 1024, 2048, 1}; break;
    case 7: d = {A_.in[29], F.WT + WO_WOUT3, 1024, 1024, 0}; break;
    case 8: case 9: case 10: case 11: d = {A_.in[9] + (size_t)(i - 8) * 1024 * 5632, F.WT + WO_FIN + (size_t)(i - 8) * 5632 * 1024, 1024, 5632, 2}; break;
    default: d = {A_.in[10] + (size_t)(i - 12) * 2816 * 1024, F.WT + WO_FOUT + (size_t)(i - 12) * 1024 * 2816, 2816, 1024, 0}; break;
    }
    return d;
}
__device__ __forceinline__ void p0a(Frame& F, const Args& A_) {
    PHASE_IDS();
    LAS float* sl = (LAS float*)F.lds;
    LAS float* red = (LAS float*)(F.lds + 40960);
#pragma unroll
    for (int j = 0; j < 5; ++j) { const int i4 = (tid + 512 * j) * 4;
        if (i4 < 9 * 1024) { const f32x4 v = i4 < 8192 ? *(const f32x4*)(A_.in[1] + i4) : *(const f32x4*)(A_.in[3] + (i4 - 8192));
            f32x4 o; o[0] = silu_f(v[0]); o[1] = silu_f(v[1]); o[2] = silu_f(v[2]); o[3] = silu_f(v[3]); *(LAS f32x4*)(sl + i4) = o; } }
    __syncthreads();
    for (int u = blockIdx.x; u < 4 * 64; u += F.G) {
        const int l = u >> 6, jb = u & 63; const int lc = lane < 48 ? lane : 47;
        const float* w = A_.in[4] + (size_t)l * 1024 * 6144 + jb * 96 + 2 * lc;
        float a0[9], a1[9];
#pragma unroll
        for (int r = 0; r < 9; ++r) { a0[r] = 0.f; a1[r] = 0.f; }
        const int kb = wave * 128;
#pragma unroll 16
        for (int k = 0; k < 128; ++k) { typedef float f32x2 __attribute__((ext_vector_type(2))); const f32x2 wv = __builtin_nontemporal_load((const f32x2*)(w + (size_t)(kb + k) * 6144));
#pragma unroll
            for (int r = 0; r < 9; ++r) { const float sv = sl[r * 1024 + kb + k]; a0[r] += sv * wv[0]; a1[r] += sv * wv[1]; } }
        if (lane < 48) {
#pragma unroll
            for (int r = 0; r < 9; ++r) { red[(wave * 9 + r) * 96 + 2 * lane] = a0[r]; red[(wave * 9 + r) * 96 + 2 * lane + 1] = a1[r]; } }
        __syncthreads();
        for (int i = tid; i < 9 * 96; i += 512) { const int r = i / 96, j = i % 96; float sm = 0.f;
#pragma unroll
            for (int wv = 0; wv < 8; ++wv) sm += red[(wv * 9 + r) * 96 + j];
            F.MOD[((size_t)l * 9 + r) * 6144 + jb * 96 + j] = sm + A_.in[5][(size_t)l * 6144 + jb * 96 + j]; }
        __syncthreads();
    }
    if (blockIdx.x < 16 && tid < 64) for (int i = blockIdx.x * 64 + tid; i < 64 * 16; i += 1024) { const int pos = i >> 4, j = i & 15; const float inv = 1.0f / powf(10000.0f, (float)(2 * j) / 32.0f); const float ang = (float)pos * inv;
        F.CS[2 * i] = cosf(ang); F.CS[2 * i + 1] = sinf(ang); }
    __syncthreads();
}
struct CItem { const float* src; bf16* dst; int N, K; };
__device__ __forceinline__ CItem citem(const Frame& F, const Args& A_, int gidx) {
    int i = 0, r = gidx;
#pragma unroll 1
    for (; i < 15; ++i) { const WDesc d = wdesc(F, A_, i); const int nit = (d.K / 64) * (d.N / 32); if (r < nit) break; r -= nit; }
    const WDesc d = wdesc(F, A_, i); const int nblk = d.N / 32, kb = r / nblk, nb = r % nblk, k0 = 64 * kb, n0 = 32 * nb;
    CItem c; c.src = d.W + (size_t)k0 * d.N + n0; c.dst = d.WT + (size_t)perm_row32(d.perm, n0) * d.K + k0; c.N = d.N; c.K = d.K; return c;
}
__device__ __forceinline__ void convert_all_weights(Frame& F, const Args& A_) {
    PHASE_IDS();
    LAS float* scr = (LAS float*)(F.lds + wave * 8704);
    constexpr int TOTAL = 1536 + 512 + 768 + 512 + 640 + 512 + 1024 + 512 + 4 * 2816 + 4 * 1408;
    const int gw = F.vcu * NWAVES + wave, NGW = F.G * NWAVES;
    if (gw >= TOTAL) return;
    CItem cur = citem(F, A_, gw);
    float wv[32];
#pragma unroll
    for (int i = 0; i < 32; ++i) wv[i] = __builtin_nontemporal_load(cur.src + (size_t)(2 * i + (lane >> 5)) * cur.N + (lane & 31));
#pragma unroll 1
    for (int g = gw; g < TOTAL; g += NGW) {
#pragma unroll
        for (int i = 0; i < 32; ++i) scr[(2 * i + (lane >> 5)) * 33 + (lane & 31)] = wv[i];
        const CItem me = cur;
        if (g + NGW < TOTAL) { cur = citem(F, A_, g + NGW);
#pragma unroll
            for (int i = 0; i < 32; ++i) wv[i] = __builtin_nontemporal_load(cur.src + (size_t)(2 * i + (lane >> 5)) * cur.N + (lane & 31)); }
        LDS_WAIT(); asm volatile("" ::: "memory");
        const int c = lane & 7;
#pragma unroll
        for (int j = 0; j < 4; ++j) { const int n = (lane >> 3) + 8 * j; const LAS float* sp = scr + (8 * c) * 33 + n;
            v4u o; o.x = pk2(sp[0 * 33], sp[1 * 33]); o.y = pk2(sp[2 * 33], sp[3 * 33]); o.z = pk2(sp[4 * 33], sp[5 * 33]); o.w = pk2(sp[6 * 33], sp[7 * 33]);
            *(GAS v4u*)(me.dst + (size_t)n * me.K + 8 * c) = o; }
        LDS_WAIT(); asm volatile("" ::: "memory");
    }
}

__device__ __forceinline__ void bias_layer(Frame& F, int l0, int l1, int rank, int count) {
    PHASE_IDS();
    typedef short bf16x8 __attribute__((ext_vector_type(8)));
    LAS unsigned short* shb = (LAS unsigned short*)F.lds;
    int ubase = 0;
#pragma unroll 1
    for (int gi = 2 * l0; gi < 2 * l1; ++gi) {
        const int layer = gi >> 1; const int g = (gi & 1) == 0 ? layer : 4 + layer, l = layer; const int N = g >= 4 ? 5632 : (g == 0 ? 3072 : g == 1 ? 1536 : g == 2 ? 1280 : 2048);
        const bf16* wt = F.WT + (g >= 4 ? WO_FIN + (size_t)l * 5632 * 1024 : (g == 0 ? WO_QKV0 : g == 1 ? WO_QKV1 : g == 2 ? WO_QKV2 : WO_WIN3));
        const int shoff = g >= 4 ? 3 * 1024 : 0; const int nun = N / 128;
        for (int uu = ubase + ((rank - ubase % count + count) % count); uu < ubase + nun; uu += count) {
            const int ch = uu - ubase;
            __syncthreads();
#pragma unroll
            for (int j = 0; j < 8; ++j) { const int i = tid + 512 * j; const int r = i >> 8, k4 = (i & 255) * 4; typedef unsigned u32x2_ __attribute__((ext_vector_type(2))); u32x2_ w = {0u, 0u};
                if (r < 9) { const f32x4 v = *(const f32x4*)(F.MOD + ((size_t)l * 9 + r) * 6144 + shoff + k4); w.x = pk2(v[0], v[1]); w.y = pk2(v[2], v[3]); }
                *(LAS u32x2_*)(shb + r * 1032 + k4) = w; }
            __syncthreads();
            const int n0 = ch * 128 + wave * 16; const bf16* wp = wt + (size_t)(n0 + (lane & 15)) * 1024 + 8 * (lane >> 4);
            f32x4 acc = {0.f, 0.f, 0.f, 0.f};
#pragma unroll 16
            for (int st = 0; st < 32; ++st) { const bf16x8 b = *(const bf16x8*)(wp + 32 * st); const bf16x8 a = *(const LAS bf16x8*)(shb + (lane & 15) * 1032 + 32 * st + 8 * (lane >> 4));
                acc = __builtin_amdgcn_mfma_f32_16x16x32_bf16(a, b, acc, 0, 0, 0); }
#pragma unroll
            for (int e = 0; e < 4; ++e) { const int r = 4 * (lane >> 4) + e; if (r < 9) F.BIAS[(size_t)g * BIAS_SLOT + (size_t)r * N + n0 + (lane & 15)] = acc[e]; }
        }
        ubase += nun;
    }
    __syncthreads();
}
__device__ __forceinline__ void p0b(Frame& F, const Args& A_) {
    bias_layer(F, 0, 4, (int)blockIdx.x, (int)F.G);
    PHASE_IDS();
    const int gw = F.vcu * NWAVES + wave, NGW = F.G * NWAVES;
    for (int row0 = gw; row0 < MT; row0 += 3 * NGW) {
        f32x4 v[3][4];
#pragma unroll
        for (int q = 0; q < 3; ++q) { const int row = row0 + q * NGW; if (row < MT) { const bool lat = row < ML; const float* src = lat ? A_.in[0] + (size_t)row * 1024 : A_.in[2] + (size_t)(row - ML) * 1024;
#pragma unroll
            for (int j = 0; j < 4; ++j) v[q][j] = *(const f32x4*)(src + 256 * j + 4 * lane); } }
#pragma unroll
        for (int q = 0; q < 3; ++q) { const int row = row0 + q * NGW; if (row < MT) { const bool lat = row < ML; const int rm = lat ? (row >> 11) : 8;
            const float* sc = F.MOD + (size_t)rm * 6144 + 1024; const float* ng = A_.in[6];
            float sq = 0.f;
#pragma unroll
            for (int j = 0; j < 4; ++j) { const int col = 256 * j + 4 * lane; const f32x4 x = v[q][j];
                sq += (x[0] * x[0] + x[1] * x[1]) + (x[2] * x[2] + x[3] * x[3]);
                const f32x4 o = x * (*(const f32x4*)(ng + col)) * (*(const f32x4*)(sc + col) + 1.0f);
                typedef unsigned u32x2 __attribute__((ext_vector_type(2))); u32x2 w; w.x = pk2(o[0], o[1]); w.y = pk2(o[2], o[3]); *(u32x2*)(F.XS + (size_t)row * 1024 + col) = w; }
            sq = wave_sum(sq, lane);
            if (lane < 4) F.SSQ[(size_t)row * 4 + lane] = lane == 0 ? sq : 0.f; } }
    }
}
__device__ __forceinline__ void p_final(Frame& F, const Args& A_) {
    PHASE_IDS();
    const int gw = F.vcu * NWAVES + wave, NGW = F.G * NWAVES;
    for (int row = gw; row < ML; row += NGW) {
        const float rs = pg8::row_rstd(F.SSQ, row); float* p = F.out + (size_t)row * 1024; const bf16* hp = F.HL + (size_t)row * 1024;
#pragma unroll
        for (int j = 0; j < 4; ++j) { const int col = 256 * j + 4 * lane; typedef unsigned u32x2_ __attribute__((ext_vector_type(2))); const u32x2_ w = *(const u32x2_*)(hp + col);
            const f32x4 hv = {bf_lo(w.x), __builtin_bit_cast(float, w.x & 0xffff0000u), bf_lo(w.y), __builtin_bit_cast(float, w.y & 0xffff0000u)};
            *(f32x4*)(p + col) = hv * rs * (*(const f32x4*)(A_.in[8] + col)); }
    }
}
namespace att {
typedef unsigned short bf16;
using bf16x8=__attribute__((ext_vector_type(8)))short;
using s16x4=__attribute__((ext_vector_type(4)))short;
using f32x16=__attribute__((ext_vector_type(16)))float;
using u32x4=__attribute__((ext_vector_type(4)))unsigned;
constexpr int D=64,NW=8,QBLK=32,QB=QBLK*NW,KVBLK=64,QP=1024;
__device__ __forceinline__ int crow(int r,int hi){return (r&3)+8*(r>>2)+4*hi;}
#define SBAR() __builtin_amdgcn_sched_barrier(0)
constexpr int NSLOT=3, SLOTB=8192;
constexpr int LDS_K=0, LDS_V=NSLOT*SLOTB, LDS_WS=2*NSLOT*SLOTB, LDS_OST=LDS_WS+NW*64*4, LDS_BYTES=LDS_OST+NW*4096;
constexpr int LDS_RPB=86016;
struct Job { const bf16* Q; bf16* O; const bf16* Kc; const bf16* Vc; const bf16* Kl; const bf16* Vl; int NT; int lat; int qpos0; int kt0; int h; int wave0; const float* aux; };

__device__ __forceinline__ void glds16(const void*gsrc,unsigned lds_dst){unsigned keep;
  asm volatile("s_mov_b32 %0, m0\n\ts_mov_b32 m0, %2\n\ts_nop 0\n\tglobal_load_lds_dwordx4 %1, off\n\ts_mov_b32 m0, %0":"=&s"(keep):"v"(gsrc),"s"(lds_dst):"memory");}
__device__ __forceinline__ void glds16s(const void*sbase,unsigned voff,unsigned lds_dst){unsigned keep;
  asm volatile("s_nop 4\n\ts_mov_b32 %0, m0\n\ts_mov_b32 m0, %3\n\ts_nop 0\n\tglobal_load_lds_dwordx4 %1, %2\n\ts_mov_b32 m0, %0":"=&s"(keep):"v"(voff),"s"(sbase),"s"(lds_dst):"memory");}
__device__ __forceinline__ float max3f(float a,float b,float c){float r;asm("v_max3_f32 %0, %1, %2, %3":"=v"(r):"v"(a),"v"(b),"v"(c));return r;}
__device__ __forceinline__ float max2f(float a,float b){float r;asm("v_max_f32_e32 %0, %1, %2":"=v"(r):"v"(a),"v"(b));return r;}
__device__ __forceinline__ float fadd_s(float a,float b){float r;asm("v_add_f32_e32 %0, %1, %2":"=v"(r):"v"(a),"v"(b));return r;}
__device__ __forceinline__ float fsub_s(float a,float b){float r;asm("v_sub_f32_e32 %0, %1, %2":"=v"(r):"v"(a),"v"(b));return r;}
typedef float f32x2_t __attribute__((ext_vector_type(2))); typedef __bf16 bf16x2_t __attribute__((ext_vector_type(2)));
__device__ __forceinline__ unsigned cvtpk_s(float lo,float hi){f32x2_t v={lo,hi};bf16x2_t b=__builtin_convertvector(v,bf16x2_t);return __builtin_bit_cast(unsigned,b);}
#define WAIT_BAR(N) asm volatile("s_waitcnt vmcnt(" #N ") lgkmcnt(0)\n\ts_barrier":::"memory")
__device__ __forceinline__ void qkt(f32x16&p0,f32x16&p1,const char*Kslot,const bf16x8*qr,const f32x16&negm,int r32,int hi){
  const char*kb=Kslot+hi*1024+r32*16;
  #pragma unroll
  for(int d0=0;d0<4;++d0){
    const bf16x8 b0=*reinterpret_cast<const bf16x8*>(kb+d0*2048);
    const bf16x8 b1=*reinterpret_cast<const bf16x8*>(kb+d0*2048+512);
    if(d0==0){p0=__builtin_amdgcn_mfma_f32_32x32x16_bf16(b0,qr[0],negm,0,0,0);p1=__builtin_amdgcn_mfma_f32_32x32x16_bf16(b1,qr[0],negm,0,0,0);}
    else{p0=__builtin_amdgcn_mfma_f32_32x32x16_bf16(b0,qr[d0],p0,0,0,0);p1=__builtin_amdgcn_mfma_f32_32x32x16_bf16(b1,qr[d0],p1,0,0,0);}}
}
typedef __attribute__((address_space(3))) const char* lds_cptr;
typedef short v4i16_t __attribute__((ext_vector_type(4)));
__device__ __forceinline__ void kload8(bf16x8*kf,lds_cptr kp){
  kf[0]=*(const __attribute__((address_space(3))) bf16x8*)(kp);      kf[1]=*(const __attribute__((address_space(3))) bf16x8*)(kp+512);
  kf[2]=*(const __attribute__((address_space(3))) bf16x8*)(kp+2048); kf[3]=*(const __attribute__((address_space(3))) bf16x8*)(kp+2560);
  kf[4]=*(const __attribute__((address_space(3))) bf16x8*)(kp+4096); kf[5]=*(const __attribute__((address_space(3))) bf16x8*)(kp+4608);
  kf[6]=*(const __attribute__((address_space(3))) bf16x8*)(kp+6144); kf[7]=*(const __attribute__((address_space(3))) bf16x8*)(kp+6656);
}
__device__ __forceinline__ void kload2(bf16x8*kf,lds_cptr kp,int j){ kf[2*j]=*(const __attribute__((address_space(3))) bf16x8*)(kp+j*2048); kf[2*j+1]=*(const __attribute__((address_space(3))) bf16x8*)(kp+j*2048+512); }
__device__ __forceinline__ s16x4 vtr(lds_cptr p){ return __builtin_bit_cast(s16x4,__builtin_amdgcn_ds_read_tr16_b64_v4i16((__attribute__((address_space(3))) v4i16_t*)p)); }
__device__ __forceinline__ float rowmax(const f32x16&p0,const f32x16&p1){
  float a=max3f(p0[0],p0[1],p1[0]),b=max3f(p0[2],p0[3],p1[1]);a=max3f(a,p1[2],p1[3]);
  #pragma unroll
  for(int r=4;r<16;r+=4){a=max3f(a,p0[r],p0[r+1]);b=max3f(b,p0[r+2],p0[r+3]);a=max3f(a,p1[r],p1[r+1]);b=max3f(b,p1[r+2],p1[r+3]);}
  const float m=max2f(a,b);
  auto rr=__builtin_amdgcn_permlane32_swap(__float_as_uint(m),__float_as_uint(m),false,false);
  return max2f(__uint_as_float(rr[0]),__uint_as_float(rr[1]));
}
__device__ __forceinline__ void pv(f32x16*o,int vb,bf16x8 pa0,bf16x8 pa1,bf16x8 pa2,bf16x8 pa3){
  #pragma unroll
  for(int d0=0;d0<2;++d0){s16x4 lo[4],hi[4];
    #pragma unroll
    for(int ks=0;ks<4;++ks){
      asm volatile("ds_read_b64_tr_b16 %0,%1 offset:%c2":"=&v"(lo[ks]):"v"(vb),"i"(d0*4096+ks*1024):"memory");
      asm volatile("ds_read_b64_tr_b16 %0,%1 offset:%c2":"=&v"(hi[ks]):"v"(vb),"i"(d0*4096+ks*1024+512):"memory");}
    asm volatile("s_waitcnt lgkmcnt(0)":::"memory");SBAR();
    #define PK(k) (bf16x8){lo[k][0],lo[k][1],lo[k][2],lo[k][3],hi[k][0],hi[k][1],hi[k][2],hi[k][3]}
    o[d0]=__builtin_amdgcn_mfma_f32_32x32x16_bf16(pa0,PK(0),o[d0],0,0,0);
    o[d0]=__builtin_amdgcn_mfma_f32_32x32x16_bf16(pa1,PK(1),o[d0],0,0,0);
    o[d0]=__builtin_amdgcn_mfma_f32_32x32x16_bf16(pa2,PK(2),o[d0],0,0,0);
    o[d0]=__builtin_amdgcn_mfma_f32_32x32x16_bf16(pa3,PK(3),o[d0],0,0,0);
    #undef PK
  }
}
typedef __attribute__((address_space(3))) const float* lds_fptr;
__device__ __forceinline__ bf16 f2bf_(float f){ unsigned u=__builtin_bit_cast(unsigned,f); return (bf16)((u+0x7fffu+((u>>16)&1u))>>16); }
struct MaskCtx { int kt0, v0, v1, v2, v3, v4; lds_fptr rp; };
template<int KIND> __device__ __forceinline__ void mask_setup(MaskCtx&mc,const Job&J,char*shm,int tid,int wid,int r32,int hi){
  mc.kt0=J.kt0; mc.v0=mc.v1=mc.v2=mc.v3=0; mc.v4=wid&1; mc.rp=(lds_fptr)(shm+LDS_RPB);
  if constexpr(KIND==0){
    if(J.lat&&tid<465) ((__attribute__((address_space(3))) float*)(shm+LDS_RPB))[tid]=J.aux[tid]*1.4426950408889634f;
    const int rq=(J.qpos0>>6)+(wid>>1), qc=(wid&1)*32+r32; int r0=rq-4; r0=r0<0?0:(r0>24?24:r0); int cs=qc-8; cs=cs<0?0:(cs>48?48:cs);
    mc.v0=rq; mc.v1=qc; mc.v2=r0; mc.v3=cs;
  } else if constexpr(KIND==2){ mc.v0=J.qpos0+wid*32+r32; mc.v1=J.qpos0+wid*32; }
}
template<int KIND> __device__ __forceinline__ void mask_tile(f32x16&p0,f32x16&p1,int t,const MaskCtx&mc,int hi){
  const float NEG=-INFINITY;
  if constexpr(KIND==0){
    if(t<4)return;
    const int kr=mc.kt0+(t-4);
    if(kr<mc.v2||kr>=mc.v2+8){
      _Pragma("unroll") for(int r=0;r<16;++r){p0[r]=NEG;p1[r]=NEG;} return; }
    const lds_fptr T=mc.rp+(kr-mc.v0+7)*31; const int ib=15-mc.v1+4*hi, wb=4*hi-mc.v3;
    _Pragma("unroll") for(int r=0;r<16;++r){ const int c=(r&3)+8*(r>>2);
      if(mc.v4==0||r>=12){ const bool ok=(unsigned)(wb+c)<16u; const float bv=T[ok?ib+c:0]; p0[r]=ok?p0[r]+bv:NEG; } else p0[r]=NEG;
      if(mc.v4!=0||r<4){ const bool ok=(unsigned)(wb+c+32)<16u; const float bv=T[ok?ib+c+32:0]; p1[r]=ok?p1[r]+bv:NEG; } else p1[r]=NEG; }
  } else if constexpr(KIND==2){
    if(t<4)return;
    const int k0=64*(mc.kt0+t-4), dk=k0-mc.v1;
    if(dk>=-96&&dk<=64)return;
    if(dk<=-192||dk>=160){ _Pragma("unroll") for(int r=0;r<16;++r){p0[r]=NEG;p1[r]=NEG;} return; }
    const int dq=k0+4*hi-mc.v0+128;
    _Pragma("unroll") for(int r=0;r<16;++r){ const int c=(r&3)+8*(r>>2); if((unsigned)(dq+c)>256u)p0[r]=NEG; if((unsigned)(dq+c+32)>256u)p1[r]=NEG; }
  }
}
template<int KIND> __device__ __forceinline__ bool tile_dead(int t,const MaskCtx&mc){
  if constexpr(KIND==0){ if(t<4)return false; const int kr=mc.kt0+(t-4); return kr<mc.v2||kr>=mc.v2+8; }
  else if constexpr(KIND==2){ if(t<4)return false; const int dk=64*(mc.kt0+t-4)-mc.v1; return dk<=-192||dk>=160; }
  else return false;
}
#ifndef ATTN_STORE16
#define ATTN_STORE16(p,v) (*(u32x4*)(p)=(v))
#endif
template<int KIND,int THRL> __device__ __forceinline__ void attn_unit(const Job&J,char*shm){
  constexpr int LDK=KIND==0?1024:KIND==1?256:128;
  const int tid=fresh_tid(J.wave0),lane=tid&63,r32=lane&31,hi=lane>>5; const int wid=__builtin_amdgcn_readfirstlane(tid>>6);
  const bf16*Qw=J.Q+(long)(wid*QBLK)*QP;
  const unsigned lds0=(unsigned)(uintptr_t)shm;
  float*wsf=(float*)(shm+LDS_WS)+wid*64;
  const unsigned kvo=(unsigned)(wid*512+lane*8)*2u, vvo=(unsigned)((16*(wid&3)+(lane>>2))*LDK+(wid>>2)*32+(lane&3)*8)*2u;
  const unsigned kdst=lds0+LDS_K+wid*1024, vdst=lds0+LDS_V+wid*1024;
  #define DMA_K(t,slot) glds16s(((t)<4?J.Kc+(long)(t)*4096:J.Kl+(long)((t)-4)*4096),kvo,(unsigned)__builtin_amdgcn_readfirstlane(kdst+(slot)))
  #define DMA_V(t,slot) glds16s(((t)<4?J.Vc+(long)(t)*KVBLK*LDK:J.Vl+(long)((t)-4)*KVBLK*LDK),vvo,(unsigned)__builtin_amdgcn_readfirstlane(vdst+(slot)))
  const int vb0=(int)(lds0+LDS_V)+((lane>>4)&1)*32+(lane&3)*8+(4*hi+((lane&15)>>2))*64;
  const char*Kbase=shm+LDS_K; bf16x8 kf[8];
  const lds_cptr shm3=(lds_cptr)shm; const lds_cptr kp0=shm3+LDS_K+hi*1024+r32*16; const lds_cptr vp0=shm3+LDS_V+((lane>>4)&1)*32+(lane&3)*8+(4*hi+((lane&15)>>2))*64;
  const int NT=J.NT;
  MaskCtx mc; mask_setup<KIND>(mc,J,shm,tid,wid,r32,hi);
  DMA_K(0,0);DMA_V(0,0);DMA_K(1,SLOTB);
  bf16x8 qr[4];
  #pragma unroll
  for(int d0=0;d0<4;++d0)qr[d0]=*reinterpret_cast<const bf16x8*>(&Qw[(long)r32*QP+d0*16+hi*8]);
  float mhat=0.f,l_reg=0.f;f32x16 o[2];o[0]=f32x16{};o[1]=f32x16{};f32x16 negm=f32x16{};asm volatile("":"+v"(negm));
  #define CMASK(P0,P1,t) mask_tile<KIND>(P0,P1,(t),mc,hi)
  bool resc=false;
  #define START(P0,P1) do{ const float rm=rowmax(P0,P1); resc=false; \
    { const float dl=rm; mhat=fadd_s(mhat,dl); \
      _Pragma("unroll") for(int r=0;r<16;++r){P0[r]=fsub_s(P0[r],dl);P1[r]=fsub_s(P1[r],dl);} \
      _Pragma("unroll") for(int r=0;r<16;++r)negm[r]=-mhat; asm volatile("":"+v"(negm)); } \
    _Pragma("unroll") for(int r=0;r<16;++r)P0[r]=__builtin_amdgcn_exp2f(P0[r]); }while(0)
  #define RESC() do{ if(resc){ asm volatile("s_waitcnt lgkmcnt(0)":::"memory"); \
      _Pragma("unroll") for(int d_=0;d_<2;++d_) _Pragma("unroll") for(int r=0;r<16;++r)o[d_][r]*=wsf[crow(r,hi)]; } }while(0)
  f32x16 pA0,pA1,pB0,pB1;
  int sl_prev=0,sl_cur=0,sl_next=SLOTB;
  #define ROT() do{sl_prev=sl_cur;sl_cur=sl_next;sl_next=(sl_next==(NSLOT-1)*SLOTB)?0:sl_next+SLOTB;}while(0)
  DMA_K(2,2*SLOTB);
  WAIT_BAR(3);
  qkt(pA0,pA1,Kbase,qr,negm,r32,hi);asm volatile("s_nop 15\n\ts_nop 7":"+v"(pA0),"+v"(pA1));
  START(pA0,pA1);
  _Pragma("unroll") for(int r=0;r<16;++r)pA1[r]=__builtin_amdgcn_exp2f(pA1[r]);
  WAIT_BAR(0);
  DMA_K(3,0);DMA_V(1,SLOTB);
  ROT();
  kload8(kf,kp0+sl_cur);
  WAIT_BAR(2);
  s16x4 vlo[8],vhi[8]; u32x4 pw0,pw1,pw2,pw3;
  #define PKW(P,B) cvtpk_s(P[B],P[B+1])
  #define PAF(k) __builtin_bit_cast(bf16x8,pw##k)
  #define VFR(i) (bf16x8){vlo[i][0],vlo[i][1],vlo[i][2],vlo[i][3],vhi[i][0],vhi[i][1],vhi[i][2],vhi[i][3]}
  #define PIN(x) asm volatile("":"+v"(x))
  #define MX3(a,b,c) __builtin_fmaxf(__builtin_fmaxf((a),(b)),(c))
  #define GAPA(MF,A0,A1,A2,A3,W0,W1,PW) do{ MF; sacc+=A0; sacc+=A1; sacc+=A2; sacc+=A3; PIN(sacc); W0; W1; PIN(PW); SBAR(); }while(0)
  #define EX(v) __builtin_amdgcn_exp2f(v)
  #define GAPB(MF,X,B) do{ MF; X[B]=EX(X[B]); X[B+1]=EX(X[B+1]); X[B+2]=EX(X[B+2]); X[B+3]=EX(X[B+3]); PIN(X); SBAR(); }while(0)
  #define VRD(i) do{ vlo[i]=vtr(vp_+(((i)>>2)*4096+((i)&3)*1024)); vhi[i]=vtr(vp_+(((i)>>2)*4096+((i)&3)*1024+512)); }while(0)
  #define KRD(G,j) do{ if(G){ kload2(kf,kp0+sl_next,j); SBAR(); } }while(0)
  #define STEP(C0,C1,P0,P1,t,GK,GV,GL) do{ SBAR(); \
    if(KIND!=1&&tile_dead<KIND>((t),mc)&&tile_dead<KIND>((t)-1,mc)){   \
      if(GK){DMA_K((t)+3,sl_cur);} if(GV){DMA_V((t)+1,sl_next);} KRD(GL,0); KRD(GL,1); KRD(GL,2); KRD(GL,3); \
      _Pragma("unroll") for(int r_=0;r_<16;++r_){C0[r_]=0.f;C1[r_]=0.f;} resc=false; SBAR(); } else { \
    const lds_cptr vp_=vp0+sl_prev; \
    VRD(0); SBAR(); float sacc=(P0[0]+P0[1]); \
    GAPA(C0=__builtin_amdgcn_mfma_f32_32x32x16_bf16(kf[0],qr[0],negm,0,0,0), P0[2],P0[3],P0[4],P0[5],     pw0[0]=PKW(P0,0), pw0[1]=PKW(P0,2), pw0); \
    VRD(4); SBAR(); GAPA(C1=__builtin_amdgcn_mfma_f32_32x32x16_bf16(kf[1],qr[0],negm,0,0,0), P0[6],P0[7],P0[8],P0[9],     pw0[2]=PKW(P0,4), pw0[3]=PKW(P0,6), pw0); \
    VRD(1); SBAR(); GAPA(C0=__builtin_amdgcn_mfma_f32_32x32x16_bf16(kf[2],qr[1],C0,0,0,0),   P0[10],P0[11],P0[12],P0[13], pw1[0]=PKW(P0,8), pw1[1]=PKW(P0,10), pw1); \
    VRD(5); SBAR(); GAPA(C1=__builtin_amdgcn_mfma_f32_32x32x16_bf16(kf[3],qr[1],C1,0,0,0),   P0[14],P0[15],P1[0],P1[1],   pw1[2]=PKW(P0,12),pw1[3]=PKW(P0,14), pw1); \
    VRD(2); SBAR(); GAPA(C0=__builtin_amdgcn_mfma_f32_32x32x16_bf16(kf[4],qr[2],C0,0,0,0),   P1[2],P1[3],P1[4],P1[5],     pw2[0]=PKW(P1,0), pw2[1]=PKW(P1,2), pw2); \
    VRD(6); SBAR(); GAPA(C1=__builtin_amdgcn_mfma_f32_32x32x16_bf16(kf[5],qr[2],C1,0,0,0),   P1[6],P1[7],P1[8],P1[9],     pw2[2]=PKW(P1,4), pw2[3]=PKW(P1,6), pw2); \
    VRD(3); SBAR(); GAPA(C0=__builtin_amdgcn_mfma_f32_32x32x16_bf16(kf[6],qr[3],C0,0,0,0),   P1[10],P1[11],P1[12],P1[13], pw3[0]=PKW(P1,8), pw3[1]=PKW(P1,10), pw3); \
    VRD(7); SBAR(); GAPA(C1=__builtin_amdgcn_mfma_f32_32x32x16_bf16(kf[7],qr[3],C1,0,0,0),   P1[14],P1[15],0.f,0.f,       pw3[2]=PKW(P1,12),pw3[3]=PKW(P1,14), pw3); \
    l_reg+=sacc; \
    if(GK){DMA_K((t)+3,sl_cur);} if(GV){DMA_V((t)+1,sl_next);} \
    CMASK(C0,C1,t); \
    { float a=MX3(C0[0],C0[1],C1[0]),b=MX3(C0[2],C0[3],C1[1]); a=MX3(a,C1[2],C1[3]); \
      _Pragma("unroll") for(int r=4;r<16;r+=4){a=MX3(a,C0[r],C0[r+1]);b=MX3(b,C0[r+2],C0[r+3]);a=MX3(a,C1[r],C1[r+1]);b=MX3(b,C1[r+2],C1[r+3]);} \
      float rm=__builtin_fmaxf(a,b); { auto rr=__builtin_amdgcn_permlane32_swap(__float_as_uint(rm),__float_as_uint(rm),false,false); rm=__builtin_fmaxf(__uint_as_float(rr[0]),__uint_as_float(rr[1])); } \
      resc=false; \
      if(__builtin_expect(__any(rm>(float)THRL),0)){ const float dl=__builtin_fmaxf(rm,0.f); mhat+=dl; \
        _Pragma("unroll") for(int r=0;r<16;++r){C0[r]-=dl;C1[r]-=dl;} \
        _Pragma("unroll") for(int r=0;r<16;++r)negm[r]=-mhat; asm volatile("":"+v"(negm)); \
        const float f=__builtin_amdgcn_exp2f(-dl); l_reg*=f; if(hi==0)wsf[r32]=f; resc=true; } } \
    SBAR(); \
    GAPB(o[0]=__builtin_amdgcn_mfma_f32_32x32x16_bf16(PAF(0),VFR(0),o[0],0,0,0), C0,0); \
    GAPB(o[1]=__builtin_amdgcn_mfma_f32_32x32x16_bf16(PAF(0),VFR(4),o[1],0,0,0), C0,4); \
    KRD(GL,0); GAPB(o[0]=__builtin_amdgcn_mfma_f32_32x32x16_bf16(PAF(1),VFR(1),o[0],0,0,0), C0,8); \
    KRD(GL,1); GAPB(o[1]=__builtin_amdgcn_mfma_f32_32x32x16_bf16(PAF(1),VFR(5),o[1],0,0,0), C0,12); \
    KRD(GL,2); GAPB(o[0]=__builtin_amdgcn_mfma_f32_32x32x16_bf16(PAF(2),VFR(2),o[0],0,0,0), C1,0); \
    KRD(GL,3); GAPB(o[1]=__builtin_amdgcn_mfma_f32_32x32x16_bf16(PAF(2),VFR(6),o[1],0,0,0), C1,4); \
    GAPB(o[0]=__builtin_amdgcn_mfma_f32_32x32x16_bf16(PAF(3),VFR(3),o[0],0,0,0), C1,8); \
    GAPB(o[1]=__builtin_amdgcn_mfma_f32_32x32x16_bf16(PAF(3),VFR(7),o[1],0,0,0), C1,12); \
    } }while(0)
  int t=1;
  #undef CMASK
  #define CMASK(P0,P1,t) do{}while(0)
  if constexpr(KIND==1) for(;t+5<NT;t+=2){
    STEP(pB0,pB1,pA0,pA1,t,true,true,true);     WAIT_BAR(2); RESC(); ROT();
    STEP(pA0,pA1,pB0,pB1,t+1,true,true,true);   WAIT_BAR(2); RESC(); ROT();
  }
  #undef CMASK
  #define CMASK(P0,P1,t) mask_tile<KIND>(P0,P1,(t),mc,hi)
  #define ENDW(tt) do{ if((tt)+3<NT){WAIT_BAR(2);} else if((tt)+2<NT){WAIT_BAR(1);} else {WAIT_BAR(0);} }while(0)
  for(;t+1<NT;t+=2){
    STEP(pB0,pB1,pA0,pA1,t,(t+3<NT),(t+1<NT),(t+1<NT));       ENDW(t);   RESC(); ROT();
    STEP(pA0,pA1,pB0,pB1,t+1,(t+4<NT),(t+2<NT),(t+2<NT));     ENDW(t+1); RESC(); ROT();
  }
  STEP(pB0,pB1,pA0,pA1,NT-1,false,false,false); RESC();
  { float sacc=pB0[0]+pB0[1]; _Pragma("unroll") for(int r=2;r<16;++r)sacc+=pB0[r]; _Pragma("unroll") for(int r=0;r<16;++r)sacc+=pB1[r]; l_reg+=sacc;
    pw0=(u32x4){PKW(pB0,0),PKW(pB0,2),PKW(pB0,4),PKW(pB0,6)};pw1=(u32x4){PKW(pB0,8),PKW(pB0,10),PKW(pB0,12),PKW(pB0,14)};pw2=(u32x4){PKW(pB1,0),PKW(pB1,2),PKW(pB1,4),PKW(pB1,6)};pw3=(u32x4){PKW(pB1,8),PKW(pB1,10),PKW(pB1,12),PKW(pB1,14)};
    SBAR(); pv(o,vb0+sl_cur,PAF(0),PAF(1),PAF(2),PAF(3)); }
  #undef PKW
  #undef PAF
  #undef VFR
  #undef PIN
  #undef MX3
  #undef GAPA
  #undef GAPB
  #undef EX
  #undef VRD
  #undef KRD
  #undef STEP
  #undef ENDW
  {auto rr=__builtin_amdgcn_permlane32_swap(__float_as_uint(l_reg),__float_as_uint(l_reg),false,false);l_reg=__uint_as_float(rr[0])+__uint_as_float(rr[1]);}
  if constexpr(KIND==2) l_reg+=__builtin_amdgcn_exp2f(J.aux[0]*1.4426950408889634f-mhat);
  if(hi==0)wsf[32+r32]=l_reg;asm volatile("s_waitcnt lgkmcnt(0)":::"memory");
  float rli[16];
  #pragma unroll
  for(int r=0;r<16;++r)rli[r]=__builtin_amdgcn_rcpf(wsf[32+crow(r,hi)]);
  bf16*Ow=J.O+(long)(wid*QBLK)*QP;
  { bf16*stg=(bf16*)(shm+LDS_OST)+wid*2048;
    #pragma unroll
    for(int r=0;r<16;++r){const int orow=crow(r,hi);
      #pragma unroll
      for(int d0=0;d0<2;++d0)stg[orow*64+d0*32+r32]=(bf16)cvtpk_s(o[d0][r]*rli[r],0.f);}
    asm volatile("s_waitcnt lgkmcnt(0)":::"memory");
    #pragma unroll
    for(int i=0;i<4;++i){const int row=i*8+(lane>>3),ch=lane&7; const u32x4 v=*(const u32x4*)(stg+row*64+ch*8); ATTN_STORE16(Ow+(long)row*QP+ch*8,v);} }
  asm volatile("s_waitcnt lgkmcnt(0)\n\ts_barrier":::"memory");
  #undef DMA_K
  #undef DMA_V
  #undef CMASK
  #undef START
  #undef RESC
  #undef ROT
}
#undef SBAR
#undef WAIT_BAR
}
__device__ __forceinline__ void sb_arrive(Frame& F, int j);
template <int KIND> __device__ __forceinline__ void attn_phase(Frame& F, const Args& A_) {
    constexpr int ldk = KIND == 0 ? 1024 : KIND == 1 ? 256 : 128, gsz = KIND == 0 ? 1 : KIND == 1 ? 4 : 8;
    char* shm = (char*)F.lds;
#pragma unroll 1
    for (int it = 0; ; ++it) {
        int U;
        if (F.xm && it == 4) sb_arrive(F, 18 + 2 * KIND);
        if (F.xm) {
            if (it < 4) U = F.xg * 128 + 4 * F.lidx + it; else if (it == 4 && F.lidx < 16) U = 1024 + F.xg * 16 + F.lidx; else break;
        } else { const int rounds = (1024 + 4 * F.G - 1) / (4 * F.G); const int r = it >> 2;
          if (r < rounds) { U = 4 * F.vcu + (it & 3) + r * 4 * F.G; if (U >= 1024) continue; }
          else { U = 1024 + F.vcu + (it - 4 * rounds) * F.G; if (U >= 1152) break; } }
        const bool lat = U < 1024; const int bh = lat ? (U >> 3) : (U - 1024), qb = lat ? (U & 7) : 0, b = bh >> 4, h = bh & 15, kvh = h / gsz;
        int kt0 = 0, nlt = 0;
        if (lat) {
            if constexpr (KIND == 1) { kt0 = 0; nlt = 32; }
            else if constexpr (KIND == 2) { const int q0 = qb * 256; const int lo = q0 - 128 < 0 ? 0 : q0 - 128, hi_ = q0 + 383 > SEQ - 1 ? SEQ - 1 : q0 + 383; kt0 = lo >> 6; nlt = (hi_ >> 6) - kt0 + 1; }
            else { const int rf = qb * 4; int r0f = rf - 4; r0f = r0f < 0 ? 0 : (r0f > 24 ? 24 : r0f); int r0l = rf + 3 - 4; r0l = r0l < 0 ? 0 : (r0l > 24 ? 24 : r0l);
                kt0 = r0f; nlt = r0l + 8 - r0f; if (nlt & 1) { if (kt0 + nlt < 32) ++nlt; else { --kt0; ++nlt; } } }
        }
        const size_t qrow = lat ? (size_t)b * SEQ + qb * 256 : (size_t)ML + b * CTXL;
        att::Job J;
        unsigned char* Rb = F.R + (size_t)b * SLAB; const size_t lrow = lat ? (size_t)qb * 256 : (size_t)SEQ;
        J.Q = (bf16*)(Rb + SL_Q) + lrow * 1024 + h * 64; J.O = (bf16*)F.HF + qrow * 1024 + h * 64;
        J.Kc = (bf16*)(Rb + SL_K) + (size_t)(kvh * 36 + 32) * 4096; J.Vc = (bf16*)(Rb + SL_V) + (size_t)SEQ * ldk + kvh * 64;
        J.Kl = (bf16*)(Rb + SL_K) + (size_t)(kvh * 36 + kt0) * 4096; J.Vl = (bf16*)(Rb + SL_V) + (size_t)(kt0 * 64) * ldk + kvh * 64;
        J.NT = 4 + nlt; J.lat = lat ? 1 : 0; J.qpos0 = qb * 256; J.kt0 = kt0; J.h = h; J.wave0 = F.wave0;
        J.aux = KIND == 0 ? A_.in[12] + (size_t)h * 465 : (KIND == 2 ? A_.in[19] + h : nullptr);
        att::attn_unit<KIND, 8>(J, shm);
    }
    if (F.xm) sb_arrive(F, 19 + 2 * KIND);
}
constexpr size_t WS_WG = 2 * MiB + 65536;
constexpr size_t LRU_AGG_OFF = 0, LRU_HIN_OFF = 16 * MiB;
__device__ __forceinline__ void lru_wprep(Frame& F, const Args& A_) {
    PHASE_IDS();
    bf16* WG = (bf16*)(F.ws + WS_WG);
    for (int i = (F.vcu * NWAVES + wave) * 64 + lane; i < 16 * 4 * 64 * 64; i += F.G * NWAVES * 64) {
        const int d = i & 63, e = (i >> 6) & 63, s = (i >> 12) & 3, n = i >> 14; const int dir = s >> 1;
        const float* src = (s & 1) ? A_.in[26] : A_.in[24];
        WG[i] = (bf16)f2bf(src[((size_t)(dir * 16 + n) * 64 + d) * 64 + e]); }
}
struct LruSpan { int dir, isctx, T, tok0; size_t rowb; };
__device__ __forceinline__ LruSpan lru_span(int step) { LruSpan s; s.dir = step >= 9 ? 1 : 0; const int s9 = step - 9 * s.dir; s.isctx = s9 == 0 ? 1 : 0; const int sp = s.dir ? 8 - s9 : s9 - 1;
    s.T = s.isctx ? CTXL : SEQ; s.tok0 = s.isctx ? 0 : sp * 256; s.rowb = s.isctx ? (size_t)SEQ : (size_t)0; return s; }
__device__ __forceinline__ void lru_sweeps(Frame& F, const Args& A_) {
    PHASE_IDS();
    typedef short bf16x8 __attribute__((ext_vector_type(8))); typedef float f32x16 __attribute__((ext_vector_type(16)));
    const int r32 = lane & 31, hi = lane >> 5;
    LAS float* xcf = (LAS float*)F.lds;
    LAS unsigned short* xcb = (LAS unsigned short*)(F.lds + 36864);
    LAS unsigned short* glt = (LAS unsigned short*)(F.lds + 73728);
    LAS unsigned short* hft = (LAS unsigned short*)(F.lds + 94208);
    LAS unsigned short* wgt = (LAS unsigned short*)(F.lds + 114688);
    LAS float* agg = (LAS float*)(F.lds + 123904);
    const bf16* WG = (const bf16*)(F.ws + WS_WG);
    bf16* HFW = (bf16*)F.HF;
    const int cq = tid & 15, tg = tid >> 4;
    const int trow = tid >> 2, tq = tid & 3;
#pragma unroll 1
    for (int v = F.xm ? F.xg * 32 + F.lidx : F.vcu; v < 256; v += F.xm ? 256 : F.G) {
        const int b = v >> 5, n = (v >> 1) & 15, hf = v & 1;
        const int ch = 64 * n + 32 * hf + r32;
        const char* XRb = (const char*)(F.R + (size_t)b * SLAB + SL_XR) + (size_t)(64 * n) * 2; bf16* GL = (bf16*)(F.R + (size_t)b * SLAB + SL_GL) + 64 * n + 32 * hf;
        bf16* HFb = HFW + (size_t)b * SEQ * 1024 + 64 * n + 32 * hf;
        bf16* dummy = (bf16*)(F.ws + WS_HC + 4 * MiB) + ((size_t)v * 512 + tid) * 16;
        f32x4 cwv[4];
#pragma unroll
        for (int k = 0; k < 4; ++k) cwv[k] = *(const f32x4*)(A_.in[22] + k * 1024 + 64 * n + 4 * cq);
        const f32x4 cbv = *(const f32x4*)(A_.in[23] + 64 * n + 4 * cq);
        typedef unsigned u32x2 __attribute__((ext_vector_type(2))); u32x2 xin[11]; v4u gin[2], hin[2];
#define LRU_FETCH(sp_) do { \
        _Pragma("unroll") for (int i = 0; i < 11; ++i) { int tt = (sp_).tok0 + 8 * tg - 2 + i; if (i < 2) tt = tt < 0 ? 0 : tt; if (i == 10) tt = tt > (sp_).T - 1 ? (sp_).T - 1 : tt; \
            xin[i] = *(const u32x2*)(XRb + (unsigned)((((int)(sp_).rowb + tt) * 1024 + 4 * cq) * 2)); } \
        { const unsigned e_ = ((sp_).dir && !(sp_).isctx) ? (unsigned)(((sp_).tok0 + trow) * 1024 + 8 * tq) : 0u;     \
          const bf16* gp = GL + e_; gin[0] = *(const GAS v4u*)gp; gin[1] = *(const GAS v4u*)(gp + 128 * 1024); const bf16* hp = HFb + e_; hin[0] = *(const GAS v4u*)hp; hin[1] = *(const GAS v4u*)(hp + 128 * 1024); } } while (0)
        { const LruSpan s0 = lru_span(0); LRU_FETCH(s0); }
#pragma unroll 1
        for (int d = 0; d < 2; ++d) {
            float S = 0.f;
            if (d == 1) asm volatile("s_waitcnt vmcnt(0)" ::: "memory");
            const float nba = -LOG2E * A_.in[25][d * 1024 + ch], nbx = -LOG2E * A_.in[27][d * 1024 + ch]; const float sp = -8.0f * LOG2E * log1pf(expf(-A_.in[28][d * 1024 + ch]));
            { const int row = tid >> 3, pc = tid & 7, st_ = row >> 5, e = row & 31;
              *(LAS v4u*)(wgt + row * 72 + 8 * pc) = *(const GAS v4u*)(WG + ((size_t)((n * 4 + 2 * d + st_) * 64 + 32 * hf + e) * 64 + 8 * pc)); }
#pragma unroll 1
        for (int s9 = 0; s9 < 9; ++s9) {
            const int step = 9 * d + s9;
            const LruSpan cur = lru_span(step);
            f32x4 xf[11];
            { const u32x2 z = {0u, 0u}; const int t0 = cur.tok0 + 8 * tg; if (t0 - 2 < 0) xin[0] = z; if (t0 - 1 < 0) xin[1] = z; if (t0 + 8 >= cur.T) xin[10] = z; }
#pragma unroll
            for (int i = 0; i < 11; ++i) { xf[i][0] = bf_lo(xin[i].x); xf[i][1] = __builtin_bit_cast(float, xin[i].x & 0xffff0000u); xf[i][2] = bf_lo(xin[i].y); xf[i][3] = __builtin_bit_cast(float, xin[i].y & 0xffff0000u); }
#pragma unroll
            for (int j = 0; j < 8; ++j) { const int tok = 8 * tg + j; const f32x4 a = cbv + cwv[0] * xf[j] + cwv[1] * xf[j + 1] + cwv[2] * xf[j + 2] + cwv[3] * xf[j + 3];
                if ((cq >> 3) == hf) *(LAS f32x4*)(xcf + tok * 36 + 4 * (cq & 7)) = a;
                u32x2 w; w.x = att::cvtpk_s(a[0], a[1]); w.y = att::cvtpk_s(a[2], a[3]); *(LAS u32x2*)(xcb + tok * 72 + 4 * cq) = w; }
            if (cur.dir && !cur.isctx) { *(LAS v4u*)(glt + trow * 40 + 8 * tq) = gin[0]; *(LAS v4u*)(glt + (trow + 128) * 40 + 8 * tq) = gin[1];
                                         *(LAS v4u*)(hft + trow * 40 + 8 * tq) = hin[0]; *(LAS v4u*)(hft + (trow + 128) * 40 + 8 * tq) = hin[1]; }
            __syncthreads();
            { const LruSpan nx = lru_span(step + 1 < 18 ? step + 1 : 17); LRU_FETCH(nx); }
            bf16x8 Af[4];
#pragma unroll
            for (int ks = 0; ks < 4; ++ks) Af[ks] = *(const LAS bf16x8*)(xcb + (32 * wave + r32) * 72 + 16 * ks + 8 * hi);
            f32x16 acc[2];
#pragma unroll
            for (int s = 0; s < 2; ++s) { acc[s] = (f32x16){};
#pragma unroll
                for (int ks = 0; ks < 4; ++ks) acc[s] = __builtin_amdgcn_mfma_f32_32x32x16_bf16(Af[ks], *(const LAS bf16x8*)(wgt + (s * 32 + r32) * 72 + 16 * ks + 8 * hi), acc[s], 0, 0, 0); }
            float af[16], bv[16];
#pragma unroll
            for (int r = 0; r < 16; ++r) { const int tok = 32 * wave + (r & 3) + 8 * (r >> 2) + 4 * hi; const float xv = xcf[tok * 36 + r32];
                const float rg = __builtin_amdgcn_rcpf(1.0f + __builtin_amdgcn_exp2f(__builtin_fmaf(acc[0][r], -LOG2E, nba))), ig = __builtin_amdgcn_rcpf(1.0f + __builtin_amdgcn_exp2f(__builtin_fmaf(acc[1][r], -LOG2E, nbx)));
                const float a = __builtin_amdgcn_exp2f(sp * rg);
                af[r] = a; bv[r] = __builtin_amdgcn_sqrtf(1.0f - a * a) * (ig * xv); }
            float RA[4], RB[4], LA[4], UA[4], LB[4], UB[4], st[4], h[16];
            if (cur.dir == 0) {
#pragma unroll
                for (int j = 0; j < 4; ++j) { float A = 1.f, Bv = 0.f;
#pragma unroll
                    for (int i = 0; i < 4; ++i) { Bv = af[4 * j + i] * Bv + bv[4 * j + i]; A *= af[4 * j + i]; }
                    RA[j] = A; RB[j] = Bv; }
            } else {
#pragma unroll
                for (int j = 0; j < 4; ++j) { float A = 1.f, Bv = 0.f;
#pragma unroll
                    for (int i = 3; i >= 0; --i) { Bv = af[4 * j + i] * Bv + bv[4 * j + i]; A *= af[4 * j + i]; }
                    RA[j] = A; RB[j] = Bv; }
            }
#pragma unroll
            for (int j = 0; j < 4; ++j) { auto ra = __builtin_amdgcn_permlane32_swap(__float_as_uint(RA[j]), __float_as_uint(RA[j]), false, false); LA[j] = __uint_as_float(ra[0]); UA[j] = __uint_as_float(ra[1]);
                auto rb = __builtin_amdgcn_permlane32_swap(__float_as_uint(RB[j]), __float_as_uint(RB[j]), false, false); LB[j] = __uint_as_float(rb[0]); UB[j] = __uint_as_float(rb[1]); }
            { float s = 0.f, At = 1.f;
              if (cur.dir == 0) {
#pragma unroll
                  for (int j = 0; j < 4; ++j) { s = LA[j] * s + LB[j]; s = UA[j] * s + UB[j]; At *= LA[j] * UA[j]; }
              } else {
#pragma unroll
                  for (int j = 3; j >= 0; --j) { s = UA[j] * s + UB[j]; s = LA[j] * s + LB[j]; At *= LA[j] * UA[j]; }
              }
              if (hi == 0) { typedef float f32x2_ __attribute__((ext_vector_type(2))); f32x2_ w2; w2[0] = At; w2[1] = s; *(LAS f32x2_*)(agg + (wave * 32 + r32) * 2) = w2; } }
            __syncthreads();
            float mine = 0.f;
            { float s = S;
#pragma unroll
              for (int k = 0; k < 8; ++k) { const int w = cur.dir ? 7 - k : k; typedef float f32x2_ __attribute__((ext_vector_type(2))); const f32x2_ ab2 = *(const LAS f32x2_*)(agg + (w * 32 + r32) * 2);
                  mine = (w == wave) ? s : mine; s = ab2[0] * s + ab2[1]; }
              S = s; }
            if (cur.dir == 0) {
                { float s = mine;
#pragma unroll
                  for (int j = 0; j < 4; ++j) { const float slo = s; s = LA[j] * s + LB[j]; const float sup = s; s = UA[j] * s + UB[j]; st[j] = hi ? sup : slo; } }
#pragma unroll
                for (int j = 0; j < 4; ++j) { float hh = st[j];
#pragma unroll
                    for (int i = 0; i < 4; ++i) { hh = af[4 * j + i] * hh + bv[4 * j + i]; h[4 * j + i] = hh; } }
            } else {
                { float s = mine;
#pragma unroll
                  for (int j = 3; j >= 0; --j) { const float sup = s; s = UA[j] * s + UB[j]; const float slo = s; s = LA[j] * s + LB[j]; st[j] = hi ? sup : slo; } }
#pragma unroll
                for (int j = 0; j < 4; ++j) { float hh = st[j];
#pragma unroll
                    for (int i = 3; i >= 0; --i) { hh = af[4 * j + i] * hh + bv[4 * j + i]; h[4 * j + i] = hh; } }
            }
            if (!cur.isctx) {
                if (cur.dir == 0) {
#pragma unroll
                    for (int r = 0; r < 16; ++r) { const int tok = 32 * wave + (r & 3) + 8 * (r >> 2) + 4 * hi; hft[tok * 40 + r32] = (unsigned short)att::cvtpk_s(h[r], 0.f); }
                } else {
#pragma unroll
                    for (int r = 0; r < 16; ++r) { const int tok = 32 * wave + (r & 3) + 8 * (r >> 2) + 4 * hi;
                        const float gl = bf_lo((unsigned)glt[tok * 40 + r32]), hfv = bf_lo((unsigned)hft[tok * 40 + r32]); glt[tok * 40 + r32] = (unsigned short)att::cvtpk_s((hfv + h[r]) * gl, 0.f); }
                }
            }
            __syncthreads();
            { const unsigned e_ = (unsigned)((cur.tok0 + trow) * 1024 + 8 * tq); const LAS unsigned short* src = (cur.dir ? glt : hft) + trow * 40 + 8 * tq;
              bf16* op = cur.isctx ? dummy : (cur.dir == 0 ? HFb + e_ : GL + e_); *(GAS v4u*)op = *(const LAS v4u*)src; *(GAS v4u*)(op + (cur.isctx ? 8 : 128 * 1024)) = *(const LAS v4u*)(src + 128 * 40); }
        } }
#undef LRU_FETCH
    }
}

#define XB_TMO      128
#define XB_XCNT(j)  (256  + 64 * (j))
#define XB_XSUB(j)  (1280 + 64 * (j))
#define XB_XGEN(j)  (2304 + 64 * (j))
#define XB_TOP      3328
#define XB_TOPGEN   3392
#define XCD_BAR_WORDS 3456
#define XB_SPIN_CAP (1u << 18)

__device__ __forceinline__ unsigned xb_ld(unsigned* p)              { return __hip_atomic_load(p, __ATOMIC_RELAXED, __HIP_MEMORY_SCOPE_AGENT); }
__device__ __forceinline__ unsigned xb_add(unsigned* p, unsigned v) { return __hip_atomic_fetch_add(p, v, __ATOMIC_RELAXED, __HIP_MEMORY_SCOPE_AGENT); }
__device__ __forceinline__ unsigned xb_xcc_id() { return (unsigned)__builtin_amdgcn_s_getreg((3 << 11) | 20) & 0xFu; }
#define XB_SPIN(cond, bar) do { unsigned _sp = 0; while (cond) { __builtin_amdgcn_s_sleep(1); \
    if ((++_sp & 255u) == 0u) { if (xb_ld(&(bar)[XB_TMO])) break; if (_sp > XB_SPIN_CAP) { atomicAdd(&(bar)[XB_TMO], 1u); break; } } } } while (0)

struct XcdBarrier {
    unsigned* bar; unsigned x;
    volatile LAS unsigned* st;
};

__device__ __forceinline__ XcdBarrier xcd_barrier_post(unsigned* bar, volatile LAS unsigned* st) {
    XcdBarrier b; b.bar = bar; b.x = xb_xcc_id(); b.st = st;
    if (threadIdx.x == 0) (void)xb_add(&bar[XB_XCNT(b.x)], 1u);
    return b;
}
__device__ __forceinline__ void xcd_barrier_complete(unsigned* bar, unsigned x, unsigned& nloc, unsigned& nx) {
    const unsigned G = gridDim.x * gridDim.y * gridDim.z;
    unsigned sum, cnt, mine, sp = 0u;
    for (;;) {
        sum = 0u; cnt = 0u; mine = 0u;
#pragma unroll
        for (unsigned j = 0; j < 16; ++j) { const unsigned c = xb_ld(&bar[XB_XCNT(j)]); sum += c; cnt += (c > 0u) ? 1u : 0u; mine = (j == x) ? c : mine; }
        if (sum == G) break;
        __builtin_amdgcn_s_sleep(1);
        if ((++sp & 255u) == 0u) { if (xb_ld(&bar[XB_TMO])) break; if (sp > XB_SPIN_CAP) { atomicAdd(&bar[XB_TMO], 1u); break; } }
    }
    nloc = mine > 0u ? mine : 1u; nx = cnt > 0u ? cnt : 1u;
}

__device__ __forceinline__ void xcd_barrier(const XcdBarrier& b) {
    asm volatile("s_waitcnt vmcnt(0)" ::: "memory");
    __syncthreads();
    if (threadIdx.x == 0) {
        unsigned* bar = b.bar; unsigned bx = b.x; asm volatile("" : "+s"(bx), "+s"(bar));
        __builtin_amdgcn_s_waitcnt(0);
        unsigned nloc = b.st[0], nx = b.st[1];
        if (nloc == 0u) { xcd_barrier_complete(bar, bx, nloc, nx); b.st[0] = nloc; b.st[1] = nx; }
        const unsigned old = xb_add(&bar[XB_XSUB(bx)], 1u);
        const unsigned gen = old / nloc;
        if (old + 1u == (gen + 1u) * nloc) {
            __builtin_amdgcn_fence(__ATOMIC_RELEASE, "agent");
            asm volatile("s_waitcnt vmcnt(0)" ::: "memory");
            const unsigned og = xb_add(&bar[XB_TOP], 1u);
            const unsigned tg = og / nx;
            if (og + 1u == (tg + 1u) * nx) xb_add(&bar[XB_TOPGEN], 1u);
            else XB_SPIN(xb_ld(&bar[XB_TOPGEN]) == tg, bar);
            __builtin_amdgcn_fence(__ATOMIC_ACQUIRE, "agent");
            xb_add(&bar[XB_XGEN(bx)], 1u);
            asm volatile("s_waitcnt vmcnt(0)" ::: "memory");
        } else {
            XB_SPIN(xb_ld(&bar[XB_XGEN(bx)]) == gen, bar);
            __builtin_amdgcn_fence(__ATOMIC_ACQUIRE, "agent");
            asm volatile("s_waitcnt vmcnt(0)" ::: "memory");
        }
    }
    __syncthreads();
}

constexpr int MISC_OFF = 131072 + 320;
#define GSYNC() xcd_barrier(bar)
__device__ __forceinline__ void xl_barrier(Frame& F) {
    asm volatile("s_waitcnt vmcnt(0)" ::: "memory");
    __syncthreads();
    if (threadIdx.x == 0) { unsigned* cntw = (unsigned*)(F.ws + WS_CTL) + 56320 + 64 * F.xg; unsigned* relw = (unsigned*)(F.ws + WS_CTL) + 57344 + 64 * F.xg;
        __builtin_amdgcn_s_waitcnt(0);
        const unsigned old = __hip_atomic_fetch_add(cntw, 1u, __ATOMIC_RELAXED, __HIP_MEMORY_SCOPE_AGENT); const unsigned gen = old >> 5;
        if ((old & 31u) == 31u) __hip_atomic_fetch_add(relw, 1u, __ATOMIC_RELAXED, __HIP_MEMORY_SCOPE_AGENT);
        else { unsigned sp = 0; while (__hip_atomic_load(relw, __ATOMIC_RELAXED, __HIP_MEMORY_SCOPE_AGENT) <= gen) { __builtin_amdgcn_s_sleep(1); if (++sp > (1u << 22)) break; } }
        __builtin_amdgcn_fence(__ATOMIC_ACQUIRE, "agent"); asm volatile("s_waitcnt vmcnt(0)" ::: "memory"); }
    __syncthreads();
}
#define XSYNC() do { if (F.xm) xl_barrier(F); else xcd_barrier(bar); } while (0)

#define SB_XSUB(j, x) (((j) < 18 ? 32768 + (j) * 1152 : 98304 + ((j) - 18) * 1152) + 64 * (x))
#define SB_TOP(j)     SB_XSUB(j, 16)
__device__ __forceinline__ void sb_arrive(Frame& F, int j) {
    asm volatile("s_waitcnt vmcnt(0)" ::: "memory");
    __syncthreads();
    if (F.xm) { if (threadIdx.x == 0) { unsigned* ctl = (unsigned*)(F.ws + WS_CTL);
            const unsigned old = __hip_atomic_fetch_add(ctl + SB_XSUB(j, F.xg), 1u, __ATOMIC_RELAXED, __HIP_MEMORY_SCOPE_AGENT);
            if (old + 1u == 32u) __hip_atomic_store(ctl + SB_XSUB(j, F.xg + 8), 32u, __ATOMIC_RELAXED, __HIP_MEMORY_SCOPE_AGENT); }
        return; }
    if (threadIdx.x == 0) { unsigned* ctl = (unsigned*)(F.ws + WS_CTL); const unsigned x = xb_xcc_id(); const unsigned nloc = ((volatile LAS unsigned*)(F.lds + MISC_OFF))[0];
        const unsigned old = __hip_atomic_fetch_add(ctl + SB_XSUB(j, x), 1u, __ATOMIC_RELAXED, __HIP_MEMORY_SCOPE_AGENT);
        if (old + 1u == nloc) {
            __builtin_amdgcn_fence(__ATOMIC_RELEASE, "agent"); asm volatile("s_waitcnt vmcnt(0)" ::: "memory");
            __hip_atomic_fetch_add(ctl + SB_TOP(j), nloc, __ATOMIC_RELAXED, __HIP_MEMORY_SCOPE_AGENT); } }
}
__device__ __forceinline__ void sb_wait(Frame& F, int j) {
    if (threadIdx.x == 0) { unsigned* w = (unsigned*)(F.ws + WS_CTL) + (F.xm ? SB_XSUB(j, F.xg + 8) : SB_TOP(j)); unsigned sp = 0; const unsigned need = F.xm ? 32u : (unsigned)F.G;
        while (__hip_atomic_load(w, __ATOMIC_RELAXED, __HIP_MEMORY_SCOPE_AGENT) < need) { __builtin_amdgcn_s_sleep(8); if (++sp > (1u << 21)) break; }
        __builtin_amdgcn_fence(__ATOMIC_ACQUIRE, "agent"); asm volatile("s_waitcnt vmcnt(0)" ::: "memory"); }
    __syncthreads();
}

__device__ __forceinline__ LAS const float* rstd_table(Frame& F, int pm) {
    LAS float* tb = (LAS float*)(F.lds + 131072 + 1024); const int tid_ = fresh_tid(F.wave0);
#pragma unroll
    for (int t = 0; t < 2; ++t) { const int lane_ = tid_ & 63, w_ = tid_ >> 6; const int r = t * 128 + w_ * 16 + (lane_ & 15);
        const float rs = pg8::row_rstd_q(F.SSQ, pm * 256 + r, lane_ >> 4); if ((lane_ >> 4) == 0) tb[r] = rs; }
    __syncthreads(); return (LAS const float*)tb;
}
template <int L> __device__ __forceinline__ void p1_std(Frame& F, const Args& A_) {
    constexpr int N = L == 0 ? 3072 : L == 1 ? 1536 : L == 2 ? 1280 : 2048;
    const bf16* wt = F.WT + (L == 0 ? WO_QKV0 : L == 1 ? WO_QKV1 : L == 2 ? WO_QKV2 : WO_WIN3);
    pg8::Gemm g{F.XS, wt, MT, N, 1024, 0}; pg8::StaticOrder S; if (F.xm) S.init_x(MT, N, F.xg, F.lidx); else S.init(MT, N, F.G, (int)blockIdx.x);
    pg8::EpiProj<L> E{F.SSQ, F.BIAS + (size_t)L * BIAS_SLOT, N, F.R, L == 0 ? 16 : L == 1 ? 4 : 2, A_.in[15], A_.in[16], F.CS};
    pg8::gemm_phase<pg8::EpiProj<L>, pg8::StaticOrder, true, true>(F.lds, g, S, E, F.wave0);
}
template <int L> __device__ __forceinline__ void mixer(Frame& F, const Args& A_, const XcdBarrier& bar) {
    if constexpr (L < 3) attn_phase<L>(F, A_);
    else lru_sweeps(F, A_);
}
template <int L> __device__ __forceinline__ void tail_std(Frame& F, const Args& A_, const XcdBarrier& bar) {
    const float* mod = F.MOD + (size_t)L * 9 * 6144;
    constexpr int Mo = L == 3 ? ML : MT;
    {
        const bf16* A = L == 3 ? (const bf16*)(F.R + SL_GL) : (const bf16*)F.HF;
        const bf16* wt = F.WT + (L == 0 ? WO_WO0 : L == 1 ? WO_WO1 : L == 2 ? WO_WO2 : WO_WOUT3);
        pg8::Gemm g{A, wt, Mo, 1024, 1024, L == 3 ? SLAB : (size_t)0}; pg8::StaticOrder S; if (F.xm) S.init_x(Mo, 1024, F.xg, F.lidx); else S.init(Mo, 1024, F.G, (int)blockIdx.x);
        pg8::EpiResid<L == 0> E{F.HL, F.HC, mod + 2 * 1024, mod + 4 * 1024, A_.in[7] + L * 1024, F.XS, F.SSQ, L == 0 ? A_.in[0] : nullptr, L == 0 ? A_.in[2] : nullptr};
        E.ssl = (LAS float*)(F.lds + 131072 + 11264);
        pg8::gemm_phase<pg8::EpiResid<L == 0>, pg8::StaticOrder, true, true>(F.lds, g, S, E, F.wave0);
    }
    XSYNC();
    {
        pg8::Gemm g{F.XS, F.WT + WO_FIN + (size_t)L * 5632 * 1024, Mo, 5632, 1024, 0}; pg8::StaticOrder S; if (F.xm) S.init_x(Mo, 5632, F.xg, F.lidx); else S.init(Mo, 5632, F.G, (int)blockIdx.x);
        pg8::EpiSwiGLU E{F.SSQ, F.BIAS + (size_t)(4 + L) * BIAS_SLOT, F.R};
        { pg8::Unit u0; if (S.next(0, u0)) { E.rpm = u0.pm; E.rsl = rstd_table(F, u0.pm); } }
        pg8::gemm_phase<pg8::EpiSwiGLU, pg8::StaticOrder, true, true>(F.lds, g, S, E, F.wave0);
    }
    XSYNC();
    {
        pg8::Gemm g{(const bf16*)(F.R + SL_HM), F.WT + WO_FOUT + (size_t)L * 1024 * 2816, Mo, 1024, 2816, SLAB}; pg8::StaticOrder S; if (F.xm) S.init_x(Mo, 1024, F.xg, F.lidx); else S.init(Mo, 1024, F.G, (int)blockIdx.x);
        const float* modn = F.MOD + (size_t)(L + 1) * 9 * 6144;
        if constexpr (L == 3) { if (S.nwg == S.G) {
            pg8::EpiResidFinal EF{F.HL, F.out, mod + 5 * 1024, A_.in[8], (float*)(F.ws + WS_SSQ + 1 * MiB), (unsigned*)(F.ws + WS_CTL) + 61440};
            pg8::gemm_phase<pg8::EpiResidFinal, pg8::StaticOrder, false, true>(F.lds, g, S, EF, F.wave0);
            return; } }
        pg8::EpiResid<false> E{F.HL, F.HC, mod + 5 * 1024, L < 3 ? modn + 1024 : nullptr, A_.in[6] + (L < 3 ? (L + 1) * 1024 : 0), L < 3 ? F.XS : nullptr, F.SSQ};
        E.ssl = (LAS float*)(F.lds + 131072 + 11264);
        pg8::gemm_phase<pg8::EpiResid<false>, pg8::StaticOrder, true, true>(F.lds, g, S, E, F.wave0);
    }
    XSYNC();
    if constexpr (L == 3) p_final(F, A_);
}
template <int L> __device__ __forceinline__ void chain(Frame& F, const Args& A_, const XcdBarrier& bar) {
    const float* mod = F.MOD + (size_t)L * 9 * 6144;
    const int c = F.xm ? (F.lidx ^ 16) : (int)blockIdx.x, G = F.xm ? 32 : (int)F.G, J = 6 * L, H2 = G / 2;
    const int EA = 18 + 2 * L, EC = 19 + 2 * L;
    const int lp0 = F.xm ? 8 * F.xg : 0, lnM = F.xm ? 8 : 64, cp0 = F.xm ? 64 + F.xg : 64, cnM = F.xm ? 1 : 8, nr = F.xm;
    {
        const bf16* wt = F.WT + (L == 0 ? WO_WO0 : L == 1 ? WO_WO1 : WO_WO2);
        pg8::Gemm g{(const bf16*)F.HF, wt, MT, 1024, 1024, 0};
        pg8::EpiResid<L == 0> E{F.HL, F.HC, mod + 2 * 1024, mod + 4 * 1024, A_.in[7] + L * 1024, F.XS, F.SSQ, L == 0 ? A_.in[0] : nullptr, L == 0 ? A_.in[2] : nullptr};
        E.ssl = (LAS float*)(F.lds + 131072 + 11264);
        pg8::ListOrder Sl; Sl.init(lp0, lnM, 1024, G, c, 0, 0, nr);
        if (F.xm) sb_wait(F, EA);
        pg8::gemm_phase<pg8::EpiResid<L == 0>, pg8::ListOrder, true, true>(F.lds, g, Sl, E, F.wave0);
        sb_arrive(F, J + 0);
        pg8::ListOrder Sc; Sc.init(cp0, cnM, 1024, G, c, 0, 1, nr);
        if (F.xm && Sc.any()) sb_wait(F, EC);
        pg8::gemm_phase<pg8::EpiResid<L == 0>, pg8::ListOrder, true, true>(F.lds, g, Sc, E, F.wave0);
        sb_arrive(F, J + 1);
    }
    {
        pg8::Gemm g{F.XS, F.WT + WO_FIN + (size_t)L * 5632 * 1024, MT, 5632, 1024, 0};
        pg8::EpiSwiGLU E{F.SSQ, F.BIAS + (size_t)(4 + L) * BIAS_SLOT, F.R};
        pg8::ListOrder Sl; Sl.init(lp0, lnM, 5632, G, c, H2, 0, nr);
        sb_wait(F, J + 0);
        if (F.xm) sb_wait(F, EC);
        { pg8::Unit u0; if (Sl.next(0, u0)) { E.rpm = u0.pm; E.rsl = rstd_table(F, u0.pm); } }
        pg8::gemm_phase<pg8::EpiSwiGLU, pg8::ListOrder, true, true>(F.lds, g, Sl, E, F.wave0);
        sb_arrive(F, J + 2);
        pg8::ListOrder Sc; Sc.init(cp0, cnM, 5632, G, c, 0, 0, nr, F.xm ? 16 : -1);
        if (Sc.any()) sb_wait(F, J + 1);
        pg8::gemm_phase<pg8::EpiSwiGLU, pg8::ListOrder, true, true>(F.lds, g, Sc, E, F.wave0);
        sb_arrive(F, J + 3);
    }
    {
        pg8::Gemm g{(const bf16*)(F.R + SL_HM), F.WT + WO_FOUT + (size_t)L * 1024 * 2816, MT, 1024, 2816, SLAB};
        const float* modn = F.MOD + (size_t)(L + 1) * 9 * 6144;
        pg8::EpiResid<false> E{F.HL, F.HC, mod + 5 * 1024, modn + 1024, A_.in[6] + (L + 1) * 1024, F.XS, F.SSQ};
        E.ssl = (LAS float*)(F.lds + 131072 + 11264);
        pg8::ListOrder Sl; Sl.init(lp0, lnM, 1024, G, c, 0, 0, nr);
        sb_wait(F, J + 2);
        pg8::gemm_phase<pg8::EpiResid<false>, pg8::ListOrder, true, true>(F.lds, g, Sl, E, F.wave0);
        sb_arrive(F, J + 4);
        pg8::ListOrder Sc; Sc.init(cp0, cnM, 1024, G, c, F.xm ? 24 : (5 * G) / 16, 1, nr);
        if (Sc.any()) sb_wait(F, J + 3);
        pg8::gemm_phase<pg8::EpiResid<false>, pg8::ListOrder, true, true>(F.lds, g, Sc, E, F.wave0);
        sb_arrive(F, J + 5);
    }
    {
        constexpr int N = L == 0 ? 1536 : L == 1 ? 1280 : 2048;
        const bf16* wt = F.WT + (L == 0 ? WO_QKV1 : L == 1 ? WO_QKV2 : WO_WIN3);
        pg8::Gemm g{F.XS, wt, MT, N, 1024, 0};
        pg8::EpiProj<L + 1> E{F.SSQ, F.BIAS + (size_t)(L + 1) * BIAS_SLOT, N, F.R, L == 0 ? 4 : 2, A_.in[15], A_.in[16], F.CS};
        if constexpr (L < 2) {
            LAS float* tb = (LAS float*)(F.lds + 131072 + 2048); const int tid_ = fresh_tid(F.wave0);
            for (int i = tid_; i < 2048; i += 512) tb[i] = F.CS[i];
            if (tid_ < 64) { tb[2048 + tid_] = A_.in[15][tid_]; tb[2112 + tid_] = A_.in[16][tid_]; }
            __syncthreads(); E.tb = (LAS const float*)tb; }
        pg8::ListOrder Sl; if (L == 0 && F.xm) { const bool ex = c >= 8 && c < 16; Sl.init(lp0, lnM, ex ? 0 : N, 24, ex ? 0 : (c >= 16 ? c - 16 : c + 16), 0, 0, nr); }
        else Sl.init(lp0, lnM, N, G, c, F.xm ? (L == 1 ? 16 : 8) : 0, 0, nr);
        sb_wait(F, J + 4);
        { pg8::Unit u0; if (Sl.next(0, u0)) { E.rpm = u0.pm; E.rsl = rstd_table(F, u0.pm); } }
        pg8::gemm_phase<pg8::EpiProj<L + 1>, pg8::ListOrder, true, true>(F.lds, g, Sl, E, F.wave0);
        pg8::ListOrder Sc; Sc.init(cp0, cnM, N, G, c, F.xm ? (L >= 1 ? 8 : 24) : H2, (L >= 1 && F.xm) ? 1 : 0, nr);
        if (Sc.any()) sb_wait(F, J + 5);
        pg8::gemm_phase<pg8::EpiProj<L + 1>, pg8::ListOrder, true, true>(F.lds, g, Sc, E, F.wave0);
    }
    XSYNC();
}

__global__ void __launch_bounds__(NWAVES * 64, 2) fwd_kernel(Args args) {
    extern __shared__ __attribute__((aligned(16))) unsigned char lds[];
    Frame F;
    F.lds = (LAS unsigned char*)lds;
        F.wave0 = __builtin_amdgcn_readfirstlane(threadIdx.x >> 6);
    F.G = gridDim.x; { const int bx = blockIdx.x; F.vcu = (F.G % 8 == 0) ? (bx % 8) * (F.G / 8) + bx / 8 : bx; }
    F.out = args.out; F.ws = args.ws;
    F.MOD = (float*)(F.ws + WS_MOD); F.CS = (float*)(F.ws + WS_CS); F.BIAS = (float*)(F.ws + WS_BIAS); F.SSQ = (float*)(F.ws + WS_SSQ); F.HC = (bf16*)(F.ws + WS_HC); F.HL = (bf16*)(F.ws + WS_LRU);
    F.WT = (bf16*)(F.ws + WS_WT); F.XS = (bf16*)(F.ws + WS_XS); F.R = F.ws + WS_R; F.HF = (float*)(F.ws + WS_HF);
    if (threadIdx.x < 8) ((LAS unsigned*)(F.lds + MISC_OFF))[threadIdx.x] = 0u;
    __syncthreads();
    XcdBarrier bar; bar.bar = (unsigned*)(F.ws + WS_CTL) + 4096; bar.st = (volatile LAS unsigned*)(F.lds + MISC_OFF); bar.x = xb_xcc_id();
    if (threadIdx.x == 0) { const unsigned li = xb_add(&bar.bar[XB_XCNT(bar.x)], 1u); ((volatile LAS unsigned*)(F.lds + MISC_OFF))[3] = li; }
    __syncthreads();
    F.xg = (int)bar.x; F.lidx = __builtin_amdgcn_readfirstlane((int)((volatile LAS unsigned*)(F.lds + MISC_OFF))[3]); F.xm = 0;
    p0a(F, args); lru_wprep(F, args); convert_all_weights(F, args);
    GSYNC();
    if (XCDMODE) {
        if (threadIdx.x == 0) { unsigned ok = (F.G == 256) ? 1u : 0u;
            for (unsigned j = 0; j < 16; ++j) { const unsigned cj = xb_ld(&bar.bar[XB_XCNT(j)]); if (cj != (j < 8 ? 32u : 0u)) ok = 0u; }
            ((volatile LAS unsigned*)(F.lds + MISC_OFF))[4] = ok; }
        __syncthreads();
        F.xm = __builtin_amdgcn_readfirstlane((int)((volatile LAS unsigned*)(F.lds + MISC_OFF))[4]);
    }
    p0b(F, args); GSYNC();
    p1_std<0>(F, args); XSYNC(); mixer<0>(F, args, bar); if (!(CHAIN && F.xm)) XSYNC();
    if constexpr (CHAIN) { chain<0>(F, args, bar); } else { tail_std<0>(F, args, bar); p1_std<1>(F, args); XSYNC(); }
    mixer<1>(F, args, bar); if (!(CHAIN && F.xm)) XSYNC();
    if constexpr (CHAIN) { chain<1>(F, args, bar); } else { tail_std<1>(F, args, bar); p1_std<2>(F, args); XSYNC(); }
    mixer<2>(F, args, bar); if (!(CHAIN && F.xm)) XSYNC();
    if constexpr (CHAIN) { chain<2>(F, args, bar); } else { tail_std<2>(F, args, bar); p1_std<3>(F, args); XSYNC(); }
    mixer<3>(F, args, bar); XSYNC();
    tail_std<3>(F, args, bar);
}

extern "C" void kernel_launch(void* const* d_in, const int* in_sizes, int n_in, void* d_out, int out_size, void* d_ws, size_t ws_size, hipStream_t stream) {
    static int grid = 0;
    if (grid == 0) {
        if (n_in != 30 || out_size != ML * DM || ws_size < WS_END) { fprintf(stderr, "kernel_launch: unexpected shapes (n_in %d out %d ws %zu); nothing launched\n", n_in, out_size, ws_size); grid = -1; return; }
        int dev = 0, cus = 0, per_cu = 0;
        if (hipGetDevice(&dev) != hipSuccess || hipDeviceGetAttribute(&cus, hipDeviceAttributeMultiprocessorCount, dev) != hipSuccess) { grid = -1; return; }
        if (hipFuncSetAttribute((const void*)fwd_kernel, hipFuncAttributeMaxDynamicSharedMemorySize, LDS_BYTES) != hipSuccess) { fprintf(stderr, "kernel_launch: hipFuncSetAttribute failed\n"); grid = -1; return; }
        if (hipOccupancyMaxActiveBlocksPerMultiprocessor(&per_cu, (const void*)fwd_kernel, NWAVES * 64, LDS_BYTES) != hipSuccess || per_cu < 1) { fprintf(stderr, "kernel_launch: occupancy query says %d\n", per_cu); per_cu = 1; }
        (void)hipGetLastError();
        grid = cus * (per_cu > 1 ? 1 : per_cu);
    }
    if (grid < 0) return;
    if (hipMemsetAsync((char*)d_ws + WS_CTL, 0, CTL_ZERO_BYTES, stream) != hipSuccess) { fprintf(stderr, "kernel_launch: memset failed\n"); return; }
    Args a{};
    for (int i = 0; i < 30; ++i) a.in[i] = (const float*)d_in[i];
    a.out = (float*)d_out; a.ws = (unsigned char*)d_ws;
    void* kargs[] = {&a};
    const hipError_t e = hipLaunchCooperativeKernel((const void*)fwd_kernel, dim3(grid), dim3(NWAVES * 64), kargs, LDS_BYTES, stream);
    if (e != hipSuccess) fprintf(stderr, "kernel_launch: cooperative launch failed: %s (grid %d)\n", hipGetErrorString(e), grid);
}
```

```cpp
#include <hip/hip_runtime.h>
#include <cstdio>
#include <cstdint>

constexpr int DM = 1024, NB = 8, SEQ = 2048, CTXL = 256, HD = 64, FF = 2816, NMOD = 6;
constexpr int ML = NB * SEQ;
constexpr int MC = NB * CTXL;
constexpr int MT = ML + MC;
constexpr float LOG2E = 1.4426950408889634f;
constexpr float QSCALE = 0.125f * LOG2E;
constexpr size_t SLAB = 14155776;
constexpr size_t SL_Q = 0, SL_K = 4718592, SL_V = 9437184;
constexpr size_t SL_HM = 0;
constexpr size_t SL_XR = 0, SL_GL = 4718592;
__host__ __device__ __forceinline__ int pan_b(int pm) { return pm < 64 ? pm >> 3 : pm - 64; }
__host__ __device__ __forceinline__ int pan_p(int pm) { return pm < 64 ? pm & 7 : 8; }
__device__ __forceinline__ int fresh_tid(int wave0) { int l; asm volatile("v_mbcnt_lo_u32_b32 %0, -1, 0\n\tv_mbcnt_hi_u32_b32 %0, -1, %0" : "=v"(l)); return wave0 * 64 + l; }
namespace pg8 {
#define PG8_LAS __attribute__((address_space(3)))
typedef unsigned short bf16_t;
typedef short bf16x8 __attribute__((ext_vector_type(8)));
typedef float f32x4 __attribute__((ext_vector_type(4)));
typedef unsigned u32x4 __attribute__((ext_vector_type(4)));
constexpr int BM = 256, BK = 64, HALF = 128, HTB = HALF * BK * 2  , STAGE_BYTES = 8 * HTB, NXCD = 8, WGM = 8;

__host__ __device__ __forceinline__ int lds_byte(int r, int c) { const int st = (r >> 4) * 2 + (c >> 5), rr = r & 15, cc = c & 31, ob = rr * 64 + cc * 2; return st * 1024 + (ob ^ (((ob >> 9) & 1) << 5)); }
__host__ __device__ __forceinline__ void stage_rc(int b, int& R, int& C) { const int st = b / 1024, sb = b % 1024, swz = sb ^ (((sb >> 9) & 1) << 5); R = (st >> 1) * 16 + swz / 64; C = (st & 1) * 32 + (swz % 64) / 2; }
__host__ __device__ __forceinline__ int perm32(int rho) { const int n = rho >> 4, i = rho & 15; return 8 * (i >> 2) + 4 * n + (i & 3); }

struct Unit { int pm, pn, hm; };
struct Gemm { const bf16_t* A; const bf16_t* Bt; int M, N, K; size_t slab;
    __device__ __forceinline__ const char* abase(int pm, size_t tstep) const { return slab ? (const char*)A + (size_t)pan_b(pm) * slab + (size_t)pan_p(pm) * tstep : (const char*)A + (size_t)pm * tstep; } };

struct StaticOrder {
    int nM, nN, nwg, G, c, xm, xg;
    __host__ __device__ void init(int M, int N, int G_, int c_) { nM = M / BM; nN = N / BM; nwg = nM * nN; G = G_; c = c_; xm = 0; xg = 0; }
    __host__ __device__ void init_x(int M, int N, int x, int lidx) { nM = M / BM == 72 ? 9 : 8; nN = N / BM; nwg = nM * nN; G = 32; c = lidx; xm = 1; xg = x; }
    __host__ __device__ bool next(int i, Unit& u) const {
        const long L0 = (long)i * G + c; const int nfull = (nwg / G) * G, rem = nwg - nfull; const bool halves = rem > 0 && 2 * rem <= G;
        long L = L0; u.hm = -1;
        if (halves && L0 >= nfull) { const long t = L0 - nfull; if (t >= 2 * rem) return false; L = nfull + (t >> 1); u.hm = (int)(t & 1); }
        if (L >= nwg) return false;
        if (xm) { const int p = (int)L % nM; u.pn = (int)L / nM; u.pm = p < 8 ? 8 * xg + p : 64 + xg; return true; }
        int wgid = (int)L; { const int q = nwg / NXCD, r = nwg % NXCD, xcd = wgid % NXCD, off = wgid / NXCD; wgid = (xcd < r ? xcd * (q + 1) : r * (q + 1) + (xcd - r) * q) + off; }
        const int nig = WGM * nN, gid = wgid / nig, fm = gid * WGM, gsz = (nM - fm) < WGM ? (nM - fm) : WGM;
        u.pm = fm + ((wgid % nig) % gsz); u.pn = (wgid % nig) / gsz; return true;
    }
    __device__ __forceinline__ void a_ready(const Unit&) const {}
    __device__ __forceinline__ void done(const Unit&) const {}
};

__device__ __forceinline__ unsigned cvt_pk_bf16(float lo, float hi) { unsigned r; asm volatile("v_cvt_pk_bf16_f32 %0, %1, %2" : "=v"(r) : "v"(lo), "v"(hi)); return r; }
typedef float f32x2 __attribute__((ext_vector_type(2)));
struct ListOrder {
    int pm0, nM, nN, nwg, G, r, nfull, noremap;
    __host__ __device__ void init(int pm0_, int nM_, int N, int G_, int c_, int rot, int halves_, int noremap_ = 0, int nfull_ = -1) { pm0 = pm0_; nM = nM_; nN = N / BM; nwg = nM * nN; G = G_; r = (c_ + rot) % G_;
        nfull = nfull_ >= 0 ? nfull_ : (halves_ ? 0 : nwg); noremap = noremap_; }
    __host__ __device__ bool next(int i, Unit& u) const {
        long L = (long)i * G + r; u.hm = -1;
        if (L >= nfull) { const long t = L - nfull; if (t >= 2 * (nwg - nfull)) return false; u.hm = (int)(t & 1); L = nfull + (t >> 1); }
        if (L >= nwg) return false;
        if (noremap) { u.pm = pm0 + (int)L % nM; u.pn = (int)L / nM; return true; }
        int wgid = (int)L; { const int q = nwg / NXCD, rr = nwg % NXCD, xcd = wgid % NXCD, off = wgid / NXCD; wgid = (xcd < rr ? xcd * (q + 1) : rr * (q + 1) + (xcd - rr) * q) + off; }
        const int nig = WGM * nN, gid = wgid / nig, fm = gid * WGM, gsz = (nM - fm) < WGM ? (nM - fm) : WGM;
        u.pm = pm0 + fm + ((wgid % nig) % gsz); u.pn = (wgid % nig) / gsz; return true;
    }
    __host__ __device__ bool any() const { return r < nfull + 2 * (nwg - nfull); }
    __device__ __forceinline__ void a_ready(const Unit&) const {}
    __device__ __forceinline__ void done(const Unit&) const {}
};

__device__ __forceinline__ float bperm_f(int src_lane, float v) { return __builtin_bit_cast(float, __builtin_amdgcn_ds_bpermute(src_lane << 2, __builtin_bit_cast(int, v))); }
__device__ __forceinline__ int mod_row(int pm) { return pm < 64 ? (pm >> 3) : 8; }
__device__ __forceinline__ float row_rstd(const float* ssq, int row) {
    const f32x4 s = *(const f32x4*)(ssq + (size_t)row * 4);
    return rsqrtf(((s[0] + s[1]) + (s[2] + s[3])) * (1.0f / 1024.0f) + 1e-6f);
}
__device__ __forceinline__ float fq_sum(float t) {
    { auto r = __builtin_amdgcn_permlane16_swap(__float_as_uint(t), __float_as_uint(t), false, false); t = __uint_as_float(r[0]) + __uint_as_float(r[1]); }
    { auto r = __builtin_amdgcn_permlane32_swap(__float_as_uint(t), __float_as_uint(t), false, false); t = __uint_as_float(r[0]) + __uint_as_float(r[1]); }
    return t;
}
__device__ __forceinline__ float row_rstd_q(const float* ssq, int row, int fq) {
    (void)fq; const f32x4 p = *(const f32x4*)(ssq + (size_t)row * 4);
    const float t = (p[0] + p[1]) + (p[2] + p[3]);
    return rsqrtf(t * (1.0f / 1024.0f) + 1e-6f);
}
__device__ __forceinline__ void st_bf16x4(bf16_t* p, f32x4 v) { typedef unsigned u32x2 __attribute__((ext_vector_type(2))); u32x2 w; w.x = cvt_pk_bf16(v[0], v[1]); w.y = cvt_pk_bf16(v[2], v[3]); *(u32x2*)p = w; }
__device__ __forceinline__ void st_bf16x8_pair(bf16_t* p, f32x4 v0, f32x4 v1, int fq) {
    unsigned a0 = cvt_pk_bf16(v0[0], v0[1]), a1 = cvt_pk_bf16(v0[2], v0[3]), b0 = cvt_pk_bf16(v1[0], v1[1]), b1 = cvt_pk_bf16(v1[2], v1[3]);
    auto rx = __builtin_amdgcn_permlane16_swap(a0, b0, false, false); auto ry = __builtin_amdgcn_permlane16_swap(a1, b1, false, false);
    typedef unsigned u32x4_ __attribute__((ext_vector_type(4))); u32x4_ w; w.x = rx[0]; w.y = ry[0]; w.z = rx[1]; w.w = ry[1];
    *(u32x4_*)(p + (fq & 1) * 16 + (fq >> 1) * 8) = w;
}
__device__ __forceinline__ void ld_bf16x8_pair(const bf16_t* p, int fq, f32x4& v0, f32x4& v1) {
    typedef unsigned u32x4_ __attribute__((ext_vector_type(4))); const u32x4_ w = *(const u32x4_*)(p + (fq & 1) * 16 + (fq >> 1) * 8);
    auto rx = __builtin_amdgcn_permlane16_swap(w.x, w.z, false, false); auto ry = __builtin_amdgcn_permlane16_swap(w.y, w.w, false, false);
    v0[0] = __builtin_bit_cast(float, rx[0] << 16); v0[1] = __builtin_bit_cast(float, rx[0] & 0xffff0000u); v0[2] = __builtin_bit_cast(float, ry[0] << 16); v0[3] = __builtin_bit_cast(float, ry[0] & 0xffff0000u);
    v1[0] = __builtin_bit_cast(float, rx[1] << 16); v1[1] = __builtin_bit_cast(float, rx[1] & 0xffff0000u); v1[2] = __builtin_bit_cast(float, ry[1] << 16); v1[3] = __builtin_bit_cast(float, ry[1] & 0xffff0000u);
}
__device__ __forceinline__ float gelu_tanh(float x) { const float z = 0.7978845608028654f * (x + 0.044715f * x * x * x); const float t = 1.0f - 2.0f * __builtin_amdgcn_rcpf(__builtin_amdgcn_exp2f(2.8853900817779268f * z) + 1.0f); return 0.5f * x * (1.0f + t); }

template <int KIND>
struct EpiProj {
    static constexpr bool PERM = false, AFTER_DRAIN = false;
    const float* ssq; const float* bias; int N;
    unsigned char* R; int nk;
    const float* qgain; const float* kgain; const float* cs;
    PG8_LAS const float* rsl = nullptr; int rpm = -1;
    PG8_LAS const float* tb = nullptr;
    __device__ __forceinline__ void operator()(const f32x4 (&acc)[2][2][4][2], const Unit& u, int wr, int wc, int fr, int fq) const {
        asm volatile("" : "+v"(fr), "+v"(fq));
        const int rm = mod_row(u.pm); const bool lat = u.pm < 64;
        const int g = 4 * u.pn + wc;
        const int tcol = u.pn * BM + wc * 32 + 4 * fq;
        unsigned char* Rb = R + (size_t)pan_b(u.pm) * SLAB; const int lr0 = (pan_p(u.pm) - u.pm) * BM;
        f32x4 bv[2][2];
#pragma unroll
        for (int bj = 0; bj < 2; ++bj)
#pragma unroll
            for (int n = 0; n < 2; ++n) bv[bj][n] = *(const f32x4*)(bias + (size_t)rm * N + tcol + bj * HALF + n * 16);
        if constexpr (KIND == 3) {
#pragma unroll
            for (int ai = 0; ai < 2; ++ai) { if (ai > 0 && u.hm >= 0) continue;
                asm volatile("" ::: "memory"); float rsv[4];
                if (rsl != nullptr && u.pm == rpm) {
#pragma unroll
                    for (int m_ = 0; m_ < 4; ++m_) rsv[m_] = rsl[(u.hm > 0 ? HALF : 0) + ai * HALF + wr * 64 + m_ * 16 + fr];
                } else {
                rsv[0] = row_rstd_q(ssq, u.pm * BM + (u.hm > 0 ? HALF : 0) + ai * HALF + wr * 64 + 0 * 16 + fr, fq); rsv[1] = row_rstd_q(ssq, u.pm * BM + (u.hm > 0 ? HALF : 0) + ai * HALF + wr * 64 + 1 * 16 + fr, fq); asm volatile("" ::: "memory"); rsv[2] = row_rstd_q(ssq, u.pm * BM + (u.hm > 0 ? HALF : 0) + ai * HALF + wr * 64 + 2 * 16 + fr, fq); rsv[3] = row_rstd_q(ssq, u.pm * BM + (u.hm > 0 ? HALF : 0) + ai * HALF + wr * 64 + 3 * 16 + fr, fq);
                }
#pragma unroll
                for (int m = 0; m < 4; ++m) { const int row = u.pm * BM + (u.hm > 0 ? HALF : 0) + ai * HALF + wr * 64 + m * 16 + fr; const float rs = rsv[m];
#pragma unroll
                    for (int bj = 0; bj < 2; ++bj) { f32x4 v2[2];
#pragma unroll
                        for (int n = 0; n < 2; ++n) { const f32x4 v = acc[ai][bj][m][n] * rs + bv[bj][n];
                            if (g < 16) v2[n] = v; else { v2[n][0] = gelu_tanh(v[0]); v2[n][1] = gelu_tanh(v[1]); v2[n][2] = gelu_tanh(v[2]); v2[n][3] = gelu_tanh(v[3]); } }
                        st_bf16x8_pair((g < 16 ? (bf16_t*)(Rb + SL_XR) + g * 64 : (bf16_t*)(Rb + SL_GL) + (g - 16) * 64) + (size_t)(row + lr0) * 1024 + 32 * bj, v2[0], v2[1], fq); } } }
        } else {
            const int slot = g < 16 ? 0 : (g < 16 + nk ? 1 : 2);
            bf16_t* dst; int ld;
            if (slot == 0) { dst = (bf16_t*)(Rb + SL_Q) + g * 64; ld = 1024; } else if (slot == 1) { dst = (bf16_t*)(Rb + SL_K) + (g - 16) * 64; ld = 64 * nk; } else { dst = (bf16_t*)(Rb + SL_V) + (g - 16 - nk) * 64; ld = 64 * nk; }
            const float* gp_ = slot == 0 ? qgain : kgain;
            const float osc = slot == 0 ? QSCALE : 1.0f;
#pragma unroll
            for (int ai = 0; ai < 2; ++ai) { if (ai > 0 && u.hm >= 0) continue;
                asm volatile("" ::: "memory"); float rsv[4];
                if (rsl != nullptr && u.pm == rpm) {
#pragma unroll
                    for (int m_ = 0; m_ < 4; ++m_) rsv[m_] = rsl[(u.hm > 0 ? HALF : 0) + ai * HALF + wr * 64 + m_ * 16 + fr];
                } else {
                rsv[0] = row_rstd_q(ssq, u.pm * BM + (u.hm > 0 ? HALF : 0) + ai * HALF + wr * 64 + 0 * 16 + fr, fq); rsv[1] = row_rstd_q(ssq, u.pm * BM + (u.hm > 0 ? HALF : 0) + ai * HALF + wr * 64 + 1 * 16 + fr, fq); asm volatile("" ::: "memory"); rsv[2] = row_rstd_q(ssq, u.pm * BM + (u.hm > 0 ? HALF : 0) + ai * HALF + wr * 64 + 2 * 16 + fr, fq); rsv[3] = row_rstd_q(ssq, u.pm * BM + (u.hm > 0 ? HALF : 0) + ai * HALF + wr * 64 + 3 * 16 + fr, fq);
                }
#pragma unroll
                for (int m = 0; m < 4; ++m) { const int row = u.pm * BM + (u.hm > 0 ? HALF : 0) + ai * HALF + wr * 64 + m * 16 + fr; const float rs = rsv[m];
                    f32x4 v[2][2];
#pragma unroll
                    for (int bj = 0; bj < 2; ++bj)
#pragma unroll
                        for (int n = 0; n < 2; ++n) v[bj][n] = acc[ai][bj][m][n] * rs + bv[bj][n];
                    if constexpr (KIND == 1) { if (slot != 2) {
                        float s = 0.f;
#pragma unroll
                        for (int bj = 0; bj < 2; ++bj)
#pragma unroll
                            for (int n = 0; n < 2; ++n) { const f32x4 x = v[bj][n]; s += (x[0] * x[0] + x[1] * x[1]) + (x[2] * x[2] + x[3] * x[3]); }
                        s = fq_sum(s);
                        const float r = rsqrtf(s * (1.0f / 64.0f) + 1e-6f);
#pragma unroll
                        for (int bj = 0; bj < 2; ++bj)
#pragma unroll
                            for (int n = 0; n < 2; ++n) v[bj][n] = v[bj][n] * r * (*(const PG8_LAS f32x4*)(tb + (slot == 0 ? 2048 : 2112) + 32 * bj + 16 * n + 4 * fq)); } }
                    if constexpr (KIND == 1 || KIND == 2) { if (slot != 2 && lat) {
                        const int t = row & 2047;
#pragma unroll
                        for (int bj = 0; bj < 2; ++bj) { const int pos = bj == 0 ? (t >> 6) : (t & 63);
                            const f32x4 c01 = *(const PG8_LAS f32x4*)(tb + (pos * 16 + 4 * fq) * 2), c23 = *(const PG8_LAS f32x4*)(tb + (pos * 16 + 4 * fq) * 2 + 4);
                            const f32x4 co = {c01[0], c01[2], c23[0], c23[2]}, si = {c01[1], c01[3], c23[1], c23[3]};
                            const f32x4 x1 = v[bj][0], x2 = v[bj][1];
                            v[bj][0] = x1 * co - x2 * si; v[bj][1] = x1 * si + x2 * co; } } }
#pragma unroll
                    for (int bj = 0; bj < 2; ++bj) {
                        if (slot == 1) {
                            const int lrow = row + lr0, chunk = 4 * bj + 2 * (fq & 1) + (fq >> 1);
                            bf16_t* kp = (bf16_t*)(Rb + SL_K) + ((size_t)(((g - 16) * 36 + (lrow >> 6)) * 8 + chunk) * 64 + (lrow & 63)) * 8 - ((fq & 1) * 16 + (fq >> 1) * 8);
                            st_bf16x8_pair(kp, v[bj][0] * osc, v[bj][1] * osc, fq);
                        } else st_bf16x8_pair(dst + (size_t)(row + lr0) * ld + 32 * bj, v[bj][0] * osc, v[bj][1] * osc, fq); } } }
        }
    }
};

struct EpiSwiGLU {
    static constexpr bool PERM = false, AFTER_DRAIN = false;
    const float* ssq; const float* bias; unsigned char* R;
    PG8_LAS const float* rsl = nullptr; int rpm = -1;
    __device__ __forceinline__ void operator()(const f32x4 (&acc)[2][2][4][2], const Unit& u, int wr, int wc, int fr, int fq) const {
        asm volatile("" : "+v"(fr), "+v"(fq));
        const int rm = mod_row(u.pm); const int tcol = u.pn * BM + wc * 32 + 4 * fq;
        f32x4 bv[2][2];
#pragma unroll
        for (int bj = 0; bj < 2; ++bj)
#pragma unroll
            for (int n = 0; n < 2; ++n) bv[bj][n] = *(const f32x4*)(bias + (size_t)rm * (2 * FF) + tcol + bj * HALF + n * 16);
#pragma unroll
        for (int ai = 0; ai < 2; ++ai) { if (ai > 0 && u.hm >= 0) continue;
            asm volatile("" ::: "memory"); float rsv[4];
            if (rsl != nullptr && u.pm == rpm) {
#pragma unroll
                for (int m = 0; m < 4; ++m) rsv[m] = rsl[(u.hm > 0 ? HALF : 0) + ai * HALF + wr * 64 + m * 16 + fr];
            } else {
#pragma unroll
            for (int m = 0; m < 4; ++m) rsv[m] = row_rstd_q(ssq, u.pm * BM + (u.hm > 0 ? HALF : 0) + ai * HALF + wr * 64 + m * 16 + fr, fq); }
#pragma unroll
            for (int m = 0; m < 4; ++m) { const int row = u.pm * BM + (u.hm > 0 ? HALF : 0) + ai * HALF + wr * 64 + m * 16 + fr; const float rs = rsv[m];
                f32x4 o2[2];
#pragma unroll
                for (int n = 0; n < 2; ++n) { const f32x4 a = acc[ai][0][m][n] * rs + bv[0][n], gg = acc[ai][1][m][n] * rs + bv[1][n];
#pragma unroll
                    for (int e = 0; e < 4; ++e) o2[n][e] = a[e] * __builtin_amdgcn_rcpf(1.0f + __builtin_amdgcn_exp2f(-1.4426950408889634f * a[e])) * gg[e]; }
                st_bf16x8_pair((bf16_t*)(R + (size_t)pan_b(u.pm) * SLAB + SL_HM) + (size_t)(row + (pan_p(u.pm) - u.pm) * BM) * FF + u.pn * 128 + wc * 32, o2[0], o2[1], fq); } }
    }
};

template <bool F32IN>
struct EpiResid {
    static constexpr bool PERM = false, AFTER_DRAIN = false;
    bf16_t* Hl; bf16_t* Hc; const float* gate; const float* nsc; const float* ng; bf16_t* XS; float* ssq;
    const float* Rl = nullptr; const float* Rc = nullptr;
    PG8_LAS float* ssl = nullptr;
    __device__ __forceinline__ void operator()(const f32x4 (&acc)[2][2][4][2], const Unit& u, int wr, int wc, int fr, int fq) const {
        asm volatile("" : "+v"(fr), "+v"(fq));
        const int rm = mod_row(u.pm);
        bf16_t* Hb = u.pm < 64 ? Hl + (size_t)u.pm * BM * 1024 : Hc + (size_t)(u.pm - 64) * BM * 1024;
        const float* Rb = F32IN ? (u.pm < 64 ? Rl + (size_t)u.pm * BM * 1024 : Rc + (size_t)(u.pm - 64) * BM * 1024) : nullptr;
        const int col0 = u.pn * BM + wc * 32 + 4 * fq; const int cst = u.pn * BM + wc * 32;
        f32x4 gt[2][2], gs[2][2];
#pragma unroll
        for (int bj = 0; bj < 2; ++bj)
#pragma unroll
            for (int n = 0; n < 2; ++n) { const int col = col0 + bj * HALF + n * 16; gt[bj][n] = *(const f32x4*)(gate + (size_t)rm * 6144 + col);
                if (XS) gs[bj][n] = *(const f32x4*)(ng + col) * (*(const f32x4*)(nsc + (size_t)rm * 6144 + col) + 1.0f); else gs[bj][n] = (f32x4){0.f, 0.f, 0.f, 0.f}; }
#pragma unroll
        for (int ai = 0; ai < 2; ++ai) { if (ai > 0 && u.hm >= 0) continue;
#pragma unroll
          for (int mh = 0; mh < 2; ++mh) {
            asm volatile("" ::: "memory");
            const int rl0 = (u.hm > 0 ? HALF : 0) + ai * HALF + wr * 64 + mh * 32 + fr;
            f32x4 hv[2][2][2];
#pragma unroll
            for (int m = 0; m < 2; ++m)
#pragma unroll
                for (int bj = 0; bj < 2; ++bj) {
                    if constexpr (F32IN) {
#pragma unroll
                        for (int n = 0; n < 2; ++n) hv[m][bj][n] = __builtin_nontemporal_load((const f32x4*)(Rb + (size_t)(rl0 + m * 16) * 1024 + col0 + bj * HALF + n * 16));
                    } else ld_bf16x8_pair(Hb + (size_t)(rl0 + m * 16) * 1024 + cst + bj * HALF, fq, hv[m][bj][0], hv[m][bj][1]); }
            float ssv[2];
#pragma unroll
            for (int m = 0; m < 2; ++m) { const int rl = rl0 + m * 16; const int row = u.pm * BM + rl; float ss = 0.f;
#pragma unroll
                for (int bj = 0; bj < 2; ++bj) { f32x4 xo[2], ho[2];
#pragma unroll
                    for (int n = 0; n < 2; ++n) {
                        const f32x4 hn = hv[m][bj][n] + gt[bj][n] * acc[ai][bj][2 * mh + m][n]; ho[n] = hn;
                        ss += (hn[0] * hn[0] + hn[1] * hn[1]) + (hn[2] * hn[2] + hn[3] * hn[3]);
                        xo[n] = hn * gs[bj][n]; }
                    st_bf16x8_pair(Hb + (size_t)rl * 1024 + cst + bj * HALF, ho[0], ho[1], fq);
                    if (XS) st_bf16x8_pair(XS + (size_t)row * 1024 + cst + bj * HALF, xo[0], xo[1], fq); }
                ssv[m] = fq_sum(ss); }
            if (fq == 0) {
#pragma unroll
                for (int m = 0; m < 2; ++m) ssl[(wr * 4 + wc) * 128 + ai * 64 + mh * 32 + m * 16 + fr] = ssv[m]; } } }
        asm volatile("s_waitcnt lgkmcnt(0)" ::: "memory"); __builtin_amdgcn_s_barrier(); asm volatile("" ::: "memory");
        if (wc == 0) { const int lane_ = fq * 16 + fr;
#pragma unroll
            for (int t = 0; t < 2; ++t) { const int rr = lane_ + 64 * t;
                if (t == 0 || u.hm < 0) { const float tot = (ssl[(wr * 4 + 0) * 128 + rr] + ssl[(wr * 4 + 1) * 128 + rr]) + (ssl[(wr * 4 + 2) * 128 + rr] + ssl[(wr * 4 + 3) * 128 + rr]);
                    const int rl = (u.hm > 0 ? HALF : 0) + (rr >> 6) * HALF + wr * 64 + (rr & 63);
                    ssq[(size_t)(u.pm * BM + rl) * 4 + u.pn] = tot; } } }
    }
};

struct EpiResidFinal {
    static constexpr bool PERM = false, AFTER_DRAIN = true;
    const bf16_t* H; float* out; const float* gate; const float* gfin; float* ssqx; unsigned* cnt;
    __device__ __forceinline__ void fused(f32x4 (&acc)[2][2][4][2], const Unit& u, int wr, int wc, int fr, int fq, PG8_LAS unsigned char* lds, int wid, int lane) const {
        asm volatile("" : "+v"(fr), "+v"(fq));
        const int rm = mod_row(u.pm); const bf16_t* Hb = H + (size_t)u.pm * BM * 1024; const int col0 = u.pn * BM + wc * 32 + 4 * fq; const int cst = u.pn * BM + wc * 32;
        f32x4 gt[2][2];
#pragma unroll
        for (int bj = 0; bj < 2; ++bj)
#pragma unroll
            for (int n = 0; n < 2; ++n) gt[bj][n] = *(const f32x4*)(gate + (size_t)rm * 6144 + col0 + bj * HALF + n * 16);
#pragma unroll
        for (int ai = 0; ai < 2; ++ai)
#pragma unroll
            for (int mh = 0; mh < 2; ++mh) { asm volatile("" ::: "memory");
                const int rl0 = ai * HALF + wr * 64 + mh * 32 + fr; f32x4 hv[2][2][2];
#pragma unroll
                for (int m = 0; m < 2; ++m)
#pragma unroll
                    for (int bj = 0; bj < 2; ++bj) ld_bf16x8_pair(Hb + (size_t)(rl0 + m * 16) * 1024 + cst + bj * HALF, fq, hv[m][bj][0], hv[m][bj][1]);
#pragma unroll
                for (int m = 0; m < 2; ++m) { float ss = 0.f;
#pragma unroll
                    for (int bj = 0; bj < 2; ++bj)
#pragma unroll
                        for (int n = 0; n < 2; ++n) { const f32x4 hn = hv[m][bj][n] + gt[bj][n] * acc[ai][bj][2 * mh + m][n]; acc[ai][bj][2 * mh + m][n] = hn;
                            ss += (hn[0] * hn[0] + hn[1] * hn[1]) + (hn[2] * hn[2] + hn[3] * hn[3]); }
                    ss = fq_sum(ss);
                    if (fq == 0) __hip_atomic_store(ssqx + (size_t)(u.pm * BM + rl0 + m * 16) * 16 + 4 * u.pn + wc, ss, __ATOMIC_RELAXED, __HIP_MEMORY_SCOPE_AGENT); } }
        asm volatile("s_waitcnt vmcnt(0)" ::: "memory");
        if (lane == 0) __hip_atomic_fetch_add(cnt + 64 * u.pm, 1u, __ATOMIC_RELAXED, __HIP_MEMORY_SCOPE_AGENT);
        if (wid == 0) { unsigned sp = 0;
            while ((unsigned)__builtin_amdgcn_readfirstlane(__hip_atomic_load(cnt + 64 * u.pm, __ATOMIC_RELAXED, __HIP_MEMORY_SCOPE_AGENT)) < 32u) { __builtin_amdgcn_s_sleep(2); if (++sp > (1u << 21)) break; }
            __builtin_amdgcn_fence(__ATOMIC_ACQUIRE, "agent"); asm volatile("s_waitcnt vmcnt(0)" ::: "memory"); }
        asm volatile("s_waitcnt lgkmcnt(0)" ::: "memory"); __builtin_amdgcn_s_barrier(); asm volatile("" ::: "memory");
        f32x4 gf[2][2];
#pragma unroll
        for (int bj = 0; bj < 2; ++bj)
#pragma unroll
            for (int n = 0; n < 2; ++n) gf[bj][n] = *(const f32x4*)(gfin + col0 + bj * HALF + n * 16);
#pragma unroll
        for (int ai = 0; ai < 2; ++ai) { asm volatile("" ::: "memory"); float rsv[4];
#pragma unroll
            for (int m = 0; m < 4; ++m) { const unsigned long long* sp8 = (const unsigned long long*)(ssqx + (size_t)(u.pm * BM + ai * HALF + wr * 64 + m * 16 + fr) * 16); float t = 0.f;
#pragma unroll
                for (int q = 0; q < 8; ++q) { const unsigned long long w = __hip_atomic_load(sp8 + q, __ATOMIC_RELAXED, __HIP_MEMORY_SCOPE_AGENT); t += __uint_as_float((unsigned)w) + __uint_as_float((unsigned)(w >> 32)); }
                rsv[m] = rsqrtf(t * (1.0f / 1024.0f) + 1e-6f); }
#pragma unroll
            for (int m = 0; m < 4; ++m) { const int row = u.pm * BM + ai * HALF + wr * 64 + m * 16 + fr;
#pragma unroll
                for (int bj = 0; bj < 2; ++bj)
#pragma unroll
                    for (int n = 0; n < 2; ++n) __builtin_nontemporal_store(acc[ai][bj][m][n] * rsv[m] * gf[bj][n], (f32x4*)(out + (size_t)row * 1024 + col0 + bj * HALF + n * 16)); } }
    }
    __device__ __forceinline__ void operator()(const f32x4 (&)[2][2][4][2], const Unit&, int, int, int, int) const {}
};

template <class Epi, class Sched, bool ALIGN_EPI = false, bool SP2 = false>
__device__ __forceinline__ void gemm_phase(PG8_LAS unsigned char* lds, const Gemm g, const Sched& S, const Epi& E, const int wave0) {
    const int tid = fresh_tid(wave0), wid = __builtin_amdgcn_readfirstlane(tid >> 6), lane = tid & 63, wr = wid >> 2, wc = wid & 3, fr = lane & 15, fq = lane >> 4;
    const int K = g.K, nt = K / BK;
    unsigned voffA[2], voffB[2];
#pragma unroll
    for (int i = 0; i < 2; ++i) { int R, C; stage_rc(tid * 16 + i * 8192, R, C); const int Rb = Epi::PERM ? ((R & ~31) + perm32(R & 31)) : R;
        voffA[i] = (unsigned)(R * K + C) * 2u; voffB[i] = (unsigned)(Rb * K + C) * 2u; }
    const size_t kstep = (size_t)(BK * 2);
    const size_t hstep = (size_t)HALF * K * 2;
    const size_t tstep = 2 * hstep;
    const unsigned ldsw = (unsigned)wid * 1024u;
    const int aoff = lds_byte(wr * 64 + fr, fq * 8), boff = lds_byte(wc * 32 + fr, fq * 8);
#define PG8_SA(b, h) (((b) * 2 + (h)) * HTB)
#define PG8_SB(b, h) ((4 + (b) * 2 + (h)) * HTB)
#define PG8_STAGE(bufoff, gbase, voff) do { _Pragma("unroll") for (int _i = 0; _i < 2; ++_i) \
        __builtin_amdgcn_global_load_lds((const unsigned*)((const char*)(gbase) + (voff)[_i]), (PG8_LAS unsigned*)(lds + (bufoff) + ldsw + _i * 8192), 16, 0, 0); } while (0)
#define PG8_LDA(dst, b, h) do { _Pragma("unroll") for (int m = 0; m < 4; ++m) _Pragma("unroll") for (int k = 0; k < 2; ++k) dst[m][k] = *(const PG8_LAS bf16x8*)(lds + PG8_SA(b, h) + aoff + m * 2048 + k * 1024); } while (0)
#define PG8_LDB(dst, b, h) do { _Pragma("unroll") for (int n = 0; n < 2; ++n) _Pragma("unroll") for (int k = 0; k < 2; ++k) dst[n][k] = *(const PG8_LAS bf16x8*)(lds + PG8_SB(b, h) + boff + n * 2048 + k * 1024); } while (0)
#define PG8_MMA(ai, bj, At, Bt) do { __builtin_amdgcn_s_setprio(1); _Pragma("unroll") for (int m = 0; m < 4; ++m) _Pragma("unroll") for (int n = 0; n < 2; ++n) _Pragma("unroll") for (int k = 0; k < 2; ++k) \
        acc[ai][bj][m][n] = __builtin_amdgcn_mfma_f32_16x16x32_bf16(Bt[n][k], At[m][k], acc[ai][bj][m][n], 0, 0, 0); __builtin_amdgcn_s_setprio(0); } while (0)
#define PG8_WAIT_V(n) asm volatile("s_waitcnt vmcnt(" #n ")" ::: "memory")
#define PG8_WAIT_L(n) asm volatile("s_waitcnt lgkmcnt(" #n ")" ::: "memory")
#define PG8_BAR __builtin_amdgcn_s_barrier()
#define PG8_SCHED __builtin_amdgcn_sched_barrier(0)
    Unit cur, nxt; int ui = 0;
    if (!S.next(0, cur)) return;
    f32x4 acc[2][2][4][2];
#pragma unroll
    for (int a = 0; a < 2; ++a)
#pragma unroll
        for (int b = 0; b < 2; ++b)
#pragma unroll
            for (int m = 0; m < 4; ++m)
#pragma unroll
                for (int n = 0; n < 2; ++n) acc[a][b][m][n] = (f32x4){0.f, 0.f, 0.f, 0.f};
    bf16x8 At[4][2], B0[2][2], B1[2][2];
    static_assert(SP2, "half units are wired into the SP2 loop only");
    const char* cA = g.abase(cur.pm, tstep) + (cur.hm > 0 ? hstep : 0); const char* cB = (const char*)g.Bt + (size_t)cur.pn * tstep;
    size_t cAh = cur.hm >= 0 ? 0 : hstep;
    S.a_ready(cur);
    if constexpr (SP2) {
        PG8_STAGE(PG8_SB(0, 0), cB, voffB); PG8_STAGE(PG8_SB(0, 1), cB + hstep, voffB); PG8_STAGE(PG8_SA(0, 0), cA, voffA); PG8_STAGE(PG8_SA(0, 1), cA + cAh, voffA);
        if (wr == 1) PG8_BAR;
        PG8_WAIT_V(2); PG8_BAR;
        PG8_STAGE(PG8_SB(1, 0), cB + kstep, voffB); PG8_STAGE(PG8_SA(1, 0), cA + kstep, voffA); PG8_STAGE(PG8_SB(1, 1), cB + hstep + kstep, voffB);
        PG8_WAIT_V(6); PG8_BAR;
    } else {
        PG8_STAGE(PG8_SB(0, 0), cB, voffB); PG8_STAGE(PG8_SA(0, 0), cA, voffA); PG8_STAGE(PG8_SB(0, 1), cB + hstep, voffB); PG8_STAGE(PG8_SA(0, 1), cA + hstep, voffA);
        if (wr == 1) PG8_BAR;
        PG8_WAIT_V(4); PG8_BAR;
        PG8_STAGE(PG8_SB(1, 0), cB + kstep, voffB); PG8_STAGE(PG8_SA(1, 0), cA + kstep, voffA); PG8_STAGE(PG8_SB(1, 1), cB + hstep + kstep, voffB);
        PG8_WAIT_V(6); PG8_BAR;
    }
    for (;;) {
        const bool has_next = S.next(ui + 1, nxt);
        const char* nA = has_next ? g.abase(nxt.pm, tstep) + (nxt.hm > 0 ? hstep : 0) : cA; const char* nB = has_next ? (const char*)g.Bt + (size_t)nxt.pn * tstep : cB;
        const size_t nAh = has_next ? (nxt.hm >= 0 ? 0 : hstep) : cAh; const bool cfull = cur.hm < 0;
        for (int t = 0; t < nt; t += 2) {
            const bool last = (t == nt - 2);
            int tq = t; asm volatile("" : "+s"(tq));
            const char* a1 = cA + (size_t)(tq + 1) * kstep;
            const char* a2 = last ? nA : cA + (size_t)(tq + 2) * kstep; const char* b2 = last ? nB : cB + (size_t)(tq + 2) * kstep;
            const char* a3 = a2 + kstep; const char* b3 = b2 + kstep;
            const size_t a2h = last ? nAh : cAh;
            if (last && has_next) S.a_ready(nxt);
            if constexpr (SP2) {
            PG8_LDB(B0, 0, 0); PG8_LDB(B1, 0, 1); PG8_SCHED; PG8_LDA(At, 0, 0); PG8_STAGE(PG8_SA(1, 1), a1 + cAh, voffA);
            PG8_WAIT_V(8); PG8_WAIT_L(0); PG8_BAR; PG8_MMA(0, 0, At, B0); PG8_MMA(0, 1, At, B1); PG8_BAR; PG8_SCHED;
            if (cfull) PG8_LDA(At, 0, 1); PG8_STAGE(PG8_SB(0, 0), b2, voffB); PG8_STAGE(PG8_SB(0, 1), b2 + hstep, voffB); PG8_STAGE(PG8_SA(0, 0), a2, voffA);
            PG8_WAIT_V(8); PG8_WAIT_L(0); PG8_BAR; if (cfull) { PG8_MMA(1, 0, At, B0); PG8_MMA(1, 1, At, B1); } PG8_BAR; PG8_SCHED;
            PG8_LDB(B0, 1, 0); PG8_LDB(B1, 1, 1); PG8_SCHED; PG8_LDA(At, 1, 0); PG8_STAGE(PG8_SA(0, 1), a2 + a2h, voffA);
            PG8_WAIT_V(8); PG8_WAIT_L(0); PG8_BAR; PG8_MMA(0, 0, At, B0); PG8_MMA(0, 1, At, B1); PG8_BAR; PG8_SCHED;
            if (cfull) PG8_LDA(At, 1, 1); PG8_STAGE(PG8_SB(1, 0), b3, voffB); PG8_STAGE(PG8_SB(1, 1), b3 + hstep, voffB); PG8_STAGE(PG8_SA(1, 0), a3, voffA);
            PG8_WAIT_V(8); PG8_WAIT_L(0); PG8_BAR; if (cfull) { PG8_MMA(1, 0, At, B0); PG8_MMA(1, 1, At, B1); } PG8_BAR; PG8_SCHED;
            } else {
            PG8_LDB(B0, 0, 0); PG8_SCHED; PG8_LDA(At, 0, 0); PG8_STAGE(PG8_SA(1, 1), a1 + hstep, voffA);
            PG8_WAIT_L(8); PG8_BAR; PG8_WAIT_L(0); PG8_MMA(0, 0, At, B0); PG8_BAR; PG8_SCHED;
            PG8_LDB(B1, 0, 1); PG8_STAGE(PG8_SB(0, 0), b2, voffB);
            PG8_BAR; PG8_WAIT_L(0); PG8_MMA(0, 1, At, B1); PG8_BAR;
            PG8_LDA(At, 0, 1); PG8_STAGE(PG8_SA(0, 0), a2, voffA);
            PG8_BAR; PG8_WAIT_L(0); PG8_MMA(1, 0, At, B0); PG8_BAR; PG8_SCHED;
            PG8_STAGE(PG8_SB(0, 1), b2 + hstep, voffB);
            PG8_WAIT_V(6); PG8_BAR; PG8_MMA(1, 1, At, B1); PG8_BAR;
            PG8_LDB(B0, 1, 0); PG8_SCHED; PG8_LDA(At, 1, 0); PG8_STAGE(PG8_SA(0, 1), a2 + hstep, voffA);
            PG8_WAIT_L(8); PG8_BAR; PG8_WAIT_L(0); PG8_MMA(0, 0, At, B0); PG8_BAR; PG8_SCHED;
            PG8_LDB(B1, 1, 1); PG8_STAGE(PG8_SB(1, 0), b3, voffB);
            PG8_BAR; PG8_WAIT_L(0); PG8_MMA(0, 1, At, B1); PG8_BAR;
            PG8_LDA(At, 1, 1); PG8_STAGE(PG8_SA(1, 0), a3, voffA);
            PG8_BAR; PG8_WAIT_L(0); PG8_MMA(1, 0, At, B0); PG8_BAR; PG8_SCHED;
            PG8_STAGE(PG8_SB(1, 1), b3 + hstep, voffB);
            PG8_WAIT_V(6); PG8_BAR; PG8_MMA(1, 1, At, B1); PG8_BAR;
            }
        }
        if constexpr (ALIGN_EPI) { if (wr == 0) PG8_BAR; }
        if constexpr (!Epi::AFTER_DRAIN) { E(acc, cur, wr, wc, fr, fq); S.done(cur); }
        if (!has_next) break;
#pragma unroll
        for (int a = 0; a < 2; ++a)
#pragma unroll
            for (int b = 0; b < 2; ++b)
#pragma unroll
                for (int m = 0; m < 4; ++m)
#pragma unroll
                    for (int n = 0; n < 2; ++n) acc[a][b][m][n] = (f32x4){0.f, 0.f, 0.f, 0.f};
        cur = nxt; cA = nA; cB = nB; cAh = nAh; ++ui;
        if constexpr (ALIGN_EPI) { if (wr == 1) PG8_BAR; }
    }
    PG8_WAIT_V(0);
    if constexpr (!ALIGN_EPI) { if (wr == 0) PG8_BAR; }
    PG8_BAR;
    if constexpr (Epi::AFTER_DRAIN) { E.fused(acc, cur, wr, wc, fr, fq, lds, wid, lane); S.done(cur); }
#undef PG8_SA
#undef PG8_SB
#undef PG8_STAGE
#undef PG8_LDA
#undef PG8_LDB
#undef PG8_MMA
#undef PG8_WAIT_V
#undef PG8_WAIT_L
#undef PG8_BAR
#undef PG8_SCHED
}
}
#define GAS __attribute__((address_space(1)))
#define LAS __attribute__((address_space(3)))
typedef unsigned short bf16;
typedef unsigned v4u __attribute__((ext_vector_type(4)));
typedef float f32x4 __attribute__((ext_vector_type(4)));
constexpr int NWAVES = 8;
constexpr bool MFMA_ATTN[3] = {true, true, true};
constexpr bool LRU_MFMA = true;
constexpr bool XCDMODE = true;
constexpr bool CHAIN = true;
constexpr int PROBE_DUP_PRO = 1;
constexpr int PROBE_DUP_ATT = 1;
constexpr int PROBE_DUP_P3 = 1, PROBE_DUP_P4 = 1, PROBE_DUP_P5 = 1;
constexpr int PROBE_DUP_ATTN_ONLY[3] = {1, 1, 1};
constexpr int LDS_BYTES = 147456;
constexpr size_t MiB = 1u << 20;
constexpr size_t WS_CTL = 0, CTL_ZERO_BYTES = 1 * MiB;
constexpr size_t WS_MOD = 1 * MiB;
constexpr size_t WS_CS = 2 * MiB;
constexpr size_t WS_BIAS = 3 * MiB;
constexpr size_t BIAS_SLOT = 9 * 5632;
constexpr size_t WS_SSQ = 5 * MiB;
constexpr size_t WS_HC = 8 * MiB;
constexpr size_t WS_WT = 16 * MiB;
constexpr size_t WS_XS = 106 * MiB;
constexpr size_t WS_R = 142 * MiB;
constexpr size_t R3 = 36 * MiB;
constexpr size_t WS_HF = 250 * MiB;
constexpr size_t WS_LRU = 314 * MiB;
constexpr size_t WS_END = 346 * MiB;
constexpr size_t WO_QKV0 = 0, WO_WO0 = WO_QKV0 + 3072 * 1024, WO_QKV1 = WO_WO0 + 1024 * 1024, WO_WO1 = WO_QKV1 + 1536 * 1024, WO_QKV2 = WO_WO1 + 1024 * 1024,
                 WO_WO2 = WO_QKV2 + 1280 * 1024, WO_WIN3 = WO_WO2 + 1024 * 1024, WO_WOUT3 = WO_WIN3 + 2048 * 1024, WO_FIN = WO_WOUT3 + 1024 * 1024,
                 WO_FOUT = WO_FIN + 4 * (size_t)5632 * 1024, WO_END = WO_FOUT + 4 * (size_t)1024 * 2816;
static_assert(WO_END * 2 <= 90 * MiB, "weight region");

struct Args { const float* in[30]; float* out; unsigned char* ws; };

struct Frame {
    LAS unsigned char* lds; int vcu, G, wave0; int xm, xg, lidx;
    float* out; unsigned char* ws;
    float* MOD; float* CS; float* BIAS; float* SSQ; bf16* HC; bf16* HL; bf16* WT; bf16* XS; unsigned char* R; float* HF;
};
#define PHASE_IDS() const int tid = fresh_tid(F.wave0), lane = tid & 63, wave = __builtin_amdgcn_readfirstlane(tid >> 6); (void)tid; (void)lane; (void)wave
#define LDS_WAIT() asm volatile("s_waitcnt lgkmcnt(0)" ::: "memory")
__device__ __forceinline__ unsigned f2bf(float f) { unsigned u = __builtin_bit_cast(unsigned, f); return (u + 0x7fffu + ((u >> 16) & 1u)) >> 16; }
__device__ __forceinline__ unsigned pk2(float lo, float hi) { return f2bf(lo) | (f2bf(hi) << 16); }
__device__ __forceinline__ float bf_lo(unsigned w) { return __builtin_bit_cast(float, w << 16); }
__device__ __forceinline__ float bf_hi(unsigned w) { return __builtin_bit_cast(float, w & 0xffff0000u); }
__device__ __forceinline__ float wave_sum(float v, int lane) {
#pragma unroll
    for (int o = 1; o < 64; o <<= 1) v += pg8::bperm_f(lane ^ o, v);
    return v;
}
__device__ __forceinline__ float silu_f(float x) { return x / (1.0f + __expf(-x)); }

__device__ __forceinline__ int perm_row32(int perm, int n0) {
    if (perm == 1) { const int t = n0 >> 8, w = n0 & 255; return (t << 8) + (((w >> 5) & 1) << 7) + (((w >> 6) & 3) << 5); }
    if (perm == 2) { const int half = n0 >= FF ? 1 : 0; const int i = half ? n0 - FF : n0; return ((i >> 7) << 8) + (half << 7) + (i & 127); }
    return n0;
}
__device__ __forceinline__ void p0_transpose_item(const float* W, int K, int N, bf16* WT, int perm, LAS float* scr, int item, int lane) {
    const int nblk = N / 32, kb = item / nblk, nb = item % nblk, k0 = 64 * kb, n0 = 32 * nb;
    const int orow = perm_row32(perm, n0);
    float wv[32];
#pragma unroll
    for (int i = 0; i < 32; ++i) wv[i] = W[(size_t)(k0 + 2 * i + (lane >> 5)) * N + n0 + (lane & 31)];
#pragma unroll
    for (int i = 0; i < 32; ++i) scr[(2 * i + (lane >> 5)) * 33 + (lane & 31)] = wv[i];
    LDS_WAIT(); asm volatile("" ::: "memory");
    const int c = lane & 7;
#pragma unroll
    for (int j = 0; j < 4; ++j) { const int n = (lane >> 3) + 8 * j; const LAS float* s = scr + (8 * c) * 33 + n;
        v4u o; o.x = pk2(s[0 * 33], s[1 * 33]); o.y = pk2(s[2 * 33], s[3 * 33]); o.z = pk2(s[4 * 33], s[5 * 33]); o.w = pk2(s[6 * 33], s[7 * 33]);
        *(GAS v4u*)(WT + (size_t)(orow + n) * K + k0 + 8 * c) = o; }
    LDS_WAIT(); asm volatile("" ::: "memory");
}
struct WDesc { const float* W; bf16* WT; int K, N, perm; };
__device__ __forceinline__ WDesc wdesc(const Frame& F, const Args& A_, int i) {
    WDesc d;
    switch (i) {
    case 0: d = {A_.in[11], F.WT + WO_QKV0, 1024, 3072, 1}; break;
    case 1: d = {A_.in[13], F.WT + WO_WO0, 1024, 1024, 0}; break;
    case 2: d = {A_.in[14], F.WT + WO_QKV1, 1024, 1536, 1}; break;
    case 3: d = {A_.in[17], F.WT + WO_WO1, 1024, 1024, 0}; break;
    case 4: d = {A_.in[18], F.WT + WO_QKV2, 1024, 1280, 1}; break;
    case 5: d = {A_.in[20], F.WT + WO_WO2, 1024, 1024, 0}; break;
    case 6: d = {A_.in[21], F.WT + WO_WIN3, 1024, 2048, 1}; break;
    case 7: d = {A_.in[29], F.WT + WO_WOUT3, 1024, 1024, 0}; break;
    case 8: case 9: case 10: case 11: d = {A_.in[9] + (size_t)(i - 8) * 1024 * 5632, F.WT + WO_FIN + (size_t)(i - 8) * 5632 * 1024, 1024, 5632, 2}; break;
    default: d = {A_.in[10] + (size_t)(i - 12) * 2816 * 1024, F.WT + WO_FOUT + (size_t)(i - 12) * 1024 * 2816, 2816, 1024, 0}; break;
    }
    return d;
}
__device__ __forceinline__ void p0a(Frame& F, const Args& A_) {
    PHASE_IDS();
    LAS float* sl = (LAS float*)F.lds;
    LAS float* red = (LAS float*)(F.lds + 40960);
#pragma unroll
    for (int j = 0; j < 5; ++j) { const int i4 = (tid + 512 * j) * 4;
        if (i4 < 9 * 1024) { const f32x4 v = i4 < 8192 ? *(const f32x4*)(A_.in[1] + i4) : *(const f32x4*)(A_.in[3] + (i4 - 8192));
            f32x4 o; o[0] = silu_f(v[0]); o[1] = silu_f(v[1]); o[2] = silu_f(v[2]); o[3] = silu_f(v[3]); *(LAS f32x4*)(sl + i4) = o; } }
    __syncthreads();
    for (int u = blockIdx.x; u < 4 * 64; u += F.G) {
        const int l = u >> 6, jb = u & 63; const int lc = lane < 48 ? lane : 47;
        const float* w = A_.in[4] + (size_t)l * 1024 * 6144 + jb * 96 + 2 * lc;
        float a0[9], a1[9];
#pragma unroll
        for (int r = 0; r < 9; ++r) { a0[r] = 0.f; a1[r] = 0.f; }
        const int kb = wave * 128;
#pragma unroll 16
        for (int k = 0; k < 128; ++k) { typedef float f32x2 __attribute__((ext_vector_type(2))); const f32x2 wv = __builtin_nontemporal_load((const f32x2*)(w + (size_t)(kb + k) * 6144));
#pragma unroll
            for (int r = 0; r < 9; ++r) { const float sv = sl[r * 1024 + kb + k]; a0[r] += sv * wv[0]; a1[r] += sv * wv[1]; } }
        if (lane < 48) {
#pragma unroll
            for (int r = 0; r < 9; ++r) { red[(wave * 9 + r) * 96 + 2 * lane] = a0[r]; red[(wave * 9 + r) * 96 + 2 * lane + 1] = a1[r]; } }
        __syncthreads();
        for (int i = tid; i < 9 * 96; i += 512) { const int r = i / 96, j = i % 96; float sm = 0.f;
#pragma unroll
            for (int wv = 0; wv < 8; ++wv) sm += red[(wv * 9 + r) * 96 + j];
            F.MOD[((size_t)l * 9 + r) * 6144 + jb * 96 + j] = sm + A_.in[5][(size_t)l * 6144 + jb * 96 + j]; }
        __syncthreads();
    }
    if (blockIdx.x < 16 && tid < 64) for (int i = blockIdx.x * 64 + tid; i < 64 * 16; i += 1024) { const int pos = i >> 4, j = i & 15; const float inv = 1.0f / powf(10000.0f, (float)(2 * j) / 32.0f); const float ang = (float)pos * inv;
        F.CS[2 * i] = cosf(ang); F.CS[2 * i + 1] = sinf(ang); }
    __syncthreads();
}
struct CItem { const float* src; bf16* dst; int N, K; };
__device__ __forceinline__ CItem citem(const Frame& F, const Args& A_, int gidx) {
    int i = 0, r = gidx;
#pragma unroll 1
    for (; i < 15; ++i) { const WDesc d = wdesc(F, A_, i); const int nit = (d.K / 64) * (d.N / 32); if (r < nit) break; r -= nit; }
    const WDesc d = wdesc(F, A_, i); const int nblk = d.N / 32, kb = r / nblk, nb = r % nblk, k0 = 64 * kb, n0 = 32 * nb;
    CItem c; c.src = d.W + (size_t)k0 * d.N + n0; c.dst = d.WT + (size_t)perm_row32(d.perm, n0) * d.K + k0; c.N = d.N; c.K = d.K; return c;
}
__device__ __forceinline__ void convert_all_weights(Frame& F, const Args& A_) {
    PHASE_IDS();
    LAS float* scr = (LAS float*)(F.lds + wave * 8704);
    constexpr int TOTAL = 1536 + 512 + 768 + 512 + 640 + 512 + 1024 + 512 + 4 * 2816 + 4 * 1408;
    const int gw = F.vcu * NWAVES + wave, NGW = F.G * NWAVES;
    if (gw >= TOTAL) return;
    CItem cur = citem(F, A_, gw);
    float wv[32];
#pragma unroll
    for (int i = 0; i < 32; ++i) wv[i] = __builtin_nontemporal_load(cur.src + (size_t)(2 * i + (lane >> 5)) * cur.N + (lane & 31));
#pragma unroll 1
    for (int g = gw; g < TOTAL; g += NGW) {
#pragma unroll
        for (int i = 0; i < 32; ++i) scr[(2 * i + (lane >> 5)) * 33 + (lane & 31)] = wv[i];
        const CItem me = cur;
        if (g + NGW < TOTAL) { cur = citem(F, A_, g + NGW);
#pragma unroll
            for (int i = 0; i < 32; ++i) wv[i] = __builtin_nontemporal_load(cur.src + (size_t)(2 * i + (lane >> 5)) * cur.N + (lane & 31)); }
        LDS_WAIT(); asm volatile("" ::: "memory");
        const int c = lane & 7;
#pragma unroll
        for (int j = 0; j < 4; ++j) { const int n = (lane >> 3) + 8 * j; const LAS float* sp = scr + (8 * c) * 33 + n;
            v4u o; o.x = pk2(sp[0 * 33], sp[1 * 33]); o.y = pk2(sp[2 * 33], sp[3 * 33]); o.z = pk2(sp[4 * 33], sp[5 * 33]); o.w = pk2(sp[6 * 33], sp[7 * 33]);
            *(GAS v4u*)(me.dst + (size_t)n * me.K + 8 * c) = o; }
        LDS_WAIT(); asm volatile("" ::: "memory");
    }
}

__device__ __forceinline__ void bias_layer(Frame& F, int l0, int l1, int rank, int count) {
    PHASE_IDS();
    typedef short bf16x8 __attribute__((ext_vector_type(8)));
    LAS unsigned short* shb = (LAS unsigned short*)F.lds;
    int ubase = 0;
#pragma unroll 1
    for (int gi = 2 * l0; gi < 2 * l1; ++gi) {
        const int layer = gi >> 1; const int g = (gi & 1) == 0 ? layer : 4 + layer, l = layer; const int N = g >= 4 ? 5632 : (g == 0 ? 3072 : g == 1 ? 1536 : g == 2 ? 1280 : 2048);
        const bf16* wt = F.WT + (g >= 4 ? WO_FIN + (size_t)l * 5632 * 1024 : (g == 0 ? WO_QKV0 : g == 1 ? WO_QKV1 : g == 2 ? WO_QKV2 : WO_WIN3));
        const int shoff = g >= 4 ? 3 * 1024 : 0; const int nun = N / 128;
        for (int uu = ubase + ((rank - ubase % count + count) % count); uu < ubase + nun; uu += count) {
            const int ch = uu - ubase;
            __syncthreads();
#pragma unroll
            for (int j = 0; j < 8; ++j) { const int i = tid + 512 * j; const int r = i >> 8, k4 = (i & 255) * 4; typedef unsigned u32x2_ __attribute__((ext_vector_type(2))); u32x2_ w = {0u, 0u};
                if (r < 9) { const f32x4 v = *(const f32x4*)(F.MOD + ((size_t)l * 9 + r) * 6144 + shoff + k4); w.x = pk2(v[0], v[1]); w.y = pk2(v[2], v[3]); }
                *(LAS u32x2_*)(shb + r * 1032 + k4) = w; }
            __syncthreads();
            const int n0 = ch * 128 + wave * 16; const bf16* wp = wt + (size_t)(n0 + (lane & 15)) * 1024 + 8 * (lane >> 4);
            f32x4 acc = {0.f, 0.f, 0.f, 0.f};
#pragma unroll 16
            for (int st = 0; st < 32; ++st) { const bf16x8 b = *(const bf16x8*)(wp + 32 * st); const bf16x8 a = *(const LAS bf16x8*)(shb + (lane & 15) * 1032 + 32 * st + 8 * (lane >> 4));
                acc = __builtin_amdgcn_mfma_f32_16x16x32_bf16(a, b, acc, 0, 0, 0); }
#pragma unroll
            for (int e = 0; e < 4; ++e) { const int r = 4 * (lane >> 4) + e; if (r < 9) F.BIAS[(size_t)g * BIAS_SLOT + (size_t)r * N + n0 + (lane & 15)] = acc[e]; }
        }
        ubase += nun;
    }
    __syncthreads();
}
__device__ __forceinline__ void p0b(Frame& F, const Args& A_) {
    bias_layer(F, 0, 4, (int)blockIdx.x, (int)F.G);
    PHASE_IDS();
    const int gw = F.vcu * NWAVES + wave, NGW = F.G * NWAVES;
    for (int row0 = gw; row0 < MT; row0 += 3 * NGW) {
        f32x4 v[3][4];
#pragma unroll
        for (int q = 0; q < 3; ++q) { const int row = row0 + q * NGW; if (row < MT) { const bool lat = row < ML; const float* src = lat ? A_.in[0] + (size_t)row * 1024 : A_.in[2] + (size_t)(row - ML) * 1024;
#pragma unroll
            for (int j = 0; j < 4; ++j) v[q][j] = *(const f32x4*)(src + 256 * j + 4 * lane); } }
#pragma unroll
        for (int q = 0; q < 3; ++q) { const int row = row0 + q * NGW; if (row < MT) { const bool lat = row < ML; const int rm = lat ? (row >> 11) : 8;
            const float* sc = F.MOD + (size_t)rm * 6144 + 1024; const float* ng = A_.in[6];
            float sq = 0.f;
#pragma unroll
            for (int j = 0; j < 4; ++j) { const int col = 256 * j + 4 * lane; const f32x4 x = v[q][j];
                sq += (x[0] * x[0] + x[1] * x[1]) + (x[2] * x[2] + x[3] * x[3]);
                const f32x4 o = x * (*(const f32x4*)(ng + col)) * (*(const f32x4*)(sc + col) + 1.0f);
                typedef unsigned u32x2 __attribute__((ext_vector_type(2))); u32x2 w; w.x = pk2(o[0], o[1]); w.y = pk2(o[2], o[3]); *(u32x2*)(F.XS + (size_t)row * 1024 + col) = w; }
            sq = wave_sum(sq, lane);
            if (lane < 4) F.SSQ[(size_t)row * 4 + lane] = lane == 0 ? sq : 0.f; } }
    }
}
__device__ __forceinline__ void p_final(Frame& F, const Args& A_) {
    PHASE_IDS();
    const int gw = F.vcu * NWAVES + wave, NGW = F.G * NWAVES;
    for (int row = gw; row < ML; row += NGW) {
        const float rs = pg8::row_rstd(F.SSQ, row); float* p = F.out + (size_t)row * 1024; const bf16* hp = F.HL + (size_t)row * 1024;
#pragma unroll
        for (int j = 0; j < 4; ++j) { const int col = 256 * j + 4 * lane; typedef unsigned u32x2_ __attribute__((ext_vector_type(2))); const u32x2_ w = *(const u32x2_*)(hp + col);
            const f32x4 hv = {bf_lo(w.x), __builtin_bit_cast(float, w.x & 0xffff0000u), bf_lo(w.y), __builtin_bit_cast(float, w.y & 0xffff0000u)};
            *(f32x4*)(p + col) = hv * rs * (*(const f32x4*)(A_.in[8] + col)); }
    }
}
namespace att {
typedef unsigned short bf16;
using bf16x8=__attribute__((ext_vector_type(8)))short;
using s16x4=__attribute__((ext_vector_type(4)))short;
using f32x16=__attribute__((ext_vector_type(16)))float;
using u32x4=__attribute__((ext_vector_type(4)))unsigned;
constexpr int D=64,NW=8,QBLK=32,QB=QBLK*NW,KVBLK=64,QP=1024;
__device__ __forceinline__ int crow(int r,int hi){return (r&3)+8*(r>>2)+4*hi;}
#define SBAR() __builtin_amdgcn_sched_barrier(0)
constexpr int NSLOT=3, SLOTB=8192;
constexpr int LDS_K=0, LDS_V=NSLOT*SLOTB, LDS_WS=2*NSLOT*SLOTB, LDS_OST=LDS_WS+NW*64*4, LDS_BYTES=LDS_OST+NW*4096;
constexpr int LDS_RPB=86016;
struct Job { const bf16* Q; bf16* O; const bf16* Kc; const bf16* Vc; const bf16* Kl; const bf16* Vl; int NT; int lat; int qpos0; int kt0; int h; int wave0; const float* aux; };

__device__ __forceinline__ void glds16(const void*gsrc,unsigned lds_dst){unsigned keep;
  asm volatile("s_mov_b32 %0, m0\n\ts_mov_b32 m0, %2\n\ts_nop 0\n\tglobal_load_lds_dwordx4 %1, off\n\ts_mov_b32 m0, %0":"=&s"(keep):"v"(gsrc),"s"(lds_dst):"memory");}
__device__ __forceinline__ void glds16s(const void*sbase,unsigned voff,unsigned lds_dst){unsigned keep;
  asm volatile("s_nop 4\n\ts_mov_b32 %0, m0\n\ts_mov_b32 m0, %3\n\ts_nop 0\n\tglobal_load_lds_dwordx4 %1, %2\n\ts_mov_b32 m0, %0":"=&s"(keep):"v"(voff),"s"(sbase),"s"(lds_dst):"memory");}
__device__ __forceinline__ float max3f(float a,float b,float c){float r;asm("v_max3_f32 %0, %1, %2, %3":"=v"(r):"v"(a),"v"(b),"v"(c));return r;}
__device__ __forceinline__ float max2f(float a,float b){float r;asm("v_max_f32_e32 %0, %1, %2":"=v"(r):"v"(a),"v"(b));return r;}
__device__ __forceinline__ float fadd_s(float a,float b){float r;asm("v_add_f32_e32 %0, %1, %2":"=v"(r):"v"(a),"v"(b));return r;}
__device__ __forceinline__ float fsub_s(float a,float b){float r;asm("v_sub_f32_e32 %0, %1, %2":"=v"(r):"v"(a),"v"(b));return r;}
typedef float f32x2_t __attribute__((ext_vector_type(2))); typedef __bf16 bf16x2_t __attribute__((ext_vector_type(2)));
__device__ __forceinline__ unsigned cvtpk_s(float lo,float hi){f32x2_t v={lo,hi};bf16x2_t b=__builtin_convertvector(v,bf16x2_t);return __builtin_bit_cast(unsigned,b);}
#define WAIT_BAR(N) asm volatile("s_waitcnt vmcnt(" #N ") lgkmcnt(0)\n\ts_barrier":::"memory")
__device__ __forceinline__ void qkt(f32x16&p0,f32x16&p1,const char*Kslot,const bf16x8*qr,const f32x16&negm,int r32,int hi){
  const char*kb=Kslot+hi*1024+r32*16;
  #pragma unroll
  for(int d0=0;d0<4;++d0){
    const bf16x8 b0=*reinterpret_cast<const bf16x8*>(kb+d0*2048);
    const bf16x8 b1=*reinterpret_cast<const bf16x8*>(kb+d0*2048+512);
    if(d0==0){p0=__builtin_amdgcn_mfma_f32_32x32x16_bf16(b0,qr[0],negm,0,0,0);p1=__builtin_amdgcn_mfma_f32_32x32x16_bf16(b1,qr[0],negm,0,0,0);}
    else{p0=__builtin_amdgcn_mfma_f32_32x32x16_bf16(b0,qr[d0],p0,0,0,0);p1=__builtin_amdgcn_mfma_f32_32x32x16_bf16(b1,qr[d0],p1,0,0,0);}}
}
typedef __attribute__((address_space(3))) const char* lds_cptr;
typedef short v4i16_t __attribute__((ext_vector_type(4)));
__device__ __forceinline__ void kload8(bf16x8*kf,lds_cptr kp){
  kf[0]=*(const __attribute__((address_space(3))) bf16x8*)(kp);      kf[1]=*(const __attribute__((address_space(3))) bf16x8*)(kp+512);
  kf[2]=*(const __attribute__((address_space(3))) bf16x8*)(kp+2048); kf[3]=*(const __attribute__((address_space(3))) bf16x8*)(kp+2560);
  kf[4]=*(const __attribute__((address_space(3))) bf16x8*)(kp+4096); kf[5]=*(const __attribute__((address_space(3))) bf16x8*)(kp+4608);
  kf[6]=*(const __attribute__((address_space(3))) bf16x8*)(kp+6144); kf[7]=*(const __attribute__((address_space(3))) bf16x8*)(kp+6656);
}
__device__ __forceinline__ void kload2(bf16x8*kf,lds_cptr kp,int j){ kf[2*j]=*(const __attribute__((address_space(3))) bf16x8*)(kp+j*2048); kf[2*j+1]=*(const __attribute__((address_space(3))) bf16x8*)(kp+j*2048+512); }
__device__ __forceinline__ s16x4 vtr(lds_cptr p){ return __builtin_bit_cast(s16x4,__builtin_amdgcn_ds_read_tr16_b64_v4i16((__attribute__((address_space(3))) v4i16_t*)p)); }
__device__ __forceinline__ float rowmax(const f32x16&p0,const f32x16&p1){
  float a=max3f(p0[0],p0[1],p1[0]),b=max3f(p0[2],p0[3],p1[1]);a=max3f(a,p1[2],p1[3]);
  #pragma unroll
  for(int r=4;r<16;r+=4){a=max3f(a,p0[r],p0[r+1]);b=max3f(b,p0[r+2],p0[r+3]);a=max3f(a,p1[r],p1[r+1]);b=max3f(b,p1[r+2],p1[r+3]);}
  const float m=max2f(a,b);
  auto rr=__builtin_amdgcn_permlane32_swap(__float_as_uint(m),__float_as_uint(m),false,false);
  return max2f(__uint_as_float(rr[0]),__uint_as_float(rr[1]));
}
__device__ __forceinline__ void pv(f32x16*o,int vb,bf16x8 pa0,bf16x8 pa1,bf16x8 pa2,bf16x8 pa3){
  #pragma unroll
  for(int d0=0;d0<2;++d0){s16x4 lo[4],hi[4];
    #pragma unroll
    for(int ks=0;ks<4;++ks){
      asm volatile("ds_read_b64_tr_b16 %0,%1 offset:%c2":"=&v"(lo[ks]):"v"(vb),"i"(d0*4096+ks*1024):"memory");
      asm volatile("ds_read_b64_tr_b16 %0,%1 offset:%c2":"=&v"(hi[ks]):"v"(vb),"i"(d0*4096+ks*1024+512):"memory");}
    asm volatile("s_waitcnt lgkmcnt(0)":::"memory");SBAR();
    #define PK(k) (bf16x8){lo[k][0],lo[k][1],lo[k][2],lo[k][3],hi[k][0],hi[k][1],hi[k][2],hi[k][3]}
    o[d0]=__builtin_amdgcn_mfma_f32_32x32x16_bf16(pa0,PK(0),o[d0],0,0,0);
    o[d0]=__builtin_amdgcn_mfma_f32_32x32x16_bf16(pa1,PK(1),o[d0],0,0,0);
    o[d0]=__builtin_amdgcn_mfma_f32_32x32x16_bf16(pa2,PK(2),o[d0],0,0,0);
    o[d0]=__builtin_amdgcn_mfma_f32_32x32x16_bf16(pa3,PK(3),o[d0],0,0,0);
    #undef PK
  }
}
typedef __attribute__((address_space(3))) const float* lds_fptr;
__device__ __forceinline__ bf16 f2bf_(float f){ unsigned u=__builtin_bit_cast(unsigned,f); return (bf16)((u+0x7fffu+((u>>16)&1u))>>16); }
struct MaskCtx { int kt0, v0, v1, v2, v3, v4; lds_fptr rp; };
template<int KIND> __device__ __forceinline__ void mask_setup(MaskCtx&mc,const Job&J,char*shm,int tid,int wid,int r32,int hi){
  mc.kt0=J.kt0; mc.v0=mc.v1=mc.v2=mc.v3=0; mc.v4=wid&1; mc.rp=(lds_fptr)(shm+LDS_RPB);
  if constexpr(KIND==0){
    if(J.lat&&tid<466) ((__attribute__((address_space(3))) float*)(shm+LDS_RPB))[tid]=tid<465?J.aux[tid]*1.4426950408889634f:0.f;
    const int rq=(J.qpos0>>6)+(wid>>1), qc=(wid&1)*32+r32; int r0=rq-4; r0=r0<0?0:(r0>24?24:r0); int cs=qc-8; cs=cs<0?0:(cs>48?48:cs);
    mc.v0=rq; mc.v1=qc; mc.v2=r0; mc.v3=cs;
  } else if constexpr(KIND==2){ mc.v0=J.qpos0+wid*32+r32; mc.v1=J.qpos0+wid*32; }
}
template<int KIND> __device__ __forceinline__ void mask_tile(f32x16&p0,f32x16&p1,int t,const MaskCtx&mc,int hi){
  const float NEG=-INFINITY;
  if constexpr(KIND==0){
    if(t<4)return;
    const int kr=mc.kt0+(t-4);
    if(kr<mc.v2||kr>=mc.v2+8){
      _Pragma("unroll") for(int r=0;r<16;++r){p0[r]=NEG;p1[r]=NEG;} return; }
    const lds_fptr T=mc.rp+(kr-mc.v0+7)*31; const int ib=15-mc.v1+4*hi, wb=4*hi-mc.v3;
    const lds_fptr zp=mc.rp+465;
#define NA_ONE(P,r,co) { const int c=((r)&3)+8*((r)>>2)+(co); const bool ok=(unsigned)(wb+c)<16u; const float bv=*(ok?T+ib+c:zp); P[r]=(ok?P[r]:NEG)+bv; }
    if(mc.v4==0){
      _Pragma("unroll") for(int r=4;r<16;++r) p1[r]=NEG;
      _Pragma("unroll") for(int r=0;r<4;++r) NA_ONE(p1,r,32)
      _Pragma("unroll") for(int g=0;g<4;++g){ __builtin_amdgcn_sched_barrier(0);
        _Pragma("unroll") for(int r=4*g;r<4*g+4;++r) NA_ONE(p0,r,0) }
    } else {
      _Pragma("unroll") for(int r=0;r<12;++r) p0[r]=NEG;
      _Pragma("unroll") for(int r=12;r<16;++r) NA_ONE(p0,r,0)
      _Pragma("unroll") for(int g=0;g<4;++g){ __builtin_amdgcn_sched_barrier(0);
        _Pragma("unroll") for(int r=4*g;r<4*g+4;++r) NA_ONE(p1,r,32) }
    }
#undef NA_ONE
  } else if constexpr(KIND==2){
    if(t<4)return;
    const int k0=64*(mc.kt0+t-4), dk=k0-mc.v1;
    if(dk>=-96&&dk<=64)return;
    if(dk<=-192||dk>=160){ _Pragma("unroll") for(int r=0;r<16;++r){p0[r]=NEG;p1[r]=NEG;} return; }
    const int dq=k0+4*hi-mc.v0+128;
    _Pragma("unroll") for(int r=0;r<16;++r){ const int c=(r&3)+8*(r>>2); if((unsigned)(dq+c)>256u)p0[r]=NEG; if((unsigned)(dq+c+32)>256u)p1[r]=NEG; }
  }
}
template<int KIND> __device__ __forceinline__ bool tile_dead(int t,const MaskCtx&mc){
  if constexpr(KIND==0){ if(t<4)return false; const int kr=mc.kt0+(t-4); return kr<mc.v2||kr>=mc.v2+8; }
  else if constexpr(KIND==2){ if(t<4)return false; const int dk=64*(mc.kt0+t-4)-mc.v1; return dk<=-192||dk>=160; }
  else return false;
}
#ifndef ATTN_STORE16
#define ATTN_STORE16(p,v) (*(u32x4*)(p)=(v))
#endif
template<int KIND,int THRL> __device__ __forceinline__ void attn_unit(const Job&J,char*shm){
  constexpr int LDK=KIND==0?1024:KIND==1?256:128;
  const int tid=fresh_tid(J.wave0),lane=tid&63,r32=lane&31,hi=lane>>5; const int wid=__builtin_amdgcn_readfirstlane(tid>>6);
  const bf16*Qw=J.Q+(long)(wid*QBLK)*QP;
  const unsigned lds0=(unsigned)(uintptr_t)shm;
  float*wsf=(float*)(shm+LDS_WS)+wid*64;
  const unsigned kvo=(unsigned)(wid*512+lane*8)*2u, vvo=(unsigned)((16*(wid&3)+(lane>>2))*LDK+(wid>>2)*32+(lane&3)*8)*2u;
  const unsigned kdst=lds0+LDS_K+wid*1024, vdst=lds0+LDS_V+wid*1024;
  #define DMA_K(t,slot) glds16s(((t)<4?J.Kc+(long)(t)*4096:J.Kl+(long)((t)-4)*4096),kvo,(unsigned)__builtin_amdgcn_readfirstlane(kdst+(slot)))
  #define DMA_V(t,slot) glds16s(((t)<4?J.Vc+(long)(t)*KVBLK*LDK:J.Vl+(long)((t)-4)*KVBLK*LDK),vvo,(unsigned)__builtin_amdgcn_readfirstlane(vdst+(slot)))
  const int vb0=(int)(lds0+LDS_V)+((lane>>4)&1)*32+(lane&3)*8+(4*hi+((lane&15)>>2))*64;
  const char*Kbase=shm+LDS_K; bf16x8 kf[8];
  const lds_cptr shm3=(lds_cptr)shm; const lds_cptr kp0=shm3+LDS_K+hi*1024+r32*16; const lds_cptr vp0=shm3+LDS_V+((lane>>4)&1)*32+(lane&3)*8+(4*hi+((lane&15)>>2))*64;
  const int NT=J.NT;
  MaskCtx mc; mask_setup<KIND>(mc,J,shm,tid,wid,r32,hi);
  DMA_K(0,0);DMA_V(0,0);DMA_K(1,SLOTB);
  bf16x8 qr[4];
  #pragma unroll
  for(int d0=0;d0<4;++d0)qr[d0]=*reinterpret_cast<const bf16x8*>(&Qw[(long)r32*QP+d0*16+hi*8]);
  float mhat=0.f,l_reg=0.f;f32x16 o[2];o[0]=f32x16{};o[1]=f32x16{};f32x16 negm=f32x16{};asm volatile("":"+v"(negm));
  #define CMASK(P0,P1,t) mask_tile<KIND>(P0,P1,(t),mc,hi)
  bool resc=false;
  #define START(P0,P1) do{ const float rm=rowmax(P0,P1); resc=false; \
    { const float dl=rm; mhat=fadd_s(mhat,dl); \
      _Pragma("unroll") for(int r=0;r<16;++r){P0[r]=fsub_s(P0[r],dl);P1[r]=fsub_s(P1[r],dl);} \
      _Pragma("unroll") for(int r=0;r<16;++r)negm[r]=-mhat; asm volatile("":"+v"(negm)); } \
    _Pragma("unroll") for(int r=0;r<16;++r)P0[r]=__builtin_amdgcn_exp2f(P0[r]); }while(0)
  #define RESC() do{ if(resc){ asm volatile("s_waitcnt lgkmcnt(0)":::"memory"); \
      _Pragma("unroll") for(int d_=0;d_<2;++d_) _Pragma("unroll") for(int r=0;r<16;++r)o[d_][r]*=wsf[crow(r,hi)]; } }while(0)
  f32x16 pA0,pA1,pB0,pB1;
  int sl_prev=0,sl_cur=0,sl_next=SLOTB;
  #define ROT() do{sl_prev=sl_cur;sl_cur=sl_next;sl_next=(sl_next==(NSLOT-1)*SLOTB)?0:sl_next+SLOTB;}while(0)
  DMA_K(2,2*SLOTB);
  WAIT_BAR(3);
  qkt(pA0,pA1,Kbase,qr,negm,r32,hi);asm volatile("s_nop 15\n\ts_nop 7":"+v"(pA0),"+v"(pA1));
  START(pA0,pA1);
  _Pragma("unroll") for(int r=0;r<16;++r)pA1[r]=__builtin_amdgcn_exp2f(pA1[r]);
  WAIT_BAR(0);
  DMA_K(3,0);DMA_V(1,SLOTB);
  ROT();
  kload8(kf,kp0+sl_cur);
  WAIT_BAR(2);
  s16x4 vlo[8],vhi[8]; u32x4 pw0,pw1,pw2,pw3;
  #define PKW(P,B) cvtpk_s(P[B],P[B+1])
  #define PAF(k) __builtin_bit_cast(bf16x8,pw##k)
  #define VFR(i) (bf16x8){vlo[i][0],vlo[i][1],vlo[i][2],vlo[i][3],vhi[i][0],vhi[i][1],vhi[i][2],vhi[i][3]}
  #define PIN(x) asm volatile("":"+v"(x))
  #define MX3(a,b,c) __builtin_fmaxf(__builtin_fmaxf((a),(b)),(c))
  #define GAPA(MF,A0,A1,A2,A3,W0,W1,PW) do{ MF; sacc+=A0; sacc+=A1; sacc+=A2; sacc+=A3; PIN(sacc); W0; W1; PIN(PW); SBAR(); }while(0)
  #define EX(v) __builtin_amdgcn_exp2f(v)
  #define GAPB(MF,X,B) do{ MF; X[B]=EX(X[B]); X[B+1]=EX(X[B+1]); X[B+2]=EX(X[B+2]); X[B+3]=EX(X[B+3]); PIN(X); SBAR(); }while(0)
  #define VRD(i) do{ vlo[i]=vtr(vp_+(((i)>>2)*4096+((i)&3)*1024)); vhi[i]=vtr(vp_+(((i)>>2)*4096+((i)&3)*1024+512)); }while(0)
  #define KRD(G,j) do{ if(G){ kload2(kf,kp0+sl_next,j); SBAR(); } }while(0)
  #define STEP(C0,C1,P0,P1,t,GK,GV,GL) do{ SBAR(); \
    if(KIND!=1&&tile_dead<KIND>((t),mc)&&tile_dead<KIND>((t)-1,mc)){   \
      if(GK){DMA_K((t)+3,sl_cur);} if(GV){DMA_V((t)+1,sl_next);} KRD(GL,0); KRD(GL,1); KRD(GL,2); KRD(GL,3); \
      _Pragma("unroll") for(int r_=0;r_<16;++r_){C0[r_]=0.f;C1[r_]=0.f;} resc=false; SBAR(); } else { \
    const lds_cptr vp_=vp0+sl_prev; \
    VRD(0); SBAR(); float sacc=(P0[0]+P0[1]); \
    GAPA(C0=__builtin_amdgcn_mfma_f32_32x32x16_bf16(kf[0],qr[0],negm,0,0,0), P0[2],P0[3],P0[4],P0[5],     pw0[0]=PKW(P0,0), pw0[1]=PKW(P0,2), pw0); \
    VRD(4); SBAR(); GAPA(C1=__builtin_amdgcn_mfma_f32_32x32x16_bf16(kf[1],qr[0],negm,0,0,0), P0[6],P0[7],P0[8],P0[9],     pw0[2]=PKW(P0,4), pw0[3]=PKW(P0,6), pw0); \
    VRD(1); SBAR(); GAPA(C0=__builtin_amdgcn_mfma_f32_32x32x16_bf16(kf[2],qr[1],C0,0,0,0),   P0[10],P0[11],P0[12],P0[13], pw1[0]=PKW(P0,8), pw1[1]=PKW(P0,10), pw1); \
    VRD(5); SBAR(); GAPA(C1=__builtin_amdgcn_mfma_f32_32x32x16_bf16(kf[3],qr[1],C1,0,0,0),   P0[14],P0[15],P1[0],P1[1],   pw1[2]=PKW(P0,12),pw1[3]=PKW(P0,14), pw1); \
    VRD(2); SBAR(); GAPA(C0=__builtin_amdgcn_mfma_f32_32x32x16_bf16(kf[4],qr[2],C0,0,0,0),   P1[2],P1[3],P1[4],P1[5],     pw2[0]=PKW(P1,0), pw2[1]=PKW(P1,2), pw2); \
    VRD(6); SBAR(); GAPA(C1=__builtin_amdgcn_mfma_f32_32x32x16_bf16(kf[5],qr[2],C1,0,0,0),   P1[6],P1[7],P1[8],P1[9],     pw2[2]=PKW(P1,4), pw2[3]=PKW(P1,6), pw2); \
    VRD(3); SBAR(); GAPA(C0=__builtin_amdgcn_mfma_f32_32x32x16_bf16(kf[6],qr[3],C0,0,0,0),   P1[10],P1[11],P1[12],P1[13], pw3[0]=PKW(P1,8), pw3[1]=PKW(P1,10), pw3); \
    VRD(7); SBAR(); GAPA(C1=__builtin_amdgcn_mfma_f32_32x32x16_bf16(kf[7],qr[3],C1,0,0,0),   P1[14],P1[15],0.f,0.f,       pw3[2]=PKW(P1,12),pw3[3]=PKW(P1,14), pw3); \
    l_reg+=sacc; \
    if(GK){DMA_K((t)+3,sl_cur);} if(GV){DMA_V((t)+1,sl_next);} \
    CMASK(C0,C1,t); \
    { float a=MX3(C0[0],C0[1],C1[0]),b=MX3(C0[2],C0[3],C1[1]); a=MX3(a,C1[2],C1[3]); \
      _Pragma("unroll") for(int r=4;r<16;r+=4){a=MX3(a,C0[r],C0[r+1]);b=MX3(b,C0[r+2],C0[r+3]);a=MX3(a,C1[r],C1[r+1]);b=MX3(b,C1[r+2],C1[r+3]);} \
      float rm=__builtin_fmaxf(a,b); { auto rr=__builtin_amdgcn_permlane32_swap(__float_as_uint(rm),__float_as_uint(rm),false,false); rm=__builtin_fmaxf(__uint_as_float(rr[0]),__uint_as_float(rr[1])); } \
      resc=false; \
      if(__builtin_expect(__any(rm>(float)THRL),0)){ const float dl=__builtin_fmaxf(rm,0.f); mhat+=dl; \
        _Pragma("unroll") for(int r=0;r<16;++r){C0[r]-=dl;C1[r]-=dl;} \
        _Pragma("unroll") for(int r=0;r<16;++r)negm[r]=-mhat; asm volatile("":"+v"(negm)); \
        const float f=__builtin_amdgcn_exp2f(-dl); l_reg*=f; if(hi==0)wsf[r32]=f; resc=true; } } \
    SBAR(); \
    GAPB(o[0]=__builtin_amdgcn_mfma_f32_32x32x16_bf16(PAF(0),VFR(0),o[0],0,0,0), C0,0); \
    GAPB(o[1]=__builtin_amdgcn_mfma_f32_32x32x16_bf16(PAF(0),VFR(4),o[1],0,0,0), C0,4); \
    KRD(GL,0); GAPB(o[0]=__builtin_amdgcn_mfma_f32_32x32x16_bf16(PAF(1),VFR(1),o[0],0,0,0), C0,8); \
    KRD(GL,1); GAPB(o[1]=__builtin_amdgcn_mfma_f32_32x32x16_bf16(PAF(1),VFR(5),o[1],0,0,0), C0,12); \
    KRD(GL,2); GAPB(o[0]=__builtin_amdgcn_mfma_f32_32x32x16_bf16(PAF(2),VFR(2),o[0],0,0,0), C1,0); \
    KRD(GL,3); GAPB(o[1]=__builtin_amdgcn_mfma_f32_32x32x16_bf16(PAF(2),VFR(6),o[1],0,0,0), C1,4); \
    GAPB(o[0]=__builtin_amdgcn_mfma_f32_32x32x16_bf16(PAF(3),VFR(3),o[0],0,0,0), C1,8); \
    GAPB(o[1]=__builtin_amdgcn_mfma_f32_32x32x16_bf16(PAF(3),VFR(7),o[1],0,0,0), C1,12); \
    } }while(0)
  int t=1;
  #undef CMASK
  #define CMASK(P0,P1,t) do{}while(0)
  if constexpr(KIND==1) for(;t+5<NT;t+=2){
    STEP(pB0,pB1,pA0,pA1,t,true,true,true);     WAIT_BAR(2); RESC(); ROT();
    STEP(pA0,pA1,pB0,pB1,t+1,true,true,true);   WAIT_BAR(2); RESC(); ROT();
  }
  #undef CMASK
  #define CMASK(P0,P1,t) mask_tile<KIND>(P0,P1,(t),mc,hi)
  #define ENDW(tt) do{ if((tt)+3<NT){WAIT_BAR(2);} else if((tt)+2<NT){WAIT_BAR(1);} else {WAIT_BAR(0);} }while(0)
  for(;t+1<NT;t+=2){
    STEP(pB0,pB1,pA0,pA1,t,(t+3<NT),(t+1<NT),(t+1<NT));       ENDW(t);   RESC(); ROT();
    STEP(pA0,pA1,pB0,pB1,t+1,(t+4<NT),(t+2<NT),(t+2<NT));     ENDW(t+1); RESC(); ROT();
  }
  STEP(pB0,pB1,pA0,pA1,NT-1,false,false,false); RESC();
  { float sacc=pB0[0]+pB0[1]; _Pragma("unroll") for(int r=2;r<16;++r)sacc+=pB0[r]; _Pragma("unroll") for(int r=0;r<16;++r)sacc+=pB1[r]; l_reg+=sacc;
    pw0=(u32x4){PKW(pB0,0),PKW(pB0,2),PKW(pB0,4),PKW(pB0,6)};pw1=(u32x4){PKW(pB0,8),PKW(pB0,10),PKW(pB0,12),PKW(pB0,14)};pw2=(u32x4){PKW(pB1,0),PKW(pB1,2),PKW(pB1,4),PKW(pB1,6)};pw3=(u32x4){PKW(pB1,8),PKW(pB1,10),PKW(pB1,12),PKW(pB1,14)};
    SBAR(); pv(o,vb0+sl_cur,PAF(0),PAF(1),PAF(2),PAF(3)); }
  #undef PKW
  #undef PAF
  #undef VFR
  #undef PIN
  #undef MX3
  #undef GAPA
  #undef GAPB
  #undef EX
  #undef VRD
  #undef KRD
  #undef STEP
  #undef ENDW
  {auto rr=__builtin_amdgcn_permlane32_swap(__float_as_uint(l_reg),__float_as_uint(l_reg),false,false);l_reg=__uint_as_float(rr[0])+__uint_as_float(rr[1]);}
  if constexpr(KIND==2) l_reg+=__builtin_amdgcn_exp2f(J.aux[0]*1.4426950408889634f-mhat);
  if(hi==0)wsf[32+r32]=l_reg;asm volatile("s_waitcnt lgkmcnt(0)":::"memory");
  float rli[16];
  #pragma unroll
  for(int r=0;r<16;++r)rli[r]=__builtin_amdgcn_rcpf(wsf[32+crow(r,hi)]);
  bf16*Ow=J.O+(long)(wid*QBLK)*QP;
  { bf16*stg=(bf16*)(shm+LDS_OST)+wid*2048;
    #pragma unroll
    for(int r=0;r<16;++r){const int orow=crow(r,hi);
      #pragma unroll
      for(int d0=0;d0<2;++d0)stg[orow*64+d0*32+r32]=(bf16)cvtpk_s(o[d0][r]*rli[r],0.f);}
    asm volatile("s_waitcnt lgkmcnt(0)":::"memory");
    #pragma unroll
    for(int i=0;i<4;++i){const int row=i*8+(lane>>3),ch=lane&7; const u32x4 v=*(const u32x4*)(stg+row*64+ch*8); ATTN_STORE16(Ow+(long)row*QP+ch*8,v);} }
  asm volatile("s_waitcnt lgkmcnt(0)\n\ts_barrier":::"memory");
  #undef DMA_K
  #undef DMA_V
  #undef CMASK
  #undef START
  #undef RESC
  #undef ROT
}
#undef SBAR
#undef WAIT_BAR
}
__device__ __forceinline__ void sb_arrive(Frame& F, int j);
template <int KIND> __device__ __forceinline__ void attn_phase(Frame& F, const Args& A_) {
    constexpr int ldk = KIND == 0 ? 1024 : KIND == 1 ? 256 : 128, gsz = KIND == 0 ? 1 : KIND == 1 ? 4 : 8;
    char* shm = (char*)F.lds;
#pragma unroll 1
    for (int it = 0; ; ++it) {
        int U;
        if (F.xm && it == 4) sb_arrive(F, 18 + 2 * KIND);
        if (F.xm) {
            if (it < 4) U = F.xg * 128 + 4 * F.lidx + it; else if (it == 4 && F.lidx < 16) U = 1024 + F.xg * 16 + F.lidx; else break;
        } else { const int rounds = (1024 + 4 * F.G - 1) / (4 * F.G); const int r = it >> 2;
          if (r < rounds) { U = 4 * F.vcu + (it & 3) + r * 4 * F.G; if (U >= 1024) continue; }
          else { U = 1024 + F.vcu + (it - 4 * rounds) * F.G; if (U >= 1152) break; } }
        const bool lat = U < 1024; const int bh = lat ? (U >> 3) : (U - 1024), qb = lat ? (U & 7) : 0, b = bh >> 4, h = bh & 15, kvh = h / gsz;
        int kt0 = 0, nlt = 0;
        if (lat) {
            if constexpr (KIND == 1) { kt0 = 0; nlt = 32; }
            else if constexpr (KIND == 2) { const int q0 = qb * 256; const int lo = q0 - 128 < 0 ? 0 : q0 - 128, hi_ = q0 + 383 > SEQ - 1 ? SEQ - 1 : q0 + 383; kt0 = lo >> 6; nlt = (hi_ >> 6) - kt0 + 1; }
            else { const int rf = qb * 4; int r0f = rf - 4; r0f = r0f < 0 ? 0 : (r0f > 24 ? 24 : r0f); int r0l = rf + 3 - 4; r0l = r0l < 0 ? 0 : (r0l > 24 ? 24 : r0l);
                kt0 = r0f; nlt = r0l + 8 - r0f; if (nlt & 1) { if (kt0 + nlt < 32) ++nlt; else { --kt0; ++nlt; } } }
        }
        const size_t qrow = lat ? (size_t)b * SEQ + qb * 256 : (size_t)ML + b * CTXL;
        att::Job J;
        unsigned char* Rb = F.R + (size_t)b * SLAB; const size_t lrow = lat ? (size_t)qb * 256 : (size_t)SEQ;
        J.Q = (bf16*)(Rb + SL_Q) + lrow * 1024 + h * 64; J.O = (bf16*)F.HF + qrow * 1024 + h * 64;
        J.Kc = (bf16*)(Rb + SL_K) + (size_t)(kvh * 36 + 32) * 4096; J.Vc = (bf16*)(Rb + SL_V) + (size_t)SEQ * ldk + kvh * 64;
        J.Kl = (bf16*)(Rb + SL_K) + (size_t)(kvh * 36 + kt0) * 4096; J.Vl = (bf16*)(Rb + SL_V) + (size_t)(kt0 * 64) * ldk + kvh * 64;
        J.NT = 4 + nlt; J.lat = lat ? 1 : 0; J.qpos0 = qb * 256; J.kt0 = kt0; J.h = h; J.wave0 = F.wave0;
        J.aux = KIND == 0 ? A_.in[12] + (size_t)h * 465 : (KIND == 2 ? A_.in[19] + h : nullptr);
        att::attn_unit<KIND, 8>(J, shm);
    }
    if (F.xm) sb_arrive(F, 19 + 2 * KIND);
}
constexpr size_t WS_WG = 2 * MiB + 65536;
constexpr size_t LRU_AGG_OFF = 0, LRU_HIN_OFF = 16 * MiB;
__device__ __forceinline__ void lru_wprep(Frame& F, const Args& A_) {
    PHASE_IDS();
    bf16* WG = (bf16*)(F.ws + WS_WG);
    for (int i = (F.vcu * NWAVES + wave) * 64 + lane; i < 16 * 4 * 64 * 64; i += F.G * NWAVES * 64) {
        const int d = i & 63, e = (i >> 6) & 63, s = (i >> 12) & 3, n = i >> 14; const int dir = s >> 1;
        const float* src = (s & 1) ? A_.in[26] : A_.in[24];
        WG[i] = (bf16)f2bf(src[((size_t)(dir * 16 + n) * 64 + d) * 64 + e]); }
}
struct LruSpan { int dir, isctx, T, tok0; size_t rowb; };
__device__ __forceinline__ LruSpan lru_span(int step) { LruSpan s; s.dir = step >= 9 ? 1 : 0; const int s9 = step - 9 * s.dir; s.isctx = s9 == 0 ? 1 : 0; const int sp = s.dir ? 8 - s9 : s9 - 1;
    s.T = s.isctx ? CTXL : SEQ; s.tok0 = s.isctx ? 0 : sp * 256; s.rowb = s.isctx ? (size_t)SEQ : (size_t)0; return s; }
__device__ __forceinline__ void lru_sweeps(Frame& F, const Args& A_) {
    PHASE_IDS();
    typedef short bf16x8 __attribute__((ext_vector_type(8))); typedef float f32x16 __attribute__((ext_vector_type(16)));
    const int r32 = lane & 31, hi = lane >> 5;
    LAS float* xcf = (LAS float*)F.lds;
    LAS unsigned short* xcb = (LAS unsigned short*)(F.lds + 36864);
    LAS unsigned short* glt = (LAS unsigned short*)(F.lds + 73728);
    LAS unsigned short* hft = (LAS unsigned short*)(F.lds + 94208);
    LAS unsigned short* wgt = (LAS unsigned short*)(F.lds + 114688);
    LAS float* agg = (LAS float*)(F.lds + 123904);
    const bf16* WG = (const bf16*)(F.ws + WS_WG);
    bf16* HFW = (bf16*)F.HF;
    const int cq = tid & 15, tg = tid >> 4;
    const int trow = tid >> 2, tq = tid & 3;
#pragma unroll 1
    for (int v = F.xm ? F.xg * 32 + F.lidx : F.vcu; v < 256; v += F.xm ? 256 : F.G) {
        const int b = v >> 5, n = (v >> 1) & 15, hf = v & 1;
        const int ch = 64 * n + 32 * hf + r32;
        const char* XRb = (const char*)(F.R + (size_t)b * SLAB + SL_XR) + (size_t)(64 * n) * 2; bf16* GL = (bf16*)(F.R + (size_t)b * SLAB + SL_GL) + 64 * n + 32 * hf;
        bf16* HFb = HFW + (size_t)b * SEQ * 1024 + 64 * n + 32 * hf;
        bf16* dummy = (bf16*)(F.ws + WS_HC + 4 * MiB) + ((size_t)v * 512 + tid) * 16;
        f32x4 cwv[4];
#pragma unroll
        for (int k = 0; k < 4; ++k) cwv[k] = *(const f32x4*)(A_.in[22] + k * 1024 + 64 * n + 4 * cq);
        const f32x4 cbv = *(const f32x4*)(A_.in[23] + 64 * n + 4 * cq);
        typedef unsigned u32x2 __attribute__((ext_vector_type(2))); u32x2 xin[11]; v4u gin[2], hin[2];
#define LRU_FETCH(sp_) do { \
        _Pragma("unroll") for (int i = 0; i < 11; ++i) { int tt = (sp_).tok0 + 8 * tg - 2 + i; if (i < 2) tt = tt < 0 ? 0 : tt; if (i == 10) tt = tt > (sp_).T - 1 ? (sp_).T - 1 : tt; \
            xin[i] = *(const u32x2*)(XRb + (unsigned)((((int)(sp_).rowb + tt) * 1024 + 4 * cq) * 2)); } \
        { const unsigned e_ = ((sp_).dir && !(sp_).isctx) ? (unsigned)(((sp_).tok0 + trow) * 1024 + 8 * tq) : 0u;     \
          const bf16* gp = GL + e_; gin[0] = *(const GAS v4u*)gp; gin[1] = *(const GAS v4u*)(gp + 128 * 1024); const bf16* hp = HFb + e_; hin[0] = *(const GAS v4u*)hp; hin[1] = *(const GAS v4u*)(hp + 128 * 1024); } } while (0)
        { const LruSpan s0 = lru_span(0); LRU_FETCH(s0); }
#pragma unroll 1
        for (int d = 0; d < 2; ++d) {
            float S = 0.f;
            if (d == 1) asm volatile("s_waitcnt vmcnt(0)" ::: "memory");
            const float nba = -LOG2E * A_.in[25][d * 1024 + ch], nbx = -LOG2E * A_.in[27][d * 1024 + ch]; const float sp = -8.0f * LOG2E * log1pf(expf(-A_.in[28][d * 1024 + ch]));
            { const int row = tid >> 3, pc = tid & 7, st_ = row >> 5, e = row & 31;
              *(LAS v4u*)(wgt + row * 72 + 8 * pc) = *(const GAS v4u*)(WG + ((size_t)((n * 4 + 2 * d + st_) * 64 + 32 * hf + e) * 64 + 8 * pc)); }
#pragma unroll 1
        for (int s9 = 0; s9 < 9; ++s9) {
            const int step = 9 * d + s9;
            const LruSpan cur = lru_span(step);
            f32x4 xf[11];
            { const u32x2 z = {0u, 0u}; const int t0 = cur.tok0 + 8 * tg; if (t0 - 2 < 0) xin[0] = z; if (t0 - 1 < 0) xin[1] = z; if (t0 + 8 >= cur.T) xin[10] = z; }
#pragma unroll
            for (int i = 0; i < 11; ++i) { xf[i][0] = bf_lo(xin[i].x); xf[i][1] = __builtin_bit_cast(float, xin[i].x & 0xffff0000u); xf[i][2] = bf_lo(xin[i].y); xf[i][3] = __builtin_bit_cast(float, xin[i].y & 0xffff0000u); }
#pragma unroll
            for (int j = 0; j < 8; ++j) { const int tok = 8 * tg + j; const f32x4 a = cbv + cwv[0] * xf[j] + cwv[1] * xf[j + 1] + cwv[2] * xf[j + 2] + cwv[3] * xf[j + 3];
                if ((cq >> 3) == hf) *(LAS f32x4*)(xcf + tok * 36 + 4 * (cq & 7)) = a;
                u32x2 w; w.x = att::cvtpk_s(a[0], a[1]); w.y = att::cvtpk_s(a[2], a[3]); *(LAS u32x2*)(xcb + tok * 72 + 4 * cq) = w; }
            if (cur.dir && !cur.isctx) { *(LAS v4u*)(glt + trow * 40 + 8 * tq) = gin[0]; *(LAS v4u*)(glt + (trow + 128) * 40 + 8 * tq) = gin[1];
                                         *(LAS v4u*)(hft + trow * 40 + 8 * tq) = hin[0]; *(LAS v4u*)(hft + (trow + 128) * 40 + 8 * tq) = hin[1]; }
            __syncthreads();
            { const LruSpan nx = lru_span(step + 1 < 18 ? step + 1 : 17); LRU_FETCH(nx); }
            bf16x8 Af[4];
#pragma unroll
            for (int ks = 0; ks < 4; ++ks) Af[ks] = *(const LAS bf16x8*)(xcb + (32 * wave + r32) * 72 + 16 * ks + 8 * hi);
            f32x16 acc[2];
#pragma unroll
            for (int s = 0; s < 2; ++s) { acc[s] = (f32x16){};
#pragma unroll
                for (int ks = 0; ks < 4; ++ks) acc[s] = __builtin_amdgcn_mfma_f32_32x32x16_bf16(Af[ks], *(const LAS bf16x8*)(wgt + (s * 32 + r32) * 72 + 16 * ks + 8 * hi), acc[s], 0, 0, 0); }
            float af[16], bv[16];
#pragma unroll
            for (int r = 0; r < 16; ++r) { const int tok = 32 * wave + (r & 3) + 8 * (r >> 2) + 4 * hi; const float xv = xcf[tok * 36 + r32];
                const float rg = __builtin_amdgcn_rcpf(1.0f + __builtin_amdgcn_exp2f(__builtin_fmaf(acc[0][r], -LOG2E, nba))), ig = __builtin_amdgcn_rcpf(1.0f + __builtin_amdgcn_exp2f(__builtin_fmaf(acc[1][r], -LOG2E, nbx)));
                const float a = __builtin_amdgcn_exp2f(sp * rg);
                af[r] = a; bv[r] = __builtin_amdgcn_sqrtf(1.0f - a * a) * (ig * xv); }
            float RA[4], RB[4], LA[4], UA[4], LB[4], UB[4], st[4], h[16];
            if (cur.dir == 0) {
#pragma unroll
                for (int j = 0; j < 4; ++j) { float A = 1.f, Bv = 0.f;
#pragma unroll
                    for (int i = 0; i < 4; ++i) { Bv = af[4 * j + i] * Bv + bv[4 * j + i]; A *= af[4 * j + i]; }
                    RA[j] = A; RB[j] = Bv; }
            } else {
#pragma unroll
                for (int j = 0; j < 4; ++j) { float A = 1.f, Bv = 0.f;
#pragma unroll
                    for (int i = 3; i >= 0; --i) { Bv = af[4 * j + i] * Bv + bv[4 * j + i]; A *= af[4 * j + i]; }
                    RA[j] = A; RB[j] = Bv; }
            }
#pragma unroll
            for (int j = 0; j < 4; ++j) { auto ra = __builtin_amdgcn_permlane32_swap(__float_as_uint(RA[j]), __float_as_uint(RA[j]), false, false); LA[j] = __uint_as_float(ra[0]); UA[j] = __uint_as_float(ra[1]);
                auto rb = __builtin_amdgcn_permlane32_swap(__float_as_uint(RB[j]), __float_as_uint(RB[j]), false, false); LB[j] = __uint_as_float(rb[0]); UB[j] = __uint_as_float(rb[1]); }
            { float s = 0.f, At = 1.f;
              if (cur.dir == 0) {
#pragma unroll
                  for (int j = 0; j < 4; ++j) { s = LA[j] * s + LB[j]; s = UA[j] * s + UB[j]; At *= LA[j] * UA[j]; }
              } else {
#pragma unroll
                  for (int j = 3; j >= 0; --j) { s = UA[j] * s + UB[j]; s = LA[j] * s + LB[j]; At *= LA[j] * UA[j]; }
              }
              if (hi == 0) { typedef float f32x2_ __attribute__((ext_vector_type(2))); f32x2_ w2; w2[0] = At; w2[1] = s; *(LAS f32x2_*)(agg + (wave * 32 + r32) * 2) = w2; } }
            __syncthreads();
            float mine = 0.f;
            { float s = S;
#pragma unroll
              for (int k = 0; k < 8; ++k) { const int w = cur.dir ? 7 - k : k; typedef float f32x2_ __attribute__((ext_vector_type(2))); const f32x2_ ab2 = *(const LAS f32x2_*)(agg + (w * 32 + r32) * 2);
                  mine = (w == wave) ? s : mine; s = ab2[0] * s + ab2[1]; }
              S = s; }
            if (cur.dir == 0) {
                { float s = mine;
#pragma unroll
                  for (int j = 0; j < 4; ++j) { const float slo = s; s = LA[j] * s + LB[j]; const float sup = s; s = UA[j] * s + UB[j]; st[j] = hi ? sup : slo; } }
#pragma unroll
                for (int j = 0; j < 4; ++j) { float hh = st[j];
#pragma unroll
                    for (int i = 0; i < 4; ++i) { hh = af[4 * j + i] * hh + bv[4 * j + i]; h[4 * j + i] = hh; } }
            } else {
                { float s = mine;
#pragma unroll
                  for (int j = 3; j >= 0; --j) { const float sup = s; s = UA[j] * s + UB[j]; const float slo = s; s = LA[j] * s + LB[j]; st[j] = hi ? sup : slo; } }
#pragma unroll
                for (int j = 0; j < 4; ++j) { float hh = st[j];
#pragma unroll
                    for (int i = 3; i >= 0; --i) { hh = af[4 * j + i] * hh + bv[4 * j + i]; h[4 * j + i] = hh; } }
            }
            if (!cur.isctx) {
                if (cur.dir == 0) {
#pragma unroll
                    for (int r = 0; r < 16; ++r) { const int tok = 32 * wave + (r & 3) + 8 * (r >> 2) + 4 * hi; hft[tok * 40 + r32] = (unsigned short)att::cvtpk_s(h[r], 0.f); }
                } else {
#pragma unroll
                    for (int r = 0; r < 16; ++r) { const int tok = 32 * wave + (r & 3) + 8 * (r >> 2) + 4 * hi;
                        const float gl = bf_lo((unsigned)glt[tok * 40 + r32]), hfv = bf_lo((unsigned)hft[tok * 40 + r32]); glt[tok * 40 + r32] = (unsigned short)att::cvtpk_s((hfv + h[r]) * gl, 0.f); }
                }
            }
            __syncthreads();
            { const unsigned e_ = (unsigned)((cur.tok0 + trow) * 1024 + 8 * tq); const LAS unsigned short* src = (cur.dir ? glt : hft) + trow * 40 + 8 * tq;
              bf16* op = cur.isctx ? dummy : (cur.dir == 0 ? HFb + e_ : GL + e_); *(GAS v4u*)op = *(const LAS v4u*)src; *(GAS v4u*)(op + (cur.isctx ? 8 : 128 * 1024)) = *(const LAS v4u*)(src + 128 * 40); }
        } }
#undef LRU_FETCH
    }
}

#define XB_TMO      128
#define XB_XCNT(j)  (256  + 64 * (j))
#define XB_XSUB(j)  (1280 + 64 * (j))
#define XB_XGEN(j)  (2304 + 64 * (j))
#define XB_TOP      3328
#define XB_TOPGEN   3392
#define XCD_BAR_WORDS 3456
#define XB_SPIN_CAP (1u << 18)

__device__ __forceinline__ unsigned xb_ld(unsigned* p)              { return __hip_atomic_load(p, __ATOMIC_RELAXED, __HIP_MEMORY_SCOPE_AGENT); }
__device__ __forceinline__ unsigned xb_add(unsigned* p, unsigned v) { return __hip_atomic_fetch_add(p, v, __ATOMIC_RELAXED, __HIP_MEMORY_SCOPE_AGENT); }
__device__ __forceinline__ unsigned xb_xcc_id() { return (unsigned)__builtin_amdgcn_s_getreg((3 << 11) | 20) & 0xFu; }
#define XB_SPIN(cond, bar) do { unsigned _sp = 0; while (cond) { __builtin_amdgcn_s_sleep(1); \
    if ((++_sp & 255u) == 0u) { if (xb_ld(&(bar)[XB_TMO])) break; if (_sp > XB_SPIN_CAP) { atomicAdd(&(bar)[XB_TMO], 1u); break; } } } } while (0)

struct XcdBarrier {
    unsigned* bar; unsigned x;
    volatile LAS unsigned* st;
};

__device__ __forceinline__ XcdBarrier xcd_barrier_post(unsigned* bar, volatile LAS unsigned* st) {
    XcdBarrier b; b.bar = bar; b.x = xb_xcc_id(); b.st = st;
    if (threadIdx.x == 0) (void)xb_add(&bar[XB_XCNT(b.x)], 1u);
    return b;
}
__device__ __forceinline__ void xcd_barrier_complete(unsigned* bar, unsigned x, unsigned& nloc, unsigned& nx) {
    const unsigned G = gridDim.x * gridDim.y * gridDim.z;
    unsigned sum, cnt, mine, sp = 0u;
    for (;;) {
        sum = 0u; cnt = 0u; mine = 0u;
#pragma unroll
        for (unsigned j = 0; j < 16; ++j) { const unsigned c = xb_ld(&bar[XB_XCNT(j)]); sum += c; cnt += (c > 0u) ? 1u : 0u; mine = (j == x) ? c : mine; }
        if (sum == G) break;
        __builtin_amdgcn_s_sleep(1);
        if ((++sp & 255u) == 0u) { if (xb_ld(&bar[XB_TMO])) break; if (sp > XB_SPIN_CAP) { atomicAdd(&bar[XB_TMO], 1u); break; } }
    }
    nloc = mine > 0u ? mine : 1u; nx = cnt > 0u ? cnt : 1u;
}

__device__ __forceinline__ void xcd_barrier(const XcdBarrier& b) {
    asm volatile("s_waitcnt vmcnt(0)" ::: "memory");
    __syncthreads();
    if (threadIdx.x == 0) {
        unsigned* bar = b.bar; unsigned bx = b.x; asm volatile("" : "+s"(bx), "+s"(bar));
        __builtin_amdgcn_s_waitcnt(0);
        unsigned nloc = b.st[0], nx = b.st[1];
        if (nloc == 0u) { xcd_barrier_complete(bar, bx, nloc, nx); b.st[0] = nloc; b.st[1] = nx; }
        const unsigned old = xb_add(&bar[XB_XSUB(bx)], 1u);
        const unsigned gen = old / nloc;
        if (old + 1u == (gen + 1u) * nloc) {
            __builtin_amdgcn_fence(__ATOMIC_RELEASE, "agent");
            asm volatile("s_waitcnt vmcnt(0)" ::: "memory");
            const unsigned og = xb_add(&bar[XB_TOP], 1u);
            const unsigned tg = og / nx;
            if (og + 1u == (tg + 1u) * nx) xb_add(&bar[XB_TOPGEN], 1u);
            else XB_SPIN(xb_ld(&bar[XB_TOPGEN]) == tg, bar);
            __builtin_amdgcn_fence(__ATOMIC_ACQUIRE, "agent");
            xb_add(&bar[XB_XGEN(bx)], 1u);
            asm volatile("s_waitcnt vmcnt(0)" ::: "memory");
        } else {
            XB_SPIN(xb_ld(&bar[XB_XGEN(bx)]) == gen, bar);
            __builtin_amdgcn_fence(__ATOMIC_ACQUIRE, "agent");
            asm volatile("s_waitcnt vmcnt(0)" ::: "memory");
        }
    }
    __syncthreads();
}

constexpr int MISC_OFF = 131072 + 320;
#define GSYNC() xcd_barrier(bar)
__device__ __forceinline__ void xl_barrier(Frame& F) {
    asm volatile("s_waitcnt vmcnt(0)" ::: "memory");
    __syncthreads();
    if (threadIdx.x == 0) { unsigned* cntw = (unsigned*)(F.ws + WS_CTL) + 56320 + 64 * F.xg; unsigned* relw = (unsigned*)(F.ws + WS_CTL) + 57344 + 64 * F.xg;
        __builtin_amdgcn_s_waitcnt(0);
        const unsigned old = __hip_atomic_fetch_add(cntw, 1u, __ATOMIC_RELAXED, __HIP_MEMORY_SCOPE_AGENT); const unsigned gen = old >> 5;
        if ((old & 31u) == 31u) __hip_atomic_fetch_add(relw, 1u, __ATOMIC_RELAXED, __HIP_MEMORY_SCOPE_AGENT);
        else { unsigned sp = 0; while (__hip_atomic_load(relw, __ATOMIC_RELAXED, __HIP_MEMORY_SCOPE_AGENT) <= gen) { __builtin_amdgcn_s_sleep(1); if (++sp > (1u << 22)) break; } }
        __builtin_amdgcn_fence(__ATOMIC_ACQUIRE, "agent"); asm volatile("s_waitcnt vmcnt(0)" ::: "memory"); }
    __syncthreads();
}
#define XSYNC() do { if (F.xm) xl_barrier(F); else xcd_barrier(bar); } while (0)

#define SB_XSUB(j, x) (((j) < 18 ? 32768 + (j) * 1152 : 98304 + ((j) - 18) * 1152) + 64 * (x))
#define SB_TOP(j)     SB_XSUB(j, 16)
__device__ __forceinline__ void sb_arrive(Frame& F, int j) {
    asm volatile("s_waitcnt vmcnt(0)" ::: "memory");
    __syncthreads();
    if (F.xm) { if (threadIdx.x == 0) { unsigned* ctl = (unsigned*)(F.ws + WS_CTL);
            const unsigned old = __hip_atomic_fetch_add(ctl + SB_XSUB(j, F.xg), 1u, __ATOMIC_RELAXED, __HIP_MEMORY_SCOPE_AGENT);
            if (old + 1u == 32u) __hip_atomic_store(ctl + SB_XSUB(j, F.xg + 8), 32u, __ATOMIC_RELAXED, __HIP_MEMORY_SCOPE_AGENT); }
        return; }
    if (threadIdx.x == 0) { unsigned* ctl = (unsigned*)(F.ws + WS_CTL); const unsigned x = xb_xcc_id(); const unsigned nloc = ((volatile LAS unsigned*)(F.lds + MISC_OFF))[0];
        const unsigned old = __hip_atomic_fetch_add(ctl + SB_XSUB(j, x), 1u, __ATOMIC_RELAXED, __HIP_MEMORY_SCOPE_AGENT);
        if (old + 1u == nloc) {
            __builtin_amdgcn_fence(__ATOMIC_RELEASE, "agent"); asm volatile("s_waitcnt vmcnt(0)" ::: "memory");
            __hip_atomic_fetch_add(ctl + SB_TOP(j), nloc, __ATOMIC_RELAXED, __HIP_MEMORY_SCOPE_AGENT); } }
}
__device__ __forceinline__ void sb_wait(Frame& F, int j) {
    if (threadIdx.x == 0) { unsigned* w = (unsigned*)(F.ws + WS_CTL) + (F.xm ? SB_XSUB(j, F.xg + 8) : SB_TOP(j)); unsigned sp = 0; const unsigned need = F.xm ? 32u : (unsigned)F.G;
        while (__hip_atomic_load(w, __ATOMIC_RELAXED, __HIP_MEMORY_SCOPE_AGENT) < need) { __builtin_amdgcn_s_sleep(8); if (++sp > (1u << 21)) break; }
        __builtin_amdgcn_fence(__ATOMIC_ACQUIRE, "agent"); asm volatile("s_waitcnt vmcnt(0)" ::: "memory"); }
    __syncthreads();
}

__device__ __forceinline__ LAS const float* rstd_table(Frame& F, int pm) {
    LAS float* tb = (LAS float*)(F.lds + 131072 + 1024); const int tid_ = fresh_tid(F.wave0);
#pragma unroll
    for (int t = 0; t < 2; ++t) { const int lane_ = tid_ & 63, w_ = tid_ >> 6; const int r = t * 128 + w_ * 16 + (lane_ & 15);
        const float rs = pg8::row_rstd_q(F.SSQ, pm * 256 + r, lane_ >> 4); if ((lane_ >> 4) == 0) tb[r] = rs; }
    __syncthreads(); return (LAS const float*)tb;
}
template <int L> __device__ __forceinline__ void p1_std(Frame& F, const Args& A_) {
    constexpr int N = L == 0 ? 3072 : L == 1 ? 1536 : L == 2 ? 1280 : 2048;
    const bf16* wt = F.WT + (L == 0 ? WO_QKV0 : L == 1 ? WO_QKV1 : L == 2 ? WO_QKV2 : WO_WIN3);
    pg8::Gemm g{F.XS, wt, MT, N, 1024, 0}; pg8::StaticOrder S; if (F.xm) S.init_x(MT, N, F.xg, F.lidx); else S.init(MT, N, F.G, (int)blockIdx.x);
    pg8::EpiProj<L> E{F.SSQ, F.BIAS + (size_t)L * BIAS_SLOT, N, F.R, L == 0 ? 16 : L == 1 ? 4 : 2, A_.in[15], A_.in[16], F.CS};
    pg8::gemm_phase<pg8::EpiProj<L>, pg8::StaticOrder, true, true>(F.lds, g, S, E, F.wave0);
}
template <int L> __device__ __forceinline__ void mixer(Frame& F, const Args& A_, const XcdBarrier& bar) {
    if constexpr (L < 3) attn_phase<L>(F, A_);
    else lru_sweeps(F, A_);
}
template <int L> __device__ __forceinline__ void tail_std(Frame& F, const Args& A_, const XcdBarrier& bar) {
    const float* mod = F.MOD + (size_t)L * 9 * 6144;
    constexpr int Mo = L == 3 ? ML : MT;
    {
        const bf16* A = L == 3 ? (const bf16*)(F.R + SL_GL) : (const bf16*)F.HF;
        const bf16* wt = F.WT + (L == 0 ? WO_WO0 : L == 1 ? WO_WO1 : L == 2 ? WO_WO2 : WO_WOUT3);
        pg8::Gemm g{A, wt, Mo, 1024, 1024, L == 3 ? SLAB : (size_t)0}; pg8::StaticOrder S; if (F.xm) S.init_x(Mo, 1024, F.xg, F.lidx); else S.init(Mo, 1024, F.G, (int)blockIdx.x);
        pg8::EpiResid<L == 0> E{F.HL, F.HC, mod + 2 * 1024, mod + 4 * 1024, A_.in[7] + L * 1024, F.XS, F.SSQ, L == 0 ? A_.in[0] : nullptr, L == 0 ? A_.in[2] : nullptr};
        E.ssl = (LAS float*)(F.lds + 131072 + 11264);
        pg8::gemm_phase<pg8::EpiResid<L == 0>, pg8::StaticOrder, true, true>(F.lds, g, S, E, F.wave0);
    }
    XSYNC();
    {
        pg8::Gemm g{F.XS, F.WT + WO_FIN + (size_t)L * 5632 * 1024, Mo, 5632, 1024, 0}; pg8::StaticOrder S; if (F.xm) S.init_x(Mo, 5632, F.xg, F.lidx); else S.init(Mo, 5632, F.G, (int)blockIdx.x);
        pg8::EpiSwiGLU E{F.SSQ, F.BIAS + (size_t)(4 + L) * BIAS_SLOT, F.R};
        { pg8::Unit u0; if (S.next(0, u0)) { E.rpm = u0.pm; E.rsl = rstd_table(F, u0.pm); } }
        pg8::gemm_phase<pg8::EpiSwiGLU, pg8::StaticOrder, true, true>(F.lds, g, S, E, F.wave0);
    }
    XSYNC();
    {
        pg8::Gemm g{(const bf16*)(F.R + SL_HM), F.WT + WO_FOUT + (size_t)L * 1024 * 2816, Mo, 1024, 2816, SLAB}; pg8::StaticOrder S; if (F.xm) S.init_x(Mo, 1024, F.xg, F.lidx); else S.init(Mo, 1024, F.G, (int)blockIdx.x);
        const float* modn = F.MOD + (size_t)(L + 1) * 9 * 6144;
        if constexpr (L == 3) { if (S.nwg == S.G) {
            pg8::EpiResidFinal EF{F.HL, F.out, mod + 5 * 1024, A_.in[8], (float*)(F.ws + WS_SSQ + 1 * MiB), (unsigned*)(F.ws + WS_CTL) + 61440};
            pg8::gemm_phase<pg8::EpiResidFinal, pg8::StaticOrder, false, true>(F.lds, g, S, EF, F.wave0);
            return; } }
        pg8::EpiResid<false> E{F.HL, F.HC, mod + 5 * 1024, L < 3 ? modn + 1024 : nullptr, A_.in[6] + (L < 3 ? (L + 1) * 1024 : 0), L < 3 ? F.XS : nullptr, F.SSQ};
        E.ssl = (LAS float*)(F.lds + 131072 + 11264);
        pg8::gemm_phase<pg8::EpiResid<false>, pg8::StaticOrder, true, true>(F.lds, g, S, E, F.wave0);
    }
    XSYNC();
    if constexpr (L == 3) p_final(F, A_);
}
template <int L> __device__ __forceinline__ void chain(Frame& F, const Args& A_, const XcdBarrier& bar) {
    const float* mod = F.MOD + (size_t)L * 9 * 6144;
    const int c = F.xm ? (F.lidx ^ 16) : (int)blockIdx.x, G = F.xm ? 32 : (int)F.G, J = 6 * L, H2 = G / 2;
    const int EA = 18 + 2 * L, EC = 19 + 2 * L;
    const int lp0 = F.xm ? 8 * F.xg : 0, lnM = F.xm ? 8 : 64, cp0 = F.xm ? 64 + F.xg : 64, cnM = F.xm ? 1 : 8, nr = F.xm;
    {
        const bf16* wt = F.WT + (L == 0 ? WO_WO0 : L == 1 ? WO_WO1 : WO_WO2);
        pg8::Gemm g{(const bf16*)F.HF, wt, MT, 1024, 1024, 0};
        pg8::EpiResid<L == 0> E{F.HL, F.HC, mod + 2 * 1024, mod + 4 * 1024, A_.in[7] + L * 1024, F.XS, F.SSQ, L == 0 ? A_.in[0] : nullptr, L == 0 ? A_.in[2] : nullptr};
        E.ssl = (LAS float*)(F.lds + 131072 + 11264);
        pg8::ListOrder Sl; Sl.init(lp0, lnM, 1024, G, c, 0, 0, nr);
        if (F.xm) sb_wait(F, EA);
        pg8::gemm_phase<pg8::EpiResid<L == 0>, pg8::ListOrder, true, true>(F.lds, g, Sl, E, F.wave0);
        sb_arrive(F, J + 0);
        pg8::ListOrder Sc; Sc.init(cp0, cnM, 1024, G, c, 0, 1, nr);
        if (F.xm && Sc.any()) sb_wait(F, EC);
        pg8::gemm_phase<pg8::EpiResid<L == 0>, pg8::ListOrder, true, true>(F.lds, g, Sc, E, F.wave0);
        sb_arrive(F, J + 1);
    }
    {
        pg8::Gemm g{F.XS, F.WT + WO_FIN + (size_t)L * 5632 * 1024, MT, 5632, 1024, 0};
        pg8::EpiSwiGLU E{F.SSQ, F.BIAS + (size_t)(4 + L) * BIAS_SLOT, F.R};
        pg8::ListOrder Sl; Sl.init(lp0, lnM, 5632, G, c, H2, 0, nr);
        sb_wait(F, J + 0);
        if (F.xm) sb_wait(F, EC);
        { pg8::Unit u0; if (Sl.next(0, u0)) { E.rpm = u0.pm; E.rsl = rstd_table(F, u0.pm); } }
        pg8::gemm_phase<pg8::EpiSwiGLU, pg8::ListOrder, true, true>(F.lds, g, Sl, E, F.wave0);
        sb_arrive(F, J + 2);
        pg8::ListOrder Sc; Sc.init(cp0, cnM, 5632, G, c, 0, 0, nr, F.xm ? 16 : -1);
        if (Sc.any()) sb_wait(F, J + 1);
        pg8::gemm_phase<pg8::EpiSwiGLU, pg8::ListOrder, true, true>(F.lds, g, Sc, E, F.wave0);
        sb_arrive(F, J + 3);
    }
    {
        pg8::Gemm g{(const bf16*)(F.R + SL_HM), F.WT + WO_FOUT + (size_t)L * 1024 * 2816, MT, 1024, 2816, SLAB};
        const float* modn = F.MOD + (size_t)(L + 1) * 9 * 6144;
        pg8::EpiResid<false> E{F.HL, F.HC, mod + 5 * 1024, modn + 1024, A_.in[6] + (L + 1) * 1024, F.XS, F.SSQ};
        E.ssl = (LAS float*)(F.lds + 131072 + 11264);
        pg8::ListOrder Sl; Sl.init(lp0, lnM, 1024, G, c, 0, 0, nr);
        sb_wait(F, J + 2);
        pg8::gemm_phase<pg8::EpiResid<false>, pg8::ListOrder, true, true>(F.lds, g, Sl, E, F.wave0);
        sb_arrive(F, J + 4);
        pg8::ListOrder Sc; Sc.init(cp0, cnM, 1024, G, c, F.xm ? 24 : (5 * G) / 16, 1, nr);
        if (Sc.any()) sb_wait(F, J + 3);
        pg8::gemm_phase<pg8::EpiResid<false>, pg8::ListOrder, true, true>(F.lds, g, Sc, E, F.wave0);
        sb_arrive(F, J + 5);
    }
    {
        constexpr int N = L == 0 ? 1536 : L == 1 ? 1280 : 2048;
        const bf16* wt = F.WT + (L == 0 ? WO_QKV1 : L == 1 ? WO_QKV2 : WO_WIN3);
        pg8::Gemm g{F.XS, wt, MT, N, 1024, 0};
        pg8::EpiProj<L + 1> E{F.SSQ, F.BIAS + (size_t)(L + 1) * BIAS_SLOT, N, F.R, L == 0 ? 4 : 2, A_.in[15], A_.in[16], F.CS};
        if constexpr (L < 2) {
            LAS float* tb = (LAS float*)(F.lds + 131072 + 2048); const int tid_ = fresh_tid(F.wave0);
            for (int i = tid_; i < 2048; i += 512) tb[i] = F.CS[i];
            if (tid_ < 64) { tb[2048 + tid_] = A_.in[15][tid_]; tb[2112 + tid_] = A_.in[16][tid_]; }
            __syncthreads(); E.tb = (LAS const float*)tb; }
        pg8::ListOrder Sl; if (L == 0 && F.xm) { const bool ex = c >= 8 && c < 16; Sl.init(lp0, lnM, ex ? 0 : N, 24, ex ? 0 : (c >= 16 ? c - 16 : c + 16), 0, 0, nr); }
        else Sl.init(lp0, lnM, N, G, c, F.xm ? (L == 1 ? 16 : 8) : 0, 0, nr);
        sb_wait(F, J + 4);
        { pg8::Unit u0; if (Sl.next(0, u0)) { E.rpm = u0.pm; E.rsl = rstd_table(F, u0.pm); } }
        pg8::gemm_phase<pg8::EpiProj<L + 1>, pg8::ListOrder, true, true>(F.lds, g, Sl, E, F.wave0);
        pg8::ListOrder Sc; Sc.init(cp0, cnM, N, G, c, F.xm ? (L >= 1 ? 8 : 24) : H2, (L >= 1 && F.xm) ? 1 : 0, nr);
        if (Sc.any()) sb_wait(F, J + 5);
        pg8::gemm_phase<pg8::EpiProj<L + 1>, pg8::ListOrder, true, true>(F.lds, g, Sc, E, F.wave0);
    }
    XSYNC();
}

__global__ void __launch_bounds__(NWAVES * 64, 2) fwd_kernel(Args args) {
    extern __shared__ __attribute__((aligned(16))) unsigned char lds[];
    Frame F;
    F.lds = (LAS unsigned char*)lds;
        F.wave0 = __builtin_amdgcn_readfirstlane(threadIdx.x >> 6);
    F.G = gridDim.x; { const int bx = blockIdx.x; F.vcu = (F.G % 8 == 0) ? (bx % 8) * (F.G / 8) + bx / 8 : bx; }
    F.out = args.out; F.ws = args.ws;
    F.MOD = (float*)(F.ws + WS_MOD); F.CS = (float*)(F.ws + WS_CS); F.BIAS = (float*)(F.ws + WS_BIAS); F.SSQ = (float*)(F.ws + WS_SSQ); F.HC = (bf16*)(F.ws + WS_HC); F.HL = (bf16*)(F.ws + WS_LRU);
    F.WT = (bf16*)(F.ws + WS_WT); F.XS = (bf16*)(F.ws + WS_XS); F.R = F.ws + WS_R; F.HF = (float*)(F.ws + WS_HF);
    if (threadIdx.x < 8) ((LAS unsigned*)(F.lds + MISC_OFF))[threadIdx.x] = 0u;
    __syncthreads();
    XcdBarrier bar; bar.bar = (unsigned*)(F.ws + WS_CTL) + 4096; bar.st = (volatile LAS unsigned*)(F.lds + MISC_OFF); bar.x = xb_xcc_id();
    if (threadIdx.x == 0) { const unsigned li = xb_add(&bar.bar[XB_XCNT(bar.x)], 1u); ((volatile LAS unsigned*)(F.lds + MISC_OFF))[3] = li; }
    __syncthreads();
    F.xg = (int)bar.x; F.lidx = __builtin_amdgcn_readfirstlane((int)((volatile LAS unsigned*)(F.lds + MISC_OFF))[3]); F.xm = 0;
    p0a(F, args); lru_wprep(F, args); convert_all_weights(F, args);
    GSYNC();
    if (XCDMODE) {
        if (threadIdx.x == 0) { unsigned ok = (F.G == 256) ? 1u : 0u;
            for (unsigned j = 0; j < 16; ++j) { const unsigned cj = xb_ld(&bar.bar[XB_XCNT(j)]); if (cj != (j < 8 ? 32u : 0u)) ok = 0u; }
            ((volatile LAS unsigned*)(F.lds + MISC_OFF))[4] = ok; }
        __syncthreads();
        F.xm = __builtin_amdgcn_readfirstlane((int)((volatile LAS unsigned*)(F.lds + MISC_OFF))[4]);
    }
    p0b(F, args); GSYNC();
    p1_std<0>(F, args); XSYNC(); mixer<0>(F, args, bar); if (!(CHAIN && F.xm)) XSYNC();
    if constexpr (CHAIN) { chain<0>(F, args, bar); } else { tail_std<0>(F, args, bar); p1_std<1>(F, args); XSYNC(); }
    mixer<1>(F, args, bar); if (!(CHAIN && F.xm)) XSYNC();
    if constexpr (CHAIN) { chain<1>(F, args, bar); } else { tail_std<1>(F, args, bar); p1_std<2>(F, args); XSYNC(); }
    mixer<2>(F, args, bar); if (!(CHAIN && F.xm)) XSYNC();
    if constexpr (CHAIN) { chain<2>(F, args, bar); } else { tail_std<2>(F, args, bar); p1_std<3>(F, args); XSYNC(); }
    mixer<3>(F, args, bar); XSYNC();
    tail_std<3>(F, args, bar);
}

extern "C" void kernel_launch(void* const* d_in, const int* in_sizes, int n_in, void* d_out, int out_size, void* d_ws, size_t ws_size, hipStream_t stream) {
    static int grid = 0;
    if (grid == 0) {
        if (n_in != 30 || out_size != ML * DM || ws_size < WS_END) { fprintf(stderr, "kernel_launch: unexpected shapes (n_in %d out %d ws %zu); nothing launched\n", n_in, out_size, ws_size); grid = -1; return; }
        int dev = 0, cus = 0, per_cu = 0;
        if (hipGetDevice(&dev) != hipSuccess || hipDeviceGetAttribute(&cus, hipDeviceAttributeMultiprocessorCount, dev) != hipSuccess) { grid = -1; return; }
        if (hipFuncSetAttribute((const void*)fwd_kernel, hipFuncAttributeMaxDynamicSharedMemorySize, LDS_BYTES) != hipSuccess) { fprintf(stderr, "kernel_launch: hipFuncSetAttribute failed\n"); grid = -1; return; }
        if (hipOccupancyMaxActiveBlocksPerMultiprocessor(&per_cu, (const void*)fwd_kernel, NWAVES * 64, LDS_BYTES) != hipSuccess || per_cu < 1) { fprintf(stderr, "kernel_launch: occupancy query says %d\n", per_cu); per_cu = 1; }
        (void)hipGetLastError();
        grid = cus * (per_cu > 1 ? 1 : per_cu);
    }
    if (grid < 0) return;
    if (hipMemsetAsync((char*)d_ws + WS_CTL, 0, CTL_ZERO_BYTES, stream) != hipSuccess) { fprintf(stderr, "kernel_launch: memset failed\n"); return; }
    Args a{};
    for (int i = 0; i < 30; ++i) a.in[i] = (const float*)d_in[i];
    a.out = (float*)d_out; a.ws = (unsigned char*)d_ws;
    void* kargs[] = {&a};
    const hipError_t e = hipLaunchCooperativeKernel((const void*)fwd_kernel, dim3(grid), dim3(NWAVES * 64), kargs, LDS_BYTES, stream);
    if (e != hipSuccess) fprintf(stderr, "kernel_launch: cooperative launch failed: %s (grid %d)\n", hipGetErrorString(e), grid);
}
```

```cpp
#include <hip/hip_runtime.h>
#include <cstdio>
#include <cstdint>

constexpr int DM = 1024, NB = 8, SEQ = 2048, CTXL = 256, HD = 64, FF = 2816, NMOD = 6;
constexpr int ML = NB * SEQ;
constexpr int MC = NB * CTXL;
constexpr int MT = ML + MC;
constexpr float LOG2E = 1.4426950408889634f;
constexpr float QSCALE = 0.125f * LOG2E;
constexpr size_t SLAB = 14155776;
constexpr size_t SL_Q = 0, SL_K = 4718592, SL_V = 9437184;
constexpr size_t SL_HM = 0;
constexpr size_t SL_XR = 0, SL_GL = 4718592;
__host__ __device__ __forceinline__ int pan_b(int pm) { return pm < 64 ? pm >> 3 : pm - 64; }
__host__ __device__ __forceinline__ int pan_p(int pm) { return pm < 64 ? pm & 7 : 8; }
__device__ __forceinline__ int fresh_tid(int wave0) { int l; asm volatile("v_mbcnt_lo_u32_b32 %0, -1, 0\n\tv_mbcnt_hi_u32_b32 %0, -1, %0" : "=v"(l)); return wave0 * 64 + l; }
namespace pg8 {
#define PG8_LAS __attribute__((address_space(3)))
typedef unsigned short bf16_t;
typedef short bf16x8 __attribute__((ext_vector_type(8)));
typedef float f32x4 __attribute__((ext_vector_type(4)));
typedef unsigned u32x4 __attribute__((ext_vector_type(4)));
constexpr int BM = 256, BK = 64, HALF = 128, HTB = HALF * BK * 2  , STAGE_BYTES = 8 * HTB, NXCD = 8, WGM = 8;

__host__ __device__ __forceinline__ int lds_byte(int r, int c) { const int st = (r >> 4) * 2 + (c >> 5), rr = r & 15, cc = c & 31, ob = rr * 64 + cc * 2; return st * 1024 + (ob ^ (((ob >> 9) & 1) << 5)); }
__host__ __device__ __forceinline__ void stage_rc(int b, int& R, int& C) { const int st = b / 1024, sb = b % 1024, swz = sb ^ (((sb >> 9) & 1) << 5); R = (st >> 1) * 16 + swz / 64; C = (st & 1) * 32 + (swz % 64) / 2; }
__host__ __device__ __forceinline__ int perm32(int rho) { const int n = rho >> 4, i = rho & 15; return 8 * (i >> 2) + 4 * n + (i & 3); }

struct Unit { int pm, pn, hm; };
struct Gemm { const bf16_t* A; const bf16_t* Bt; int M, N, K; size_t slab;
    __device__ __forceinline__ const char* abase(int pm, size_t tstep) const { return slab ? (const char*)A + (size_t)pan_b(pm) * slab + (size_t)pan_p(pm) * tstep : (const char*)A + (size_t)pm * tstep; } };

struct StaticOrder {
    int nM, nN, nwg, G, c, xm, xg;
    __host__ __device__ void init(int M, int N, int G_, int c_) { nM = M / BM; nN = N / BM; nwg = nM * nN; G = G_; c = c_; xm = 0; xg = 0; }
    __host__ __device__ void init_x(int M, int N, int x, int lidx) { nM = M / BM == 72 ? 9 : 8; nN = N / BM; nwg = nM * nN; G = 32; c = lidx; xm = 1; xg = x; }
    __host__ __device__ bool next(int i, Unit& u) const {
        const long L0 = (long)i * G + c; const int nfull = (nwg / G) * G, rem = nwg - nfull; const bool halves = rem > 0 && 2 * rem <= G;
        long L = L0; u.hm = -1;
        if (halves && L0 >= nfull) { const long t = L0 - nfull; if (t >= 2 * rem) return false; L = nfull + (t >> 1); u.hm = (int)(t & 1); }
        if (L >= nwg) return false;
        if (xm) { const int p = (int)L % nM; u.pn = (int)L / nM; u.pm = p < 8 ? 8 * xg + p : 64 + xg; return true; }
        int wgid = (int)L; { const int q = nwg / NXCD, r = nwg % NXCD, xcd = wgid % NXCD, off = wgid / NXCD; wgid = (xcd < r ? xcd * (q + 1) : r * (q + 1) + (xcd - r) * q) + off; }
        const int nig = WGM * nN, gid = wgid / nig, fm = gid * WGM, gsz = (nM - fm) < WGM ? (nM - fm) : WGM;
        u.pm = fm + ((wgid % nig) % gsz); u.pn = (wgid % nig) / gsz; return true;
    }
    __device__ __forceinline__ void a_ready(const Unit&) const {}
    __device__ __forceinline__ void done(const Unit&) const {}
};

__device__ __forceinline__ unsigned cvt_pk_bf16(float lo, float hi) { unsigned r; asm volatile("v_cvt_pk_bf16_f32 %0, %1, %2" : "=v"(r) : "v"(lo), "v"(hi)); return r; }
typedef float f32x2 __attribute__((ext_vector_type(2)));
struct ListOrder {
    int pm0, nM, nN, nwg, G, r, nfull, noremap;
    __host__ __device__ void init(int pm0_, int nM_, int N, int G_, int c_, int rot, int halves_, int noremap_ = 0, int nfull_ = -1) { pm0 = pm0_; nM = nM_; nN = N / BM; nwg = nM * nN; G = G_; r = (c_ + rot) % G_;
        nfull = nfull_ >= 0 ? nfull_ : (halves_ ? 0 : nwg); noremap = noremap_; }
    __host__ __device__ bool next(int i, Unit& u) const {
        long L = (long)i * G + r; u.hm = -1;
        if (L >= nfull) { const long t = L - nfull; if (t >= 2 * (nwg - nfull)) return false; u.hm = (int)(t & 1); L = nfull + (t >> 1); }
        if (L >= nwg) return false;
        if (noremap) { u.pm = pm0 + (int)L % nM; u.pn = (int)L / nM; return true; }
        int wgid = (int)L; { const int q = nwg / NXCD, rr = nwg % NXCD, xcd = wgid % NXCD, off = wgid / NXCD; wgid = (xcd < rr ? xcd * (q + 1) : rr * (q + 1) + (xcd - rr) * q) + off; }
        const int nig = WGM * nN, gid = wgid / nig, fm = gid * WGM, gsz = (nM - fm) < WGM ? (nM - fm) : WGM;
        u.pm = pm0 + fm + ((wgid % nig) % gsz); u.pn = (wgid % nig) / gsz; return true;
    }
    __host__ __device__ bool any() const { return r < nfull + 2 * (nwg - nfull); }
    __device__ __forceinline__ void a_ready(const Unit&) const {}
    __device__ __forceinline__ void done(const Unit&) const {}
};

__device__ __forceinline__ float bperm_f(int src_lane, float v) { return __builtin_bit_cast(float, __builtin_amdgcn_ds_bpermute(src_lane << 2, __builtin_bit_cast(int, v))); }
__device__ __forceinline__ int mod_row(int pm) { return pm < 64 ? (pm >> 3) : 8; }
__device__ __forceinline__ float row_rstd(const float* ssq, int row) {
    const f32x4 s = *(const f32x4*)(ssq + (size_t)row * 4);
    return rsqrtf(((s[0] + s[1]) + (s[2] + s[3])) * (1.0f / 1024.0f) + 1e-6f);
}
__device__ __forceinline__ float fq_sum(float t) {
    { auto r = __builtin_amdgcn_permlane16_swap(__float_as_uint(t), __float_as_uint(t), false, false); t = __uint_as_float(r[0]) + __uint_as_float(r[1]); }
    { auto r = __builtin_amdgcn_permlane32_swap(__float_as_uint(t), __float_as_uint(t), false, false); t = __uint_as_float(r[0]) + __uint_as_float(r[1]); }
    return t;
}
__device__ __forceinline__ float row_rstd_q(const float* ssq, int row, int fq) {
    (void)fq; const f32x4 p = *(const f32x4*)(ssq + (size_t)row * 4);
    const float t = (p[0] + p[1]) + (p[2] + p[3]);
    return rsqrtf(t * (1.0f / 1024.0f) + 1e-6f);
}
__device__ __forceinline__ void st_bf16x4(bf16_t* p, f32x4 v) { typedef unsigned u32x2 __attribute__((ext_vector_type(2))); u32x2 w; w.x = cvt_pk_bf16(v[0], v[1]); w.y = cvt_pk_bf16(v[2], v[3]); *(u32x2*)p = w; }
__device__ __forceinline__ void st_bf16x8_pair(bf16_t* p, f32x4 v0, f32x4 v1, int fq) {
    unsigned a0 = cvt_pk_bf16(v0[0], v0[1]), a1 = cvt_pk_bf16(v0[2], v0[3]), b0 = cvt_pk_bf16(v1[0], v1[1]), b1 = cvt_pk_bf16(v1[2], v1[3]);
    auto rx = __builtin_amdgcn_permlane16_swap(a0, b0, false, false); auto ry = __builtin_amdgcn_permlane16_swap(a1, b1, false, false);
    typedef unsigned u32x4_ __attribute__((ext_vector_type(4))); u32x4_ w; w.x = rx[0]; w.y = ry[0]; w.z = rx[1]; w.w = ry[1];
    *(u32x4_*)(p + (fq & 1) * 16 + (fq >> 1) * 8) = w;
}
__device__ __forceinline__ void ld_bf16x8_pair(const bf16_t* p, int fq, f32x4& v0, f32x4& v1) {
    typedef unsigned u32x4_ __attribute__((ext_vector_type(4))); const u32x4_ w = *(const u32x4_*)(p + (fq & 1) * 16 + (fq >> 1) * 8);
    auto rx = __builtin_amdgcn_permlane16_swap(w.x, w.z, false, false); auto ry = __builtin_amdgcn_permlane16_swap(w.y, w.w, false, false);
    v0[0] = __builtin_bit_cast(float, rx[0] << 16); v0[1] = __builtin_bit_cast(float, rx[0] & 0xffff0000u); v0[2] = __builtin_bit_cast(float, ry[0] << 16); v0[3] = __builtin_bit_cast(float, ry[0] & 0xffff0000u);
    v1[0] = __builtin_bit_cast(float, rx[1] << 16); v1[1] = __builtin_bit_cast(float, rx[1] & 0xffff0000u); v1[2] = __builtin_bit_cast(float, ry[1] << 16); v1[3] = __builtin_bit_cast(float, ry[1] & 0xffff0000u);
}
__device__ __forceinline__ float gelu_tanh(float x) { const float z = 0.7978845608028654f * (x + 0.044715f * x * x * x); const float t = 1.0f - 2.0f * __builtin_amdgcn_rcpf(__builtin_amdgcn_exp2f(2.8853900817779268f * z) + 1.0f); return 0.5f * x * (1.0f + t); }

template <int KIND>
struct EpiProj {
    static constexpr bool PERM = false, AFTER_DRAIN = false;
    const float* ssq; const float* bias; int N;
    unsigned char* R; int nk;
    const float* qgain; const float* kgain; const float* cs;
    PG8_LAS const float* rsl = nullptr; int rpm = -1;
    PG8_LAS const float* tb = nullptr;
    __device__ __forceinline__ void operator()(const f32x4 (&acc)[2][2][4][2], const Unit& u, int wr, int wc, int fr, int fq) const {
        asm volatile("" : "+v"(fr), "+v"(fq));
        const int rm = mod_row(u.pm); const bool lat = u.pm < 64;
        const int g = 4 * u.pn + wc;
        const int tcol = u.pn * BM + wc * 32 + 4 * fq;
        unsigned char* Rb = R + (size_t)pan_b(u.pm) * SLAB; const int lr0 = (pan_p(u.pm) - u.pm) * BM;
        f32x4 bv[2][2];
#pragma unroll
        for (int bj = 0; bj < 2; ++bj)
#pragma unroll
            for (int n = 0; n < 2; ++n) bv[bj][n] = *(const f32x4*)(bias + (size_t)rm * N + tcol + bj * HALF + n * 16);
        if constexpr (KIND == 3) {
#pragma unroll
            for (int ai = 0; ai < 2; ++ai) { if (ai > 0 && u.hm >= 0) continue;
                asm volatile("" ::: "memory"); float rsv[4];
                if (rsl != nullptr && u.pm == rpm) {
#pragma unroll
                    for (int m_ = 0; m_ < 4; ++m_) rsv[m_] = rsl[(u.hm > 0 ? HALF : 0) + ai * HALF + wr * 64 + m_ * 16 + fr];
                } else {
                rsv[0] = row_rstd_q(ssq, u.pm * BM + (u.hm > 0 ? HALF : 0) + ai * HALF + wr * 64 + 0 * 16 + fr, fq); rsv[1] = row_rstd_q(ssq, u.pm * BM + (u.hm > 0 ? HALF : 0) + ai * HALF + wr * 64 + 1 * 16 + fr, fq); asm volatile("" ::: "memory"); rsv[2] = row_rstd_q(ssq, u.pm * BM + (u.hm > 0 ? HALF : 0) + ai * HALF + wr * 64 + 2 * 16 + fr, fq); rsv[3] = row_rstd_q(ssq, u.pm * BM + (u.hm > 0 ? HALF : 0) + ai * HALF + wr * 64 + 3 * 16 + fr, fq);
                }
#pragma unroll
                for (int m = 0; m < 4; ++m) { const int row = u.pm * BM + (u.hm > 0 ? HALF : 0) + ai * HALF + wr * 64 + m * 16 + fr; const float rs = rsv[m];
#pragma unroll
                    for (int bj = 0; bj < 2; ++bj) { f32x4 v2[2];
#pragma unroll
                        for (int n = 0; n < 2; ++n) { const f32x4 v = acc[ai][bj][m][n] * rs + bv[bj][n];
                            if (g < 16) v2[n] = v; else { v2[n][0] = gelu_tanh(v[0]); v2[n][1] = gelu_tanh(v[1]); v2[n][2] = gelu_tanh(v[2]); v2[n][3] = gelu_tanh(v[3]); } }
                        st_bf16x8_pair((g < 16 ? (bf16_t*)(Rb + SL_XR) + g * 64 : (bf16_t*)(Rb + SL_GL) + (g - 16) * 64) + (size_t)(row + lr0) * 1024 + 32 * bj, v2[0], v2[1], fq); } } }
        } else {
            const int slot = g < 16 ? 0 : (g < 16 + nk ? 1 : 2);
            bf16_t* dst; int ld;
            if (slot == 0) { dst = (bf16_t*)(Rb + SL_Q) + g * 64; ld = 1024; } else if (slot == 1) { dst = (bf16_t*)(Rb + SL_K) + (g - 16) * 64; ld = 64 * nk; } else { dst = (bf16_t*)(Rb + SL_V) + (g - 16 - nk) * 64; ld = 64 * nk; }
            const float* gp_ = slot == 0 ? qgain : kgain;
            const float osc = slot == 0 ? QSCALE : 1.0f;
#pragma unroll
            for (int ai = 0; ai < 2; ++ai) { if (ai > 0 && u.hm >= 0) continue;
                asm volatile("" ::: "memory"); float rsv[4];
                if (rsl != nullptr && u.pm == rpm) {
#pragma unroll
                    for (int m_ = 0; m_ < 4; ++m_) rsv[m_] = rsl[(u.hm > 0 ? HALF : 0) + ai * HALF + wr * 64 + m_ * 16 + fr];
                } else {
                rsv[0] = row_rstd_q(ssq, u.pm * BM + (u.hm > 0 ? HALF : 0) + ai * HALF + wr * 64 + 0 * 16 + fr, fq); rsv[1] = row_rstd_q(ssq, u.pm * BM + (u.hm > 0 ? HALF : 0) + ai * HALF + wr * 64 + 1 * 16 + fr, fq); asm volatile("" ::: "memory"); rsv[2] = row_rstd_q(ssq, u.pm * BM + (u.hm > 0 ? HALF : 0) + ai * HALF + wr * 64 + 2 * 16 + fr, fq); rsv[3] = row_rstd_q(ssq, u.pm * BM + (u.hm > 0 ? HALF : 0) + ai * HALF + wr * 64 + 3 * 16 + fr, fq);
                }
#pragma unroll
                for (int m = 0; m < 4; ++m) { const int row = u.pm * BM + (u.hm > 0 ? HALF : 0) + ai * HALF + wr * 64 + m * 16 + fr; const float rs = rsv[m];
                    f32x4 v[2][2];
#pragma unroll
                    for (int bj = 0; bj < 2; ++bj)
#pragma unroll
                        for (int n = 0; n < 2; ++n) v[bj][n] = acc[ai][bj][m][n] * rs + bv[bj][n];
                    if constexpr (KIND == 1) { if (slot != 2) {
                        float s = 0.f;
#pragma unroll
                        for (int bj = 0; bj < 2; ++bj)
#pragma unroll
                            for (int n = 0; n < 2; ++n) { const f32x4 x = v[bj][n]; s += (x[0] * x[0] + x[1] * x[1]) + (x[2] * x[2] + x[3] * x[3]); }
                        s = fq_sum(s);
                        const float r = rsqrtf(s * (1.0f / 64.0f) + 1e-6f);
#pragma unroll
                        for (int bj = 0; bj < 2; ++bj)
#pragma unroll
                            for (int n = 0; n < 2; ++n) v[bj][n] = v[bj][n] * r * (*(const PG8_LAS f32x4*)(tb + (slot == 0 ? 2048 : 2112) + 32 * bj + 16 * n + 4 * fq)); } }
                    if constexpr (KIND == 1 || KIND == 2) { if (slot != 2 && lat) {
                        const int t = row & 2047;
#pragma unroll
                        for (int bj = 0; bj < 2; ++bj) { const int pos = bj == 0 ? (t >> 6) : (t & 63);
                            const f32x4 c01 = *(const PG8_LAS f32x4*)(tb + (pos * 16 + 4 * fq) * 2), c23 = *(const PG8_LAS f32x4*)(tb + (pos * 16 + 4 * fq) * 2 + 4);
                            const f32x4 co = {c01[0], c01[2], c23[0], c23[2]}, si = {c01[1], c01[3], c23[1], c23[3]};
                            const f32x4 x1 = v[bj][0], x2 = v[bj][1];
                            v[bj][0] = x1 * co - x2 * si; v[bj][1] = x1 * si + x2 * co; } } }
#pragma unroll
                    for (int bj = 0; bj < 2; ++bj) {
                        if (slot == 1) {
                            const int lrow = row + lr0, chunk = 4 * bj + 2 * (fq & 1) + (fq >> 1);
                            bf16_t* kp = (bf16_t*)(Rb + SL_K) + ((size_t)(((g - 16) * 36 + (lrow >> 6)) * 8 + chunk) * 64 + (lrow & 63)) * 8 - ((fq & 1) * 16 + (fq >> 1) * 8);
                            st_bf16x8_pair(kp, v[bj][0] * osc, v[bj][1] * osc, fq);
                        } else st_bf16x8_pair(dst + (size_t)(row + lr0) * ld + 32 * bj, v[bj][0] * osc, v[bj][1] * osc, fq); } } }
        }
    }
};

struct EpiSwiGLU {
    static constexpr bool PERM = false, AFTER_DRAIN = false;
    const float* ssq; const float* bias; unsigned char* R;
    PG8_LAS const float* rsl = nullptr; int rpm = -1;
    __device__ __forceinline__ void operator()(const f32x4 (&acc)[2][2][4][2], const Unit& u, int wr, int wc, int fr, int fq) const {
        asm volatile("" : "+v"(fr), "+v"(fq));
        const int rm = mod_row(u.pm); const int tcol = u.pn * BM + wc * 32 + 4 * fq;
        f32x4 bv[2][2];
#pragma unroll
        for (int bj = 0; bj < 2; ++bj)
#pragma unroll
            for (int n = 0; n < 2; ++n) bv[bj][n] = *(const f32x4*)(bias + (size_t)rm * (2 * FF) + tcol + bj * HALF + n * 16);
#pragma unroll
        for (int ai = 0; ai < 2; ++ai) { if (ai > 0 && u.hm >= 0) continue;
            asm volatile("" ::: "memory"); float rsv[4];
            if (rsl != nullptr && u.pm == rpm) {
#pragma unroll
                for (int m = 0; m < 4; ++m) rsv[m] = rsl[(u.hm > 0 ? HALF : 0) + ai * HALF + wr * 64 + m * 16 + fr];
            } else {
#pragma unroll
            for (int m = 0; m < 4; ++m) rsv[m] = row_rstd_q(ssq, u.pm * BM + (u.hm > 0 ? HALF : 0) + ai * HALF + wr * 64 + m * 16 + fr, fq); }
#pragma unroll
            for (int m = 0; m < 4; ++m) { const int row = u.pm * BM + (u.hm > 0 ? HALF : 0) + ai * HALF + wr * 64 + m * 16 + fr; const float rs = rsv[m];
                f32x4 o2[2];
#pragma unroll
                for (int n = 0; n < 2; ++n) { const f32x4 a = acc[ai][0][m][n] * rs + bv[0][n], gg = acc[ai][1][m][n] * rs + bv[1][n];
#pragma unroll
                    for (int e = 0; e < 4; ++e) o2[n][e] = a[e] * __builtin_amdgcn_rcpf(1.0f + __builtin_amdgcn_exp2f(-1.4426950408889634f * a[e])) * gg[e]; }
                st_bf16x8_pair((bf16_t*)(R + (size_t)pan_b(u.pm) * SLAB + SL_HM) + (size_t)(row + (pan_p(u.pm) - u.pm) * BM) * FF + u.pn * 128 + wc * 32, o2[0], o2[1], fq); } }
    }
};

template <bool F32IN>
struct EpiResid {
    static constexpr bool PERM = false, AFTER_DRAIN = false;
    bf16_t* Hl; bf16_t* Hc; const float* gate; const float* nsc; const float* ng; bf16_t* XS; float* ssq;
    const float* Rl = nullptr; const float* Rc = nullptr;
    PG8_LAS float* ssl = nullptr;
    __device__ __forceinline__ void operator()(const f32x4 (&acc)[2][2][4][2], const Unit& u, int wr, int wc, int fr, int fq) const {
        asm volatile("" : "+v"(fr), "+v"(fq));
        const int rm = mod_row(u.pm);
        bf16_t* Hb = u.pm < 64 ? Hl + (size_t)u.pm * BM * 1024 : Hc + (size_t)(u.pm - 64) * BM * 1024;
        const float* Rb = F32IN ? (u.pm < 64 ? Rl + (size_t)u.pm * BM * 1024 : Rc + (size_t)(u.pm - 64) * BM * 1024) : nullptr;
        const int col0 = u.pn * BM + wc * 32 + 4 * fq; const int cst = u.pn * BM + wc * 32;
        f32x4 gt[2][2], gs[2][2];
#pragma unroll
        for (int bj = 0; bj < 2; ++bj)
#pragma unroll
            for (int n = 0; n < 2; ++n) { const int col = col0 + bj * HALF + n * 16; gt[bj][n] = *(const f32x4*)(gate + (size_t)rm * 6144 + col);
                if (XS) gs[bj][n] = *(const f32x4*)(ng + col) * (*(const f32x4*)(nsc + (size_t)rm * 6144 + col) + 1.0f); else gs[bj][n] = (f32x4){0.f, 0.f, 0.f, 0.f}; }
#pragma unroll
        for (int ai = 0; ai < 2; ++ai) { if (ai > 0 && u.hm >= 0) continue;
#pragma unroll
          for (int mh = 0; mh < 2; ++mh) {
            asm volatile("" ::: "memory");
            const int rl0 = (u.hm > 0 ? HALF : 0) + ai * HALF + wr * 64 + mh * 32 + fr;
            f32x4 hv[2][2][2];
#pragma unroll
            for (int m = 0; m < 2; ++m)
#pragma unroll
                for (int bj = 0; bj < 2; ++bj) {
                    if constexpr (F32IN) {
#pragma unroll
                        for (int n = 0; n < 2; ++n) hv[m][bj][n] = __builtin_nontemporal_load((const f32x4*)(Rb + (size_t)(rl0 + m * 16) * 1024 + col0 + bj * HALF + n * 16));
                    } else ld_bf16x8_pair(Hb + (size_t)(rl0 + m * 16) * 1024 + cst + bj * HALF, fq, hv[m][bj][0], hv[m][bj][1]); }
            float ssv[2];
#pragma unroll
            for (int m = 0; m < 2; ++m) { const int rl = rl0 + m * 16; const int row = u.pm * BM + rl; float ss = 0.f;
#pragma unroll
                for (int bj = 0; bj < 2; ++bj) { f32x4 xo[2], ho[2];
#pragma unroll
                    for (int n = 0; n < 2; ++n) {
                        const f32x4 hn = hv[m][bj][n] + gt[bj][n] * acc[ai][bj][2 * mh + m][n]; ho[n] = hn;
                        ss += (hn[0] * hn[0] + hn[1] * hn[1]) + (hn[2] * hn[2] + hn[3] * hn[3]);
                        xo[n] = hn * gs[bj][n]; }
                    st_bf16x8_pair(Hb + (size_t)rl * 1024 + cst + bj * HALF, ho[0], ho[1], fq);
                    if (XS) st_bf16x8_pair(XS + (size_t)row * 1024 + cst + bj * HALF, xo[0], xo[1], fq); }
                ssv[m] = fq_sum(ss); }
            if (fq == 0) {
#pragma unroll
                for (int m = 0; m < 2; ++m) ssl[(wr * 4 + wc) * 128 + ai * 64 + mh * 32 + m * 16 + fr] = ssv[m]; } } }
        asm volatile("s_waitcnt lgkmcnt(0)" ::: "memory"); __builtin_amdgcn_s_barrier(); asm volatile("" ::: "memory");
        if (wc == 0) { const int lane_ = fq * 16 + fr;
#pragma unroll
            for (int t = 0; t < 2; ++t) { const int rr = lane_ + 64 * t;
                if (t == 0 || u.hm < 0) { const float tot = (ssl[(wr * 4 + 0) * 128 + rr] + ssl[(wr * 4 + 1) * 128 + rr]) + (ssl[(wr * 4 + 2) * 128 + rr] + ssl[(wr * 4 + 3) * 128 + rr]);
                    const int rl = (u.hm > 0 ? HALF : 0) + (rr >> 6) * HALF + wr * 64 + (rr & 63);
                    ssq[(size_t)(u.pm * BM + rl) * 4 + u.pn] = tot; } } }
    }
};

struct EpiResidFinal {
    static constexpr bool PERM = false, AFTER_DRAIN = true;
    const bf16_t* H; float* out; const float* gate; const float* gfin; float* ssqx; unsigned* cnt;
    __device__ __forceinline__ void fused(f32x4 (&acc)[2][2][4][2], const Unit& u, int wr, int wc, int fr, int fq, PG8_LAS unsigned char* lds, int wid, int lane) const {
        asm volatile("" : "+v"(fr), "+v"(fq));
        const int rm = mod_row(u.pm); const bf16_t* Hb = H + (size_t)u.pm * BM * 1024; const int col0 = u.pn * BM + wc * 32 + 4 * fq; const int cst = u.pn * BM + wc * 32;
        f32x4 gt[2][2];
#pragma unroll
        for (int bj = 0; bj < 2; ++bj)
#pragma unroll
            for (int n = 0; n < 2; ++n) gt[bj][n] = *(const f32x4*)(gate + (size_t)rm * 6144 + col0 + bj * HALF + n * 16);
#pragma unroll
        for (int ai = 0; ai < 2; ++ai)
#pragma unroll
            for (int mh = 0; mh < 2; ++mh) { asm volatile("" ::: "memory");
                const int rl0 = ai * HALF + wr * 64 + mh * 32 + fr; f32x4 hv[2][2][2];
#pragma unroll
                for (int m = 0; m < 2; ++m)
#pragma unroll
                    for (int bj = 0; bj < 2; ++bj) ld_bf16x8_pair(Hb + (size_t)(rl0 + m * 16) * 1024 + cst + bj * HALF, fq, hv[m][bj][0], hv[m][bj][1]);
#pragma unroll
                for (int m = 0; m < 2; ++m) { float ss = 0.f;
#pragma unroll
                    for (int bj = 0; bj < 2; ++bj)
#pragma unroll
                        for (int n = 0; n < 2; ++n) { const f32x4 hn = hv[m][bj][n] + gt[bj][n] * acc[ai][bj][2 * mh + m][n]; acc[ai][bj][2 * mh + m][n] = hn;
                            ss += (hn[0] * hn[0] + hn[1] * hn[1]) + (hn[2] * hn[2] + hn[3] * hn[3]); }
                    ss = fq_sum(ss);
                    if (fq == 0) __hip_atomic_store(ssqx + (size_t)(u.pm * BM + rl0 + m * 16) * 16 + 4 * u.pn + wc, ss, __ATOMIC_RELAXED, __HIP_MEMORY_SCOPE_AGENT); } }
        asm volatile("s_waitcnt vmcnt(0)" ::: "memory");
        if (lane == 0) __hip_atomic_fetch_add(cnt + 64 * u.pm, 1u, __ATOMIC_RELAXED, __HIP_MEMORY_SCOPE_AGENT);
        if (wid == 0) { unsigned sp = 0;
            while ((unsigned)__builtin_amdgcn_readfirstlane(__hip_atomic_load(cnt + 64 * u.pm, __ATOMIC_RELAXED, __HIP_MEMORY_SCOPE_AGENT)) < 32u) { __builtin_amdgcn_s_sleep(2); if (++sp > (1u << 21)) break; }
            __builtin_amdgcn_fence(__ATOMIC_ACQUIRE, "agent"); asm volatile("s_waitcnt vmcnt(0)" ::: "memory"); }
        asm volatile("s_waitcnt lgkmcnt(0)" ::: "memory"); __builtin_amdgcn_s_barrier(); asm volatile("" ::: "memory");
        f32x4 gf[2][2];
#pragma unroll
        for (int bj = 0; bj < 2; ++bj)
#pragma unroll
            for (int n = 0; n < 2; ++n) gf[bj][n] = *(const f32x4*)(gfin + col0 + bj * HALF + n * 16);
#pragma unroll
        for (int ai = 0; ai < 2; ++ai) { asm volatile("" ::: "memory"); float rsv[4];
#pragma unroll
            for (int m = 0; m < 4; ++m) { const unsigned long long* sp8 = (const unsigned long long*)(ssqx + (size_t)(u.pm * BM + ai * HALF + wr * 64 + m * 16 + fr) * 16); float t = 0.f;
#pragma unroll
                for (int q = 0; q < 8; ++q) { const unsigned long long w = __hip_atomic_load(sp8 + q, __ATOMIC_RELAXED, __HIP_MEMORY_SCOPE_AGENT); t += __uint_as_float((unsigned)w) + __uint_as_float((unsigned)(w >> 32)); }
                rsv[m] = rsqrtf(t * (1.0f / 1024.0f) + 1e-6f); }
#pragma unroll
            for (int m = 0; m < 4; ++m) { const int row = u.pm * BM + ai * HALF + wr * 64 + m * 16 + fr;
#pragma unroll
                for (int bj = 0; bj < 2; ++bj)
#pragma unroll
                    for (int n = 0; n < 2; ++n) __builtin_nontemporal_store(acc[ai][bj][m][n] * rsv[m] * gf[bj][n], (f32x4*)(out + (size_t)row * 1024 + col0 + bj * HALF + n * 16)); } }
    }
    __device__ __forceinline__ void operator()(const f32x4 (&)[2][2][4][2], const Unit&, int, int, int, int) const {}
};

template <class Epi, class Sched, bool ALIGN_EPI = false, bool SP2 = false>
__device__ __forceinline__ void gemm_phase(PG8_LAS unsigned char* lds, const Gemm g, const Sched& S, const Epi& E, const int wave0) {
    const int tid = fresh_tid(wave0), wid = __builtin_amdgcn_readfirstlane(tid >> 6), lane = tid & 63, wr = wid >> 2, wc = wid & 3, fr = lane & 15, fq = lane >> 4;
    const int K = g.K, nt = K / BK;
    unsigned voffA[2], voffB[2];
#pragma unroll
    for (int i = 0; i < 2; ++i) { int R, C; stage_rc(tid * 16 + i * 8192, R, C); const int Rb = Epi::PERM ? ((R & ~31) + perm32(R & 31)) : R;
        voffA[i] = (unsigned)(R * K + C) * 2u; voffB[i] = (unsigned)(Rb * K + C) * 2u; }
    const size_t kstep = (size_t)(BK * 2);
    const size_t hstep = (size_t)HALF * K * 2;
    const size_t tstep = 2 * hstep;
    const unsigned ldsw = (unsigned)wid * 1024u;
    const int aoff = lds_byte(wr * 64 + fr, fq * 8), boff = lds_byte(wc * 32 + fr, fq * 8);
#define PG8_SA(b, h) (((b) * 2 + (h)) * HTB)
#define PG8_SB(b, h) ((4 + (b) * 2 + (h)) * HTB)
#define PG8_STAGE(bufoff, gbase, voff) do { _Pragma("unroll") for (int _i = 0; _i < 2; ++_i) \
        __builtin_amdgcn_global_load_lds((const unsigned*)((const char*)(gbase) + (voff)[_i]), (PG8_LAS unsigned*)(lds + (bufoff) + ldsw + _i * 8192), 16, 0, 0); } while (0)
#define PG8_LDA(dst, b, h) do { _Pragma("unroll") for (int m = 0; m < 4; ++m) _Pragma("unroll") for (int k = 0; k < 2; ++k) dst[m][k] = *(const PG8_LAS bf16x8*)(lds + PG8_SA(b, h) + aoff + m * 2048 + k * 1024); } while (0)
#define PG8_LDB(dst, b, h) do { _Pragma("unroll") for (int n = 0; n < 2; ++n) _Pragma("unroll") for (int k = 0; k < 2; ++k) dst[n][k] = *(const PG8_LAS bf16x8*)(lds + PG8_SB(b, h) + boff + n * 2048 + k * 1024); } while (0)
#define PG8_MMA(ai, bj, At, Bt) do { __builtin_amdgcn_s_setprio(1); _Pragma("unroll") for (int m = 0; m < 4; ++m) _Pragma("unroll") for (int n = 0; n < 2; ++n) _Pragma("unroll") for (int k = 0; k < 2; ++k) \
        acc[ai][bj][m][n] = __builtin_amdgcn_mfma_f32_16x16x32_bf16(Bt[n][k], At[m][k], acc[ai][bj][m][n], 0, 0, 0); __builtin_amdgcn_s_setprio(0); } while (0)
#define PG8_WAIT_V(n) asm volatile("s_waitcnt vmcnt(" #n ")" ::: "memory")
#define PG8_WAIT_L(n) asm volatile("s_waitcnt lgkmcnt(" #n ")" ::: "memory")
#define PG8_BAR __builtin_amdgcn_s_barrier()
#define PG8_SCHED __builtin_amdgcn_sched_barrier(0)
    Unit cur, nxt; int ui = 0;
    if (!S.next(0, cur)) return;
    f32x4 acc[2][2][4][2];
#pragma unroll
    for (int a = 0; a < 2; ++a)
#pragma unroll
        for (int b = 0; b < 2; ++b)
#pragma unroll
            for (int m = 0; m < 4; ++m)
#pragma unroll
                for (int n = 0; n < 2; ++n) acc[a][b][m][n] = (f32x4){0.f, 0.f, 0.f, 0.f};
    bf16x8 At[4][2], B0[2][2], B1[2][2];
    static_assert(SP2, "half units are wired into the SP2 loop only");
    const char* cA = g.abase(cur.pm, tstep) + (cur.hm > 0 ? hstep : 0); const char* cB = (const char*)g.Bt + (size_t)cur.pn * tstep;
    size_t cAh = cur.hm >= 0 ? 0 : hstep;
    S.a_ready(cur);
    if constexpr (SP2) {
        PG8_STAGE(PG8_SB(0, 0), cB, voffB); PG8_STAGE(PG8_SB(0, 1), cB + hstep, voffB); PG8_STAGE(PG8_SA(0, 0), cA, voffA); PG8_STAGE(PG8_SA(0, 1), cA + cAh, voffA);
        if (wr == 1) PG8_BAR;
        PG8_WAIT_V(2); PG8_BAR;
        PG8_STAGE(PG8_SB(1, 0), cB + kstep, voffB); PG8_STAGE(PG8_SA(1, 0), cA + kstep, voffA); PG8_STAGE(PG8_SB(1, 1), cB + hstep + kstep, voffB);
        PG8_WAIT_V(6); PG8_BAR;
    } else {
        PG8_STAGE(PG8_SB(0, 0), cB, voffB); PG8_STAGE(PG8_SA(0, 0), cA, voffA); PG8_STAGE(PG8_SB(0, 1), cB + hstep, voffB); PG8_STAGE(PG8_SA(0, 1), cA + hstep, voffA);
        if (wr == 1) PG8_BAR;
        PG8_WAIT_V(4); PG8_BAR;
        PG8_STAGE(PG8_SB(1, 0), cB + kstep, voffB); PG8_STAGE(PG8_SA(1, 0), cA + kstep, voffA); PG8_STAGE(PG8_SB(1, 1), cB + hstep + kstep, voffB);
        PG8_WAIT_V(6); PG8_BAR;
    }
    for (;;) {
        const bool has_next = S.next(ui + 1, nxt);
        const char* nA = has_next ? g.abase(nxt.pm, tstep) + (nxt.hm > 0 ? hstep : 0) : cA; const char* nB = has_next ? (const char*)g.Bt + (size_t)nxt.pn * tstep : cB;
        const size_t nAh = has_next ? (nxt.hm >= 0 ? 0 : hstep) : cAh; const bool cfull = cur.hm < 0;
        for (int t = 0; t < nt; t += 2) {
            const bool last = (t == nt - 2);
            int tq = t; asm volatile("" : "+s"(tq));
            const char* a1 = cA + (size_t)(tq + 1) * kstep;
            const char* a2 = last ? nA : cA + (size_t)(tq + 2) * kstep; const char* b2 = last ? nB : cB + (size_t)(tq + 2) * kstep;
            const char* a3 = a2 + kstep; const char* b3 = b2 + kstep;
            const size_t a2h = last ? nAh : cAh;
            if (last && has_next) S.a_ready(nxt);
            if constexpr (SP2) {
            PG8_LDB(B0, 0, 0); PG8_LDB(B1, 0, 1); PG8_SCHED; PG8_LDA(At, 0, 0); PG8_STAGE(PG8_SA(1, 1), a1 + cAh, voffA);
            PG8_WAIT_V(8); PG8_WAIT_L(0); PG8_BAR; PG8_MMA(0, 0, At, B0); PG8_MMA(0, 1, At, B1); PG8_BAR; PG8_SCHED;
            if (cfull) PG8_LDA(At, 0, 1); PG8_STAGE(PG8_SB(0, 0), b2, voffB); PG8_STAGE(PG8_SB(0, 1), b2 + hstep, voffB); PG8_STAGE(PG8_SA(0, 0), a2, voffA);
            PG8_WAIT_V(8); PG8_WAIT_L(0); PG8_BAR; if (cfull) { PG8_MMA(1, 0, At, B0); PG8_MMA(1, 1, At, B1); } PG8_BAR; PG8_SCHED;
            PG8_LDB(B0, 1, 0); PG8_LDB(B1, 1, 1); PG8_SCHED; PG8_LDA(At, 1, 0); PG8_STAGE(PG8_SA(0, 1), a2 + a2h, voffA);
            PG8_WAIT_V(8); PG8_WAIT_L(0); PG8_BAR; PG8_MMA(0, 0, At, B0); PG8_MMA(0, 1, At, B1); PG8_BAR; PG8_SCHED;
            if (cfull) PG8_LDA(At, 1, 1); PG8_STAGE(PG8_SB(1, 0), b3, voffB); PG8_STAGE(PG8_SB(1, 1), b3 + hstep, voffB); PG8_STAGE(PG8_SA(1, 0), a3, voffA);
            PG8_WAIT_V(8); PG8_WAIT_L(0); PG8_BAR; if (cfull) { PG8_MMA(1, 0, At, B0); PG8_MMA(1, 1, At, B1); } PG8_BAR; PG8_SCHED;
            } else {
            PG8_LDB(B0, 0, 0); PG8_SCHED; PG8_LDA(At, 0, 0); PG8_STAGE(PG8_SA(1, 1), a1 + hstep, voffA);
            PG8_WAIT_L(8); PG8_BAR; PG8_WAIT_L(0); PG8_MMA(0, 0, At, B0); PG8_BAR; PG8_SCHED;
            PG8_LDB(B1, 0, 1); PG8_STAGE(PG8_SB(0, 0), b2, voffB);
            PG8_BAR; PG8_WAIT_L(0); PG8_MMA(0, 1, At, B1); PG8_BAR;
            PG8_LDA(At, 0, 1); PG8_STAGE(PG8_SA(0, 0), a2, voffA);
            PG8_BAR; PG8_WAIT_L(0); PG8_MMA(1, 0, At, B0); PG8_BAR; PG8_SCHED;
            PG8_STAGE(PG8_SB(0, 1), b2 + hstep, voffB);
            PG8_WAIT_V(6); PG8_BAR; PG8_MMA(1, 1, At, B1); PG8_BAR;
            PG8_LDB(B0, 1, 0); PG8_SCHED; PG8_LDA(At, 1, 0); PG8_STAGE(PG8_SA(0, 1), a2 + hstep, voffA);
            PG8_WAIT_L(8); PG8_BAR; PG8_WAIT_L(0); PG8_MMA(0, 0, At, B0); PG8_BAR; PG8_SCHED;
            PG8_LDB(B1, 1, 1); PG8_STAGE(PG8_SB(1, 0), b3, voffB);
            PG8_BAR; PG8_WAIT_L(0); PG8_MMA(0, 1, At, B1); PG8_BAR;
            PG8_LDA(At, 1, 1); PG8_STAGE(PG8_SA(1, 0), a3, voffA);
            PG8_BAR; PG8_WAIT_L(0); PG8_MMA(1, 0, At, B0); PG8_BAR; PG8_SCHED;
            PG8_STAGE(PG8_SB(1, 1), b3 + hstep, voffB);
            PG8_WAIT_V(6); PG8_BAR; PG8_MMA(1, 1, At, B1); PG8_BAR;
            }
        }
        if constexpr (ALIGN_EPI) { if (wr == 0) PG8_BAR; }
        if constexpr (!Epi::AFTER_DRAIN) { E(acc, cur, wr, wc, fr, fq); S.done(cur); }
        if (!has_next) break;
#pragma unroll
        for (int a = 0; a < 2; ++a)
#pragma unroll
            for (int b = 0; b < 2; ++b)
#pragma unroll
                for (int m = 0; m < 4; ++m)
#pragma unroll
                    for (int n = 0; n < 2; ++n) acc[a][b][m][n] = (f32x4){0.f, 0.f, 0.f, 0.f};
        cur = nxt; cA = nA; cB = nB; cAh = nAh; ++ui;
        if constexpr (ALIGN_EPI) { if (wr == 1) PG8_BAR; }
    }
    PG8_WAIT_V(0);
    if constexpr (!ALIGN_EPI) { if (wr == 0) PG8_BAR; }
    PG8_BAR;
    if constexpr (Epi::AFTER_DRAIN) { E.fused(acc, cur, wr, wc, fr, fq, lds, wid, lane); S.done(cur); }
#undef PG8_SA
#undef PG8_SB
#undef PG8_STAGE
#undef PG8_LDA
#undef PG8_LDB
#undef PG8_MMA
#undef PG8_WAIT_V
#undef PG8_WAIT_L
#undef PG8_BAR
#undef PG8_SCHED
}
}
#define GAS __attribute__((address_space(1)))
#define LAS __attribute__((address_space(3)))
typedef unsigned short bf16;
typedef unsigned v4u __attribute__((ext_vector_type(4)));
typedef float f32x4 __attribute__((ext_vector_type(4)));
constexpr int NWAVES = 8;
constexpr bool MFMA_ATTN[3] = {true, true, true};
constexpr bool LRU_MFMA = true;
constexpr bool XCDMODE = true;
constexpr bool CHAIN = true;
constexpr int PROBE_DUP_PRO = 1;
constexpr int PROBE_DUP_ATT = 1;
constexpr int PROBE_DUP_P3 = 1, PROBE_DUP_P4 = 1, PROBE_DUP_P5 = 1;
constexpr int PROBE_DUP_ATTN_ONLY[3] = {1, 1, 1};
constexpr int LDS_BYTES = 147456;
constexpr size_t MiB = 1u << 20;
constexpr size_t WS_CTL = 0, CTL_ZERO_BYTES = 1 * MiB;
constexpr size_t WS_MOD = 1 * MiB;
constexpr size_t WS_CS = 2 * MiB;
constexpr size_t WS_BIAS = 3 * MiB;
constexpr size_t BIAS_SLOT = 9 * 5632;
constexpr size_t WS_SSQ = 5 * MiB;
constexpr size_t WS_HC = 8 * MiB;
constexpr size_t WS_WT = 16 * MiB;
constexpr size_t WS_XS = 106 * MiB;
constexpr size_t WS_R = 142 * MiB;
constexpr size_t R3 = 36 * MiB;
constexpr size_t WS_HF = 250 * MiB;
constexpr size_t WS_LRU = 314 * MiB;
constexpr size_t WS_END = 346 * MiB;
constexpr size_t WO_QKV0 = 0, WO_WO0 = WO_QKV0 + 3072 * 1024, WO_QKV1 = WO_WO0 + 1024 * 1024, WO_WO1 = WO_QKV1 + 1536 * 1024, WO_QKV2 = WO_WO1 + 1024 * 1024,
                 WO_WO2 = WO_QKV2 + 1280 * 1024, WO_WIN3 = WO_WO2 + 1024 * 1024, WO_WOUT3 = WO_WIN3 + 2048 * 1024, WO_FIN = WO_WOUT3 + 1024 * 1024,
                 WO_FOUT = WO_FIN + 4 * (size_t)5632 * 1024, WO_END = WO_FOUT + 4 * (size_t)1024 * 2816;
static_assert(WO_END * 2 <= 90 * MiB, "weight region");

struct Args { const float* in[30]; float* out; unsigned char* ws; };

struct Frame {
    LAS unsigned char* lds; int vcu, G, wave0; int xm, xg, lidx;
    float* out; unsigned char* ws;
    float* MOD; float* CS; float* BIAS; float* SSQ; bf16* HC; bf16* HL; bf16* WT; bf16* XS; unsigned char* R; float* HF;
};
#define PHASE_IDS() const int tid = fresh_tid(F.wave0), lane = tid & 63, wave = __builtin_amdgcn_readfirstlane(tid >> 6); (void)tid; (void)lane; (void)wave
#define LDS_WAIT() asm volatile("s_waitcnt lgkmcnt(0)" ::: "memory")
__device__ __forceinline__ unsigned f2bf(float f) { unsigned u = __builtin_bit_cast(unsigned, f); return (u + 0x7fffu + ((u >> 16) & 1u)) >> 16; }
__device__ __forceinline__ unsigned pk2(float lo, float hi) { return f2bf(lo) | (f2bf(hi) << 16); }
__device__ __forceinline__ float bf_lo(unsigned w) { return __builtin_bit_cast(float, w << 16); }
__device__ __forceinline__ float bf_hi(unsigned w) { return __builtin_bit_cast(float, w & 0xffff0000u); }
__device__ __forceinline__ float wave_sum(float v, int lane) {
#pragma unroll
    for (int o = 1; o < 64; o <<= 1) v += pg8::bperm_f(lane ^ o, v);
    return v;
}
__device__ __forceinline__ float silu_f(float x) { return x / (1.0f + __expf(-x)); }

__device__ __forceinline__ int perm_row32(int perm, int n0) {
    if (perm == 1) { const int t = n0 >> 8, w = n0 & 255; return (t << 8) + (((w >> 5) & 1) << 7) + (((w >> 6) & 3) << 5); }
    if (perm == 2) { const int half = n0 >= FF ? 1 : 0; const int i = half ? n0 - FF : n0; return ((i >> 7) << 8) + (half << 7) + (i & 127); }
    return n0;
}
__device__ __forceinline__ void p0_transpose_item(const float* W, int K, int N, bf16* WT, int perm, LAS float* scr, int item, int lane) {
    const int nblk = N / 32, kb = item / nblk, nb = item % nblk, k0 = 64 * kb, n0 = 32 * nb;
    const int orow = perm_row32(perm, n0);
    float wv[32];
#pragma unroll
    for (int i = 0; i < 32; ++i) wv[i] = W[(size_t)(k0 + 2 * i + (lane >> 5)) * N + n0 + (lane & 31)];
#pragma unroll
    for (int i = 0; i < 32; ++i) scr[(2 * i + (lane >> 5)) * 33 + (lane & 31)] = wv[i];
    LDS_WAIT(); asm volatile("" ::: "memory");
    const int c = lane & 7;
#pragma unroll
    for (int j = 0; j < 4; ++j) { const int n = (lane >> 3) + 8 * j; const LAS float* s = scr + (8 * c) * 33 + n;
        v4u o; o.x = pk2(s[0 * 33], s[1 * 33]); o.y = pk2(s[2 * 33], s[3 * 33]); o.z = pk2(s[4 * 33], s[5 * 33]); o.w = pk2(s[6 * 33], s[7 * 33]);
        *(GAS v4u*)(WT + (size_t)(orow + n) * K + k0 + 8 * c) = o; }
    LDS_WAIT(); asm volatile("" ::: "memory");
}
struct WDesc { const float* W; bf16* WT; int K, N, perm; };
__device__ __forceinline__ WDesc wdesc(const Frame& F, const Args& A_, int i) {
    WDesc d;
    switch (i) {
    case 0: d = {A_.in[11], F.WT + WO_QKV0, 1024, 3072, 1}; break;
    case 1: d = {A_.in[13], F.WT + WO_WO0, 1024, 1024, 0}; break;
    case 2: d = {A_.in[14], F.WT + WO_QKV1, 1024, 1536, 1}; break;
    case 3: d = {A_.in[17], F.WT + WO_WO1, 1024, 1024, 0}; break;
    case 4: d = {A_.in[18], F.WT + WO_QKV2, 1024, 1280, 1}; break;
    case 5: d = {A_.in[20], F.WT + WO_WO2, 1024, 1024, 0}; break;
    case 6: d = {A_.in[21], F.WT + WO_WIN3, 1024, 2048, 1}; break;
    case 7: d = {A_.in[29], F.WT + WO_WOUT3, 1024, 1024, 0}; break;
    case 8: case 9: case 10: case 11: d = {A_.in[9] + (size_t)(i - 8) * 1024 * 5632, F.WT + WO_FIN + (size_t)(i - 8) * 5632 * 1024, 1024, 5632, 2}; break;
    default: d = {A_.in[10] + (size_t)(i - 12) * 2816 * 1024, F.WT + WO_FOUT + (size_t)(i - 12) * 1024 * 2816, 2816, 1024, 0}; break;
    }
    return d;
}
__device__ __forceinline__ void p0a(Frame& F, const Args& A_) {
    PHASE_IDS();
    LAS float* sl = (LAS float*)F.lds;
    LAS float* red = (LAS float*)(F.lds + 40960);
#pragma unroll
    for (int j = 0; j < 5; ++j) { const int i4 = (tid + 512 * j) * 4;
        if (i4 < 9 * 1024) { const f32x4 v = i4 < 8192 ? *(const f32x4*)(A_.in[1] + i4) : *(const f32x4*)(A_.in[3] + (i4 - 8192));
            f32x4 o; o[0] = silu_f(v[0]); o[1] = silu_f(v[1]); o[2] = silu_f(v[2]); o[3] = silu_f(v[3]); *(LAS f32x4*)(sl + i4) = o; } }
    __syncthreads();
    for (int u = blockIdx.x; u < 4 * 64; u += F.G) {
        const int l = u >> 6, jb = u & 63; const int lc = lane < 48 ? lane : 47;
        const float* w = A_.in[4] + (size_t)l * 1024 * 6144 + jb * 96 + 2 * lc;
        float a0[9], a1[9];
#pragma unroll
        for (int r = 0; r < 9; ++r) { a0[r] = 0.f; a1[r] = 0.f; }
        const int kb = wave * 128;
#pragma unroll 16
        for (int k = 0; k < 128; ++k) { typedef float f32x2 __attribute__((ext_vector_type(2))); const f32x2 wv = __builtin_nontemporal_load((const f32x2*)(w + (size_t)(kb + k) * 6144));
#pragma unroll
            for (int r = 0; r < 9; ++r) { const float sv = sl[r * 1024 + kb + k]; a0[r] += sv * wv[0]; a1[r] += sv * wv[1]; } }
        if (lane < 48) {
#pragma unroll
            for (int r = 0; r < 9; ++r) { red[(wave * 9 + r) * 96 + 2 * lane] = a0[r]; red[(wave * 9 + r) * 96 + 2 * lane + 1] = a1[r]; } }
        __syncthreads();
        for (int i = tid; i < 9 * 96; i += 512) { const int r = i / 96, j = i % 96; float sm = 0.f;
#pragma unroll
            for (int wv = 0; wv < 8; ++wv) sm += red[(wv * 9 + r) * 96 + j];
            F.MOD[((size_t)l * 9 + r) * 6144 + jb * 96 + j] = sm + A_.in[5][(size_t)l * 6144 + jb * 96 + j]; }
        __syncthreads();
    }
    if (blockIdx.x < 16 && tid < 64) for (int i = blockIdx.x * 64 + tid; i < 64 * 16; i += 1024) { const int pos = i >> 4, j = i & 15; const float inv = 1.0f / powf(10000.0f, (float)(2 * j) / 32.0f); const float ang = (float)pos * inv;
        F.CS[2 * i] = cosf(ang); F.CS[2 * i + 1] = sinf(ang); }
    __syncthreads();
}
struct CItem { const float* src; bf16* dst; int N, K; };
__device__ __forceinline__ CItem citem(const Frame& F, const Args& A_, int gidx) {
    int i = 0, r = gidx;
#pragma unroll 1
    for (; i < 15; ++i) { const WDesc d = wdesc(F, A_, i); const int nit = (d.K / 64) * (d.N / 32); if (r < nit) break; r -= nit; }
    const WDesc d = wdesc(F, A_, i); const int nblk = d.N / 32, kb = r / nblk, nb = r % nblk, k0 = 64 * kb, n0 = 32 * nb;
    CItem c; c.src = d.W + (size_t)k0 * d.N + n0; c.dst = d.WT + (size_t)perm_row32(d.perm, n0) * d.K + k0; c.N = d.N; c.K = d.K; return c;
}
__device__ __forceinline__ void convert_all_weights(Frame& F, const Args& A_) {
    PHASE_IDS();
    LAS float* scr = (LAS float*)(F.lds + wave * 8704);
    constexpr int TOTAL = 1536 + 512 + 768 + 512 + 640 + 512 + 1024 + 512 + 4 * 2816 + 4 * 1408;
    const int gw = F.vcu * NWAVES + wave, NGW = F.G * NWAVES;
    if (gw >= TOTAL) return;
    CItem cur = citem(F, A_, gw);
    float wv[32];
#pragma unroll
    for (int i = 0; i < 32; ++i) wv[i] = __builtin_nontemporal_load(cur.src + (size_t)(2 * i + (lane >> 5)) * cur.N + (lane & 31));
#pragma unroll 1
    for (int g = gw; g < TOTAL; g += NGW) {
#pragma unroll
        for (int i = 0; i < 32; ++i) scr[(2 * i + (lane >> 5)) * 33 + (lane & 31)] = wv[i];
        const CItem me = cur;
        if (g + NGW < TOTAL) { cur = citem(F, A_, g + NGW);
#pragma unroll
            for (int i = 0; i < 32; ++i) wv[i] = __builtin_nontemporal_load(cur.src + (size_t)(2 * i + (lane >> 5)) * cur.N + (lane & 31)); }
        LDS_WAIT(); asm volatile("" ::: "memory");
        const int c = lane & 7;
#pragma unroll
        for (int j = 0; j < 4; ++j) { const int n = (lane >> 3) + 8 * j; const LAS float* sp = scr + (8 * c) * 33 + n;
            v4u o; o.x = pk2(sp[0 * 33], sp[1 * 33]); o.y = pk2(sp[2 * 33], sp[3 * 33]); o.z = pk2(sp[4 * 33], sp[5 * 33]); o.w = pk2(sp[6 * 33], sp[7 * 33]);
            *(GAS v4u*)(me.dst + (size_t)n * me.K + 8 * c) = o; }
        LDS_WAIT(); asm volatile("" ::: "memory");
    }
}

__device__ __forceinline__ void bias_layer(Frame& F, int l0, int l1, int rank, int count) {
    PHASE_IDS();
    typedef short bf16x8 __attribute__((ext_vector_type(8)));
    LAS unsigned short* shb = (LAS unsigned short*)F.lds;
    int ubase = 0;
#pragma unroll 1
    for (int gi = 2 * l0; gi < 2 * l1; ++gi) {
        const int layer = gi >> 1; const int g = (gi & 1) == 0 ? layer : 4 + layer, l = layer; const int N = g >= 4 ? 5632 : (g == 0 ? 3072 : g == 1 ? 1536 : g == 2 ? 1280 : 2048);
        const bf16* wt = F.WT + (g >= 4 ? WO_FIN + (size_t)l * 5632 * 1024 : (g == 0 ? WO_QKV0 : g == 1 ? WO_QKV1 : g == 2 ? WO_QKV2 : WO_WIN3));
        const int shoff = g >= 4 ? 3 * 1024 : 0; const int nun = N / 128;
        for (int uu = ubase + ((rank - ubase % count + count) % count); uu < ubase + nun; uu += count) {
            const int ch = uu - ubase;
            __syncthreads();
#pragma unroll
            for (int j = 0; j < 8; ++j) { const int i = tid + 512 * j; const int r = i >> 8, k4 = (i & 255) * 4; typedef unsigned u32x2_ __attribute__((ext_vector_type(2))); u32x2_ w = {0u, 0u};
                if (r < 9) { const f32x4 v = *(const f32x4*)(F.MOD + ((size_t)l * 9 + r) * 6144 + shoff + k4); w.x = pk2(v[0], v[1]); w.y = pk2(v[2], v[3]); }
                *(LAS u32x2_*)(shb + r * 1032 + k4) = w; }
            __syncthreads();
            const int n0 = ch * 128 + wave * 16; const bf16* wp = wt + (size_t)(n0 + (lane & 15)) * 1024 + 8 * (lane >> 4);
            f32x4 acc = {0.f, 0.f, 0.f, 0.f};
#pragma unroll 16
            for (int st = 0; st < 32; ++st) { const bf16x8 b = *(const bf16x8*)(wp + 32 * st); const bf16x8 a = *(const LAS bf16x8*)(shb + (lane & 15) * 1032 + 32 * st + 8 * (lane >> 4));
                acc = __builtin_amdgcn_mfma_f32_16x16x32_bf16(a, b, acc, 0, 0, 0); }
#pragma unroll
            for (int e = 0; e < 4; ++e) { const int r = 4 * (lane >> 4) + e; if (r < 9) F.BIAS[(size_t)g * BIAS_SLOT + (size_t)r * N + n0 + (lane & 15)] = acc[e]; }
        }
        ubase += nun;
    }
    __syncthreads();
}
__device__ __forceinline__ void p0b(Frame& F, const Args& A_) {
    bias_layer(F, 0, 4, (int)blockIdx.x, (int)F.G);
    PHASE_IDS();
    const int gw = F.vcu * NWAVES + wave, NGW = F.G * NWAVES;
    for (int row0 = gw; row0 < MT; row0 += 3 * NGW) {
        f32x4 v[3][4];
#pragma unroll
        for (int q = 0; q < 3; ++q) { const int row = row0 + q * NGW; if (row < MT) { const bool lat = row < ML; const float* src = lat ? A_.in[0] + (size_t)row * 1024 : A_.in[2] + (size_t)(row - ML) * 1024;
#pragma unroll
            for (int j = 0; j < 4; ++j) v[q][j] = *(const f32x4*)(src + 256 * j + 4 * lane); } }
#pragma unroll
        for (int q = 0; q < 3; ++q) { const int row = row0 + q * NGW; if (row < MT) { const bool lat = row < ML; const int rm = lat ? (row >> 11) : 8;
            const float* sc = F.MOD + (size_t)rm * 6144 + 1024; const float* ng = A_.in[6];
            float sq = 0.f;
#pragma unroll
            for (int j = 0; j < 4; ++j) { const int col = 256 * j + 4 * lane; const f32x4 x = v[q][j];
                sq += (x[0] * x[0] + x[1] * x[1]) + (x[2] * x[2] + x[3] * x[3]);
                const f32x4 o = x * (*(const f32x4*)(ng + col)) * (*(const f32x4*)(sc + col) + 1.0f);
                typedef unsigned u32x2 __attribute__((ext_vector_type(2))); u32x2 w; w.x = pk2(o[0], o[1]); w.y = pk2(o[2], o[3]); *(u32x2*)(F.XS + (size_t)row * 1024 + col) = w; }
            sq = wave_sum(sq, lane);
            if (lane < 4) F.SSQ[(size_t)row * 4 + lane] = lane == 0 ? sq : 0.f; } }
    }
}
__device__ __forceinline__ void p_final(Frame& F, const Args& A_) {
    PHASE_IDS();
    const int gw = F.vcu * NWAVES + wave, NGW = F.G * NWAVES;
    for (int row = gw; row < ML; row += NGW) {
        const float rs = pg8::row_rstd(F.SSQ, row); float* p = F.out + (size_t)row * 1024; const bf16* hp = F.HL + (size_t)row * 1024;
#pragma unroll
        for (int j = 0; j < 4; ++j) { const int col = 256 * j + 4 * lane; typedef unsigned u32x2_ __attribute__((ext_vector_type(2))); const u32x2_ w = *(const u32x2_*)(hp + col);
            const f32x4 hv = {bf_lo(w.x), __builtin_bit_cast(float, w.x & 0xffff0000u), bf_lo(w.y), __builtin_bit_cast(float, w.y & 0xffff0000u)};
            *(f32x4*)(p + col) = hv * rs * (*(const f32x4*)(A_.in[8] + col)); }
    }
}
namespace att {
typedef unsigned short bf16;
using bf16x8=__attribute__((ext_vector_type(8)))short;
using s16x4=__attribute__((ext_vector_type(4)))short;
using f32x16=__attribute__((ext_vector_type(16)))float;
using u32x4=__attribute__((ext_vector_type(4)))unsigned;
constexpr int D=64,NW=8,QBLK=32,QB=QBLK*NW,KVBLK=64,QP=1024;
__device__ __forceinline__ int crow(int r,int hi){return (r&3)+8*(r>>2)+4*hi;}
#define SBAR() __builtin_amdgcn_sched_barrier(0)
constexpr int NSLOT=3, SLOTB=8192;
constexpr int LDS_K=0, LDS_V=NSLOT*SLOTB, LDS_WS=2*NSLOT*SLOTB, LDS_OST=LDS_WS+NW*64*4, LDS_BYTES=LDS_OST+NW*4096;
constexpr int LDS_RPB=86016;
struct Job { const bf16* Q; bf16* O; const bf16* Kc; const bf16* Vc; const bf16* Kl; const bf16* Vl; int NT; int lat; int qpos0; int kt0; int h; int wave0; const float* aux; };

__device__ __forceinline__ void glds16(const void*gsrc,unsigned lds_dst){unsigned keep;
  asm volatile("s_mov_b32 %0, m0\n\ts_mov_b32 m0, %2\n\ts_nop 0\n\tglobal_load_lds_dwordx4 %1, off\n\ts_mov_b32 m0, %0":"=&s"(keep):"v"(gsrc),"s"(lds_dst):"memory");}
__device__ __forceinline__ void glds16s(const void*sbase,unsigned voff,unsigned lds_dst){unsigned keep;
  asm volatile("s_nop 4\n\ts_mov_b32 %0, m0\n\ts_mov_b32 m0, %3\n\ts_nop 0\n\tglobal_load_lds_dwordx4 %1, %2\n\ts_mov_b32 m0, %0":"=&s"(keep):"v"(voff),"s"(sbase),"s"(lds_dst):"memory");}
__device__ __forceinline__ float max3f(float a,float b,float c){float r;asm("v_max3_f32 %0, %1, %2, %3":"=v"(r):"v"(a),"v"(b),"v"(c));return r;}
__device__ __forceinline__ float max2f(float a,float b){float r;asm("v_max_f32_e32 %0, %1, %2":"=v"(r):"v"(a),"v"(b));return r;}
__device__ __forceinline__ float fadd_s(float a,float b){float r;asm("v_add_f32_e32 %0, %1, %2":"=v"(r):"v"(a),"v"(b));return r;}
__device__ __forceinline__ float fsub_s(float a,float b){float r;asm("v_sub_f32_e32 %0, %1, %2":"=v"(r):"v"(a),"v"(b));return r;}
typedef float f32x2_t __attribute__((ext_vector_type(2))); typedef __bf16 bf16x2_t __attribute__((ext_vector_type(2)));
__device__ __forceinline__ unsigned cvtpk_s(float lo,float hi){f32x2_t v={lo,hi};bf16x2_t b=__builtin_convertvector(v,bf16x2_t);return __builtin_bit_cast(unsigned,b);}
#define WAIT_BAR(N) asm volatile("s_waitcnt vmcnt(" #N ") lgkmcnt(0)\n\ts_barrier":::"memory")
__device__ __forceinline__ void qkt(f32x16&p0,f32x16&p1,const char*Kslot,const bf16x8*qr,const f32x16&negm,int r32,int hi){
  const char*kb=Kslot+hi*1024+r32*16;
  #pragma unroll
  for(int d0=0;d0<4;++d0){
    const bf16x8 b0=*reinterpret_cast<const bf16x8*>(kb+d0*2048);
    const bf16x8 b1=*reinterpret_cast<const bf16x8*>(kb+d0*2048+512);
    if(d0==0){p0=__builtin_amdgcn_mfma_f32_32x32x16_bf16(b0,qr[0],negm,0,0,0);p1=__builtin_amdgcn_mfma_f32_32x32x16_bf16(b1,qr[0],negm,0,0,0);}
    else{p0=__builtin_amdgcn_mfma_f32_32x32x16_bf16(b0,qr[d0],p0,0,0,0);p1=__builtin_amdgcn_mfma_f32_32x32x16_bf16(b1,qr[d0],p1,0,0,0);}}
}
typedef __attribute__((address_space(3))) const char* lds_cptr;
typedef short v4i16_t __attribute__((ext_vector_type(4)));
__device__ __forceinline__ void kload8(bf16x8*kf,lds_cptr kp){
  kf[0]=*(const __attribute__((address_space(3))) bf16x8*)(kp);      kf[1]=*(const __attribute__((address_space(3))) bf16x8*)(kp+512);
  kf[2]=*(const __attribute__((address_space(3))) bf16x8*)(kp+2048); kf[3]=*(const __attribute__((address_space(3))) bf16x8*)(kp+2560);
  kf[4]=*(const __attribute__((address_space(3))) bf16x8*)(kp+4096); kf[5]=*(const __attribute__((address_space(3))) bf16x8*)(kp+4608);
  kf[6]=*(const __attribute__((address_space(3))) bf16x8*)(kp+6144); kf[7]=*(const __attribute__((address_space(3))) bf16x8*)(kp+6656);
}
__device__ __forceinline__ void kload2(bf16x8*kf,lds_cptr kp,int j){ kf[2*j]=*(const __attribute__((address_space(3))) bf16x8*)(kp+j*2048); kf[2*j+1]=*(const __attribute__((address_space(3))) bf16x8*)(kp+j*2048+512); }
__device__ __forceinline__ s16x4 vtr(lds_cptr p){ return __builtin_bit_cast(s16x4,__builtin_amdgcn_ds_read_tr16_b64_v4i16((__attribute__((address_space(3))) v4i16_t*)p)); }
__device__ __forceinline__ float rowmax(const f32x16&p0,const f32x16&p1){
  float a=max3f(p0[0],p0[1],p1[0]),b=max3f(p0[2],p0[3],p1[1]);a=max3f(a,p1[2],p1[3]);
  #pragma unroll
  for(int r=4;r<16;r+=4){a=max3f(a,p0[r],p0[r+1]);b=max3f(b,p0[r+2],p0[r+3]);a=max3f(a,p1[r],p1[r+1]);b=max3f(b,p1[r+2],p1[r+3]);}
  const float m=max2f(a,b);
  auto rr=__builtin_amdgcn_permlane32_swap(__float_as_uint(m),__float_as_uint(m),false,false);
  return max2f(__uint_as_float(rr[0]),__uint_as_float(rr[1]));
}
__device__ __forceinline__ void pv(f32x16*o,int vb,bf16x8 pa0,bf16x8 pa1,bf16x8 pa2,bf16x8 pa3){
  #pragma unroll
  for(int d0=0;d0<2;++d0){s16x4 lo[4],hi[4];
    #pragma unroll
    for(int ks=0;ks<4;++ks){
      asm volatile("ds_read_b64_tr_b16 %0,%1 offset:%c2":"=&v"(lo[ks]):"v"(vb),"i"(d0*4096+ks*1024):"memory");
      asm volatile("ds_read_b64_tr_b16 %0,%1 offset:%c2":"=&v"(hi[ks]):"v"(vb),"i"(d0*4096+ks*1024+512):"memory");}
    asm volatile("s_waitcnt lgkmcnt(0)":::"memory");SBAR();
    #define PK(k) (bf16x8){lo[k][0],lo[k][1],lo[k][2],lo[k][3],hi[k][0],hi[k][1],hi[k][2],hi[k][3]}
    o[d0]=__builtin_amdgcn_mfma_f32_32x32x16_bf16(pa0,PK(0),o[d0],0,0,0);
    o[d0]=__builtin_amdgcn_mfma_f32_32x32x16_bf16(pa1,PK(1),o[d0],0,0,0);
    o[d0]=__builtin_amdgcn_mfma_f32_32x32x16_bf16(pa2,PK(2),o[d0],0,0,0);
    o[d0]=__builtin_amdgcn_mfma_f32_32x32x16_bf16(pa3,PK(3),o[d0],0,0,0);
    #undef PK
  }
}
typedef __attribute__((address_space(3))) const float* lds_fptr;
__device__ __forceinline__ bf16 f2bf_(float f){ unsigned u=__builtin_bit_cast(unsigned,f); return (bf16)((u+0x7fffu+((u>>16)&1u))>>16); }
struct MaskCtx { int kt0, v0, v1, v2, v3, v4; lds_fptr rp; };
template<int KIND> __device__ __forceinline__ void mask_setup(MaskCtx&mc,const Job&J,char*shm,int tid,int wid,int r32,int hi){
  mc.kt0=J.kt0; mc.v0=mc.v1=mc.v2=mc.v3=0; mc.v4=wid&1; mc.rp=(lds_fptr)(shm+LDS_RPB);
  if constexpr(KIND==0){
    if(J.lat&&tid<466) ((__attribute__((address_space(3))) float*)(shm+LDS_RPB))[tid]=tid<465?J.aux[tid]*1.4426950408889634f:-INFINITY;
    const int rq=(J.qpos0>>6)+(wid>>1), qc=(wid&1)*32+r32; int r0=rq-4; r0=r0<0?0:(r0>24?24:r0); int cs=qc-8; cs=cs<0?0:(cs>48?48:cs);
    mc.v0=rq; mc.v1=qc; mc.v2=r0; mc.v3=cs;
  } else if constexpr(KIND==2){ mc.v0=J.qpos0+wid*32+r32; mc.v1=J.qpos0+wid*32; }
}
template<int KIND> __device__ __forceinline__ void mask_tile(f32x16&p0,f32x16&p1,int t,const MaskCtx&mc,int hi){
  const float NEG=-INFINITY;
  if constexpr(KIND==0){
    if(t<4)return;
    const int kr=mc.kt0+(t-4);
    if(kr<mc.v2||kr>=mc.v2+8){
      _Pragma("unroll") for(int r=0;r<16;++r){p0[r]=NEG;p1[r]=NEG;} return; }
    const lds_fptr T=mc.rp+(kr-mc.v0+7)*31; const int ib=15-mc.v1+4*hi, wb=4*hi-mc.v3;
    const lds_fptr zp=mc.rp+465;
#define NA_ONE(P,r,co) { const int c=((r)&3)+8*((r)>>2)+(co); const bool ok=(unsigned)(wb+c)<16u; P[r]+=*(ok?T+ib+c:zp); }
    if(mc.v4==0){
      _Pragma("unroll") for(int r=4;r<16;++r) p1[r]=NEG;
      _Pragma("unroll") for(int r=0;r<4;++r) NA_ONE(p1,r,32)
      _Pragma("unroll") for(int g=0;g<4;++g){ __builtin_amdgcn_sched_barrier(0);
        _Pragma("unroll") for(int r=4*g;r<4*g+4;++r) NA_ONE(p0,r,0) }
    } else {
      _Pragma("unroll") for(int r=0;r<12;++r) p0[r]=NEG;
      _Pragma("unroll") for(int r=12;r<16;++r) NA_ONE(p0,r,0)
      _Pragma("unroll") for(int g=0;g<4;++g){ __builtin_amdgcn_sched_barrier(0);
        _Pragma("unroll") for(int r=4*g;r<4*g+4;++r) NA_ONE(p1,r,32) }
    }
#undef NA_ONE
  } else if constexpr(KIND==2){
    if(t<4)return;
    const int k0=64*(mc.kt0+t-4), dk=k0-mc.v1;
    if(dk>=-96&&dk<=64)return;
    if(dk<=-192||dk>=160){ _Pragma("unroll") for(int r=0;r<16;++r){p0[r]=NEG;p1[r]=NEG;} return; }
    const int dq=k0+4*hi-mc.v0+128;
    _Pragma("unroll") for(int r=0;r<16;++r){ const int c=(r&3)+8*(r>>2); if((unsigned)(dq+c)>256u)p0[r]=NEG; if((unsigned)(dq+c+32)>256u)p1[r]=NEG; }
  }
}
template<int KIND> __device__ __forceinline__ bool tile_dead(int t,const MaskCtx&mc){
  if constexpr(KIND==0){ if(t<4)return false; const int kr=mc.kt0+(t-4); return kr<mc.v2||kr>=mc.v2+8; }
  else if constexpr(KIND==2){ if(t<4)return false; const int dk=64*(mc.kt0+t-4)-mc.v1; return dk<=-192||dk>=160; }
  else return false;
}
#ifndef ATTN_STORE16
#define ATTN_STORE16(p,v) (*(u32x4*)(p)=(v))
#endif
template<int KIND,int THRL> __device__ __forceinline__ void attn_unit(const Job&J,char*shm){
  constexpr int LDK=KIND==0?1024:KIND==1?256:128;
  const int tid=fresh_tid(J.wave0),lane=tid&63,r32=lane&31,hi=lane>>5; const int wid=__builtin_amdgcn_readfirstlane(tid>>6);
  const bf16*Qw=J.Q+(long)(wid*QBLK)*QP;
  const unsigned lds0=(unsigned)(uintptr_t)shm;
  float*wsf=(float*)(shm+LDS_WS)+wid*64;
  const unsigned kvo=(unsigned)(wid*512+lane*8)*2u, vvo=(unsigned)((16*(wid&3)+(lane>>2))*LDK+(wid>>2)*32+(lane&3)*8)*2u;
  const unsigned kdst=lds0+LDS_K+wid*1024, vdst=lds0+LDS_V+wid*1024;
  #define DMA_K(t,slot) glds16s(((t)<4?J.Kc+(long)(t)*4096:J.Kl+(long)((t)-4)*4096),kvo,(unsigned)__builtin_amdgcn_readfirstlane(kdst+(slot)))
  #define DMA_V(t,slot) glds16s(((t)<4?J.Vc+(long)(t)*KVBLK*LDK:J.Vl+(long)((t)-4)*KVBLK*LDK),vvo,(unsigned)__builtin_amdgcn_readfirstlane(vdst+(slot)))
  const int vb0=(int)(lds0+LDS_V)+((lane>>4)&1)*32+(lane&3)*8+(4*hi+((lane&15)>>2))*64;
  const char*Kbase=shm+LDS_K; bf16x8 kf[8];
  const lds_cptr shm3=(lds_cptr)shm; const lds_cptr kp0=shm3+LDS_K+hi*1024+r32*16; const lds_cptr vp0=shm3+LDS_V+((lane>>4)&1)*32+(lane&3)*8+(4*hi+((lane&15)>>2))*64;
  const int NT=J.NT;
  MaskCtx mc; mask_setup<KIND>(mc,J,shm,tid,wid,r32,hi);
  DMA_K(0,0);DMA_V(0,0);DMA_K(1,SLOTB);
  bf16x8 qr[4];
  #pragma unroll
  for(int d0=0;d0<4;++d0)qr[d0]=*reinterpret_cast<const bf16x8*>(&Qw[(long)r32*QP+d0*16+hi*8]);
  float mhat=0.f,l_reg=0.f;f32x16 o[2];o[0]=f32x16{};o[1]=f32x16{};f32x16 negm=f32x16{};asm volatile("":"+v"(negm));
  #define CMASK(P0,P1,t) mask_tile<KIND>(P0,P1,(t),mc,hi)
  bool resc=false;
  #define START(P0,P1) do{ const float rm=rowmax(P0,P1); resc=false; \
    { const float dl=rm; mhat=fadd_s(mhat,dl); \
      _Pragma("unroll") for(int r=0;r<16;++r){P0[r]=fsub_s(P0[r],dl);P1[r]=fsub_s(P1[r],dl);} \
      _Pragma("unroll") for(int r=0;r<16;++r)negm[r]=-mhat; asm volatile("":"+v"(negm)); } \
    _Pragma("unroll") for(int r=0;r<16;++r)P0[r]=__builtin_amdgcn_exp2f(P0[r]); }while(0)
  #define RESC() do{ if(resc){ asm volatile("s_waitcnt lgkmcnt(0)":::"memory"); \
      _Pragma("unroll") for(int d_=0;d_<2;++d_) _Pragma("unroll") for(int r=0;r<16;++r)o[d_][r]*=wsf[crow(r,hi)]; } }while(0)
  f32x16 pA0,pA1,pB0,pB1;
  int sl_prev=0,sl_cur=0,sl_next=SLOTB;
  #define ROT() do{sl_prev=sl_cur;sl_cur=sl_next;sl_next=(sl_next==(NSLOT-1)*SLOTB)?0:sl_next+SLOTB;}while(0)
  DMA_K(2,2*SLOTB);
  WAIT_BAR(3);
  qkt(pA0,pA1,Kbase,qr,negm,r32,hi);asm volatile("s_nop 15\n\ts_nop 7":"+v"(pA0),"+v"(pA1));
  START(pA0,pA1);
  _Pragma("unroll") for(int r=0;r<16;++r)pA1[r]=__builtin_amdgcn_exp2f(pA1[r]);
  WAIT_BAR(0);
  DMA_K(3,0);DMA_V(1,SLOTB);
  ROT();
  kload8(kf,kp0+sl_cur);
  WAIT_BAR(2);
  s16x4 vlo[8],vhi[8]; u32x4 pw0,pw1,pw2,pw3;
  #define PKW(P,B) cvtpk_s(P[B],P[B+1])
  #define PAF(k) __builtin_bit_cast(bf16x8,pw##k)
  #define VFR(i) (bf16x8){vlo[i][0],vlo[i][1],vlo[i][2],vlo[i][3],vhi[i][0],vhi[i][1],vhi[i][2],vhi[i][3]}
  #define PIN(x) asm volatile("":"+v"(x))
  #define MX3(a,b,c) __builtin_fmaxf(__builtin_fmaxf((a),(b)),(c))
  #define GAPA(MF,A0,A1,A2,A3,W0,W1,PW) do{ MF; sacc+=A0; sacc+=A1; sacc+=A2; sacc+=A3; PIN(sacc); W0; W1; PIN(PW); SBAR(); }while(0)
  #define EX(v) __builtin_amdgcn_exp2f(v)
  #define GAPB(MF,X,B) do{ MF; X[B]=EX(X[B]); X[B+1]=EX(X[B+1]); X[B+2]=EX(X[B+2]); X[B+3]=EX(X[B+3]); PIN(X); SBAR(); }while(0)
  #define VRD(i) do{ vlo[i]=vtr(vp_+(((i)>>2)*4096+((i)&3)*1024)); vhi[i]=vtr(vp_+(((i)>>2)*4096+((i)&3)*1024+512)); }while(0)
  #define KRD(G,j) do{ if(G){ kload2(kf,kp0+sl_next,j); SBAR(); } }while(0)
  #define STEP(C0,C1,P0,P1,t,GK,GV,GL) do{ SBAR(); \
    if(KIND!=1&&tile_dead<KIND>((t),mc)&&tile_dead<KIND>((t)-1,mc)){   \
      if(GK){DMA_K((t)+3,sl_cur);} if(GV){DMA_V((t)+1,sl_next);} KRD(GL,0); KRD(GL,1); KRD(GL,2); KRD(GL,3); \
      _Pragma("unroll") for(int r_=0;r_<16;++r_){C0[r_]=0.f;C1[r_]=0.f;} resc=false; SBAR(); } else { \
    const lds_cptr vp_=vp0+sl_prev; \
    VRD(0); SBAR(); float sacc=(P0[0]+P0[1]); \
    GAPA(C0=__builtin_amdgcn_mfma_f32_32x32x16_bf16(kf[0],qr[0],negm,0,0,0), P0[2],P0[3],P0[4],P0[5],     pw0[0]=PKW(P0,0), pw0[1]=PKW(P0,2), pw0); \
    VRD(4); SBAR(); GAPA(C1=__builtin_amdgcn_mfma_f32_32x32x16_bf16(kf[1],qr[0],negm,0,0,0), P0[6],P0[7],P0[8],P0[9],     pw0[2]=PKW(P0,4), pw0[3]=PKW(P0,6), pw0); \
    VRD(1); SBAR(); GAPA(C0=__builtin_amdgcn_mfma_f32_32x32x16_bf16(kf[2],qr[1],C0,0,0,0),   P0[10],P0[11],P0[12],P0[13], pw1[0]=PKW(P0,8), pw1[1]=PKW(P0,10), pw1); \
    VRD(5); SBAR(); GAPA(C1=__builtin_amdgcn_mfma_f32_32x32x16_bf16(kf[3],qr[1],C1,0,0,0),   P0[14],P0[15],P1[0],P1[1],   pw1[2]=PKW(P0,12),pw1[3]=PKW(P0,14), pw1); \
    VRD(2); SBAR(); GAPA(C0=__builtin_amdgcn_mfma_f32_32x32x16_bf16(kf[4],qr[2],C0,0,0,0),   P1[2],P1[3],P1[4],P1[5],     pw2[0]=PKW(P1,0), pw2[1]=PKW(P1,2), pw2); \
    VRD(6); SBAR(); GAPA(C1=__builtin_amdgcn_mfma_f32_32x32x16_bf16(kf[5],qr[2],C1,0,0,0),   P1[6],P1[7],P1[8],P1[9],     pw2[2]=PKW(P1,4), pw2[3]=PKW(P1,6), pw2); \
    VRD(3); SBAR(); GAPA(C0=__builtin_amdgcn_mfma_f32_32x32x16_bf16(kf[6],qr[3],C0,0,0,0),   P1[10],P1[11],P1[12],P1[13], pw3[0]=PKW(P1,8), pw3[1]=PKW(P1,10), pw3); \
    VRD(7); SBAR(); GAPA(C1=__builtin_amdgcn_mfma_f32_32x32x16_bf16(kf[7],qr[3],C1,0,0,0),   P1[14],P1[15],0.f,0.f,       pw3[2]=PKW(P1,12),pw3[3]=PKW(P1,14), pw3); \
    l_reg+=sacc; \
    if(GK){DMA_K((t)+3,sl_cur);} if(GV){DMA_V((t)+1,sl_next);} \
    CMASK(C0,C1,t); \
    { float a=MX3(C0[0],C0[1],C1[0]),b=MX3(C0[2],C0[3],C1[1]); a=MX3(a,C1[2],C1[3]); \
      _Pragma("unroll") for(int r=4;r<16;r+=4){a=MX3(a,C0[r],C0[r+1]);b=MX3(b,C0[r+2],C0[r+3]);a=MX3(a,C1[r],C1[r+1]);b=MX3(b,C1[r+2],C1[r+3]);} \
      float rm=__builtin_fmaxf(a,b); { auto rr=__builtin_amdgcn_permlane32_swap(__float_as_uint(rm),__float_as_uint(rm),false,false); rm=__builtin_fmaxf(__uint_as_float(rr[0]),__uint_as_float(rr[1])); } \
      resc=false; \
      if(__builtin_expect(__any(rm>(float)THRL),0)){ const float dl=__builtin_fmaxf(rm,0.f); mhat+=dl; \
        _Pragma("unroll") for(int r=0;r<16;++r){C0[r]-=dl;C1[r]-=dl;} \
        _Pragma("unroll") for(int r=0;r<16;++r)negm[r]=-mhat; asm volatile("":"+v"(negm)); \
        const float f=__builtin_amdgcn_exp2f(-dl); l_reg*=f; if(hi==0)wsf[r32]=f; resc=true; } } \
    SBAR(); \
    GAPB(o[0]=__builtin_amdgcn_mfma_f32_32x32x16_bf16(PAF(0),VFR(0),o[0],0,0,0), C0,0); \
    GAPB(o[1]=__builtin_amdgcn_mfma_f32_32x32x16_bf16(PAF(0),VFR(4),o[1],0,0,0), C0,4); \
    KRD(GL,0); GAPB(o[0]=__builtin_amdgcn_mfma_f32_32x32x16_bf16(PAF(1),VFR(1),o[0],0,0,0), C0,8); \
    KRD(GL,1); GAPB(o[1]=__builtin_amdgcn_mfma_f32_32x32x16_bf16(PAF(1),VFR(5),o[1],0,0,0), C0,12); \
    KRD(GL,2); GAPB(o[0]=__builtin_amdgcn_mfma_f32_32x32x16_bf16(PAF(2),VFR(2),o[0],0,0,0), C1,0); \
    KRD(GL,3); GAPB(o[1]=__builtin_amdgcn_mfma_f32_32x32x16_bf16(PAF(2),VFR(6),o[1],0,0,0), C1,4); \
    GAPB(o[0]=__builtin_amdgcn_mfma_f32_32x32x16_bf16(PAF(3),VFR(3),o[0],0,0,0), C1,8); \
    GAPB(o[1]=__builtin_amdgcn_mfma_f32_32x32x16_bf16(PAF(3),VFR(7),o[1],0,0,0), C1,12); \
    } }while(0)
  int t=1;
  #undef CMASK
  #define CMASK(P0,P1,t) do{}while(0)
  if constexpr(KIND==1) for(;t+5<NT;t+=2){
    STEP(pB0,pB1,pA0,pA1,t,true,true,true);     WAIT_BAR(2); RESC(); ROT();
    STEP(pA0,pA1,pB0,pB1,t+1,true,true,true);   WAIT_BAR(2); RESC(); ROT();
  }
  #undef CMASK
  #define CMASK(P0,P1,t) mask_tile<KIND>(P0,P1,(t),mc,hi)
  #define ENDW(tt) do{ if((tt)+3<NT){WAIT_BAR(2);} else if((tt)+2<NT){WAIT_BAR(1);} else {WAIT_BAR(0);} }while(0)
  for(;t+1<NT;t+=2){
    STEP(pB0,pB1,pA0,pA1,t,(t+3<NT),(t+1<NT),(t+1<NT));       ENDW(t);   RESC(); ROT();
    STEP(pA0,pA1,pB0,pB1,t+1,(t+4<NT),(t+2<NT),(t+2<NT));     ENDW(t+1); RESC(); ROT();
  }
  STEP(pB0,pB1,pA0,pA1,NT-1,false,false,false); RESC();
  { float sacc=pB0[0]+pB0[1]; _Pragma("unroll") for(int r=2;r<16;++r)sacc+=pB0[r]; _Pragma("unroll") for(int r=0;r<16;++r)sacc+=pB1[r]; l_reg+=sacc;
    pw0=(u32x4){PKW(pB0,0),PKW(pB0,2),PKW(pB0,4),PKW(pB0,6)};pw1=(u32x4){PKW(pB0,8),PKW(pB0,10),PKW(pB0,12),PKW(pB0,14)};pw2=(u32x4){PKW(pB1,0),PKW(pB1,2),PKW(pB1,4),PKW(pB1,6)};pw3=(u32x4){PKW(pB1,8),PKW(pB1,10),PKW(pB1,12),PKW(pB1,14)};
    SBAR(); pv(o,vb0+sl_cur,PAF(0),PAF(1),PAF(2),PAF(3)); }
  #undef PKW
  #undef PAF
  #undef VFR
  #undef PIN
  #undef MX3
  #undef GAPA
  #undef GAPB
  #undef EX
  #undef VRD
  #undef KRD
  #undef STEP
  #undef ENDW
  {auto rr=__builtin_amdgcn_permlane32_swap(__float_as_uint(l_reg),__float_as_uint(l_reg),false,false);l_reg=__uint_as_float(rr[0])+__uint_as_float(rr[1]);}
  if constexpr(KIND==2) l_reg+=__builtin_amdgcn_exp2f(J.aux[0]*1.4426950408889634f-mhat);
  if(hi==0)wsf[32+r32]=l_reg;asm volatile("s_waitcnt lgkmcnt(0)":::"memory");
  float rli[16];
  #pragma unroll
  for(int r=0;r<16;++r)rli[r]=__builtin_amdgcn_rcpf(wsf[32+crow(r,hi)]);
  bf16*Ow=J.O+(long)(wid*QBLK)*QP;
  { bf16*stg=(bf16*)(shm+LDS_OST)+wid*2048;
    #pragma unroll
    for(int r=0;r<16;++r){const int orow=crow(r,hi);
      #pragma unroll
      for(int d0=0;d0<2;++d0)stg[orow*64+d0*32+r32]=(bf16)cvtpk_s(o[d0][r]*rli[r],0.f);}
    asm volatile("s_waitcnt lgkmcnt(0)":::"memory");
    #pragma unroll
    for(int i=0;i<4;++i){const int row=i*8+(lane>>3),ch=lane&7; const u32x4 v=*(const u32x4*)(stg+row*64+ch*8); ATTN_STORE16(Ow+(long)row*QP+ch*8,v);} }
  asm volatile("s_waitcnt lgkmcnt(0)\n\ts_barrier":::"memory");
  #undef DMA_K
  #undef DMA_V
  #undef CMASK
  #undef START
  #undef RESC
  #undef ROT
}
#undef SBAR
#undef WAIT_BAR
}
__device__ __forceinline__ void sb_arrive(Frame& F, int j);
template <int KIND> __device__ __forceinline__ void attn_phase(Frame& F, const Args& A_) {
    constexpr int ldk = KIND == 0 ? 1024 : KIND == 1 ? 256 : 128, gsz = KIND == 0 ? 1 : KIND == 1 ? 4 : 8;
    char* shm = (char*)F.lds;
#pragma unroll 1
    for (int it = 0; ; ++it) {
        int U;
        if (F.xm && it == 4) sb_arrive(F, 18 + 2 * KIND);
        if (F.xm) {
            if (it < 4) U = F.xg * 128 + 4 * F.lidx + it; else if (it == 4 && F.lidx < 16) U = 1024 + F.xg * 16 + F.lidx; else break;
        } else { const int rounds = (1024 + 4 * F.G - 1) / (4 * F.G); const int r = it >> 2;
          if (r < rounds) { U = 4 * F.vcu + (it & 3) + r * 4 * F.G; if (U >= 1024) continue; }
          else { U = 1024 + F.vcu + (it - 4 * rounds) * F.G; if (U >= 1152) break; } }
        const bool lat = U < 1024; const int bh = lat ? (U >> 3) : (U - 1024), qb = lat ? (U & 7) : 0, b = bh >> 4, h = bh & 15, kvh = h / gsz;
        int kt0 = 0, nlt = 0;
        if (lat) {
            if constexpr (KIND == 1) { kt0 = 0; nlt = 32; }
            else if constexpr (KIND == 2) { const int q0 = qb * 256; const int lo = q0 - 128 < 0 ? 0 : q0 - 128, hi_ = q0 + 383 > SEQ - 1 ? SEQ - 1 : q0 + 383; kt0 = lo >> 6; nlt = (hi_ >> 6) - kt0 + 1; }
            else { const int rf = qb * 4; int r0f = rf - 4; r0f = r0f < 0 ? 0 : (r0f > 24 ? 24 : r0f); int r0l = rf + 3 - 4; r0l = r0l < 0 ? 0 : (r0l > 24 ? 24 : r0l);
                kt0 = r0f; nlt = r0l + 8 - r0f; if (nlt & 1) { if (kt0 + nlt < 32) ++nlt; else { --kt0; ++nlt; } } }
        }
        const size_t qrow = lat ? (size_t)b * SEQ + qb * 256 : (size_t)ML + b * CTXL;
        att::Job J;
        unsigned char* Rb = F.R + (size_t)b * SLAB; const size_t lrow = lat ? (size_t)qb * 256 : (size_t)SEQ;
        J.Q = (bf16*)(Rb + SL_Q) + lrow * 1024 + h * 64; J.O = (bf16*)F.HF + qrow * 1024 + h * 64;
        J.Kc = (bf16*)(Rb + SL_K) + (size_t)(kvh * 36 + 32) * 4096; J.Vc = (bf16*)(Rb + SL_V) + (size_t)SEQ * ldk + kvh * 64;
        J.Kl = (bf16*)(Rb + SL_K) + (size_t)(kvh * 36 + kt0) * 4096; J.Vl = (bf16*)(Rb + SL_V) + (size_t)(kt0 * 64) * ldk + kvh * 64;
        J.NT = 4 + nlt; J.lat = lat ? 1 : 0; J.qpos0 = qb * 256; J.kt0 = kt0; J.h = h; J.wave0 = F.wave0;
        J.aux = KIND == 0 ? A_.in[12] + (size_t)h * 465 : (KIND == 2 ? A_.in[19] + h : nullptr);
        att::attn_unit<KIND, 8>(J, shm);
    }
    if (F.xm) sb_arrive(F, 19 + 2 * KIND);
}
constexpr size_t WS_WG = 2 * MiB + 65536;
constexpr size_t LRU_AGG_OFF = 0, LRU_HIN_OFF = 16 * MiB;
__device__ __forceinline__ void lru_wprep(Frame& F, const Args& A_) {
    PHASE_IDS();
    bf16* WG = (bf16*)(F.ws + WS_WG);
    for (int i = (F.vcu * NWAVES + wave) * 64 + lane; i < 16 * 4 * 64 * 64; i += F.G * NWAVES * 64) {
        const int d = i & 63, e = (i >> 6) & 63, s = (i >> 12) & 3, n = i >> 14; const int dir = s >> 1;
        const float* src = (s & 1) ? A_.in[26] : A_.in[24];
        WG[i] = (bf16)f2bf(src[((size_t)(dir * 16 + n) * 64 + d) * 64 + e]); }
}
struct LruSpan { int dir, isctx, T, tok0; size_t rowb; };
__device__ __forceinline__ LruSpan lru_span(int step) { LruSpan s; s.dir = step >= 9 ? 1 : 0; const int s9 = step - 9 * s.dir; s.isctx = s9 == 0 ? 1 : 0; const int sp = s.dir ? 8 - s9 : s9 - 1;
    s.T = s.isctx ? CTXL : SEQ; s.tok0 = s.isctx ? 0 : sp * 256; s.rowb = s.isctx ? (size_t)SEQ : (size_t)0; return s; }
__device__ __forceinline__ void lru_sweeps(Frame& F, const Args& A_) {
    PHASE_IDS();
    typedef short bf16x8 __attribute__((ext_vector_type(8))); typedef float f32x16 __attribute__((ext_vector_type(16)));
    const int r32 = lane & 31, hi = lane >> 5;
    LAS float* xcf = (LAS float*)F.lds;
    LAS unsigned short* xcb = (LAS unsigned short*)(F.lds + 36864);
    LAS unsigned short* glt = (LAS unsigned short*)(F.lds + 73728);
    LAS unsigned short* hft = (LAS unsigned short*)(F.lds + 94208);
    LAS unsigned short* wgt = (LAS unsigned short*)(F.lds + 114688);
    LAS float* agg = (LAS float*)(F.lds + 123904);
    const bf16* WG = (const bf16*)(F.ws + WS_WG);
    bf16* HFW = (bf16*)F.HF;
    const int cq = tid & 15, tg = tid >> 4;
    const int trow = tid >> 2, tq = tid & 3;
#pragma unroll 1
    for (int v = F.xm ? F.xg * 32 + F.lidx : F.vcu; v < 256; v += F.xm ? 256 : F.G) {
        const int b = v >> 5, n = (v >> 1) & 15, hf = v & 1;
        const int ch = 64 * n + 32 * hf + r32;
        const char* XRb = (const char*)(F.R + (size_t)b * SLAB + SL_XR) + (size_t)(64 * n) * 2; bf16* GL = (bf16*)(F.R + (size_t)b * SLAB + SL_GL) + 64 * n + 32 * hf;
        bf16* HFb = HFW + (size_t)b * SEQ * 1024 + 64 * n + 32 * hf;
        bf16* dummy = (bf16*)(F.ws + WS_HC + 4 * MiB) + ((size_t)v * 512 + tid) * 16;
        f32x4 cwv[4];
#pragma unroll
        for (int k = 0; k < 4; ++k) cwv[k] = *(const f32x4*)(A_.in[22] + k * 1024 + 64 * n + 4 * cq);
        const f32x4 cbv = *(const f32x4*)(A_.in[23] + 64 * n + 4 * cq);
        typedef unsigned u32x2 __attribute__((ext_vector_type(2))); u32x2 xin[11]; v4u gin[2], hin[2];
#define LRU_FETCH(sp_) do { \
        _Pragma("unroll") for (int i = 0; i < 11; ++i) { int tt = (sp_).tok0 + 8 * tg - 2 + i; if (i < 2) tt = tt < 0 ? 0 : tt; if (i == 10) tt = tt > (sp_).T - 1 ? (sp_).T - 1 : tt; \
            xin[i] = *(const u32x2*)(XRb + (unsigned)((((int)(sp_).rowb + tt) * 1024 + 4 * cq) * 2)); } \
        { const unsigned e_ = ((sp_).dir && !(sp_).isctx) ? (unsigned)(((sp_).tok0 + trow) * 1024 + 8 * tq) : 0u;     \
          const bf16* gp = GL + e_; gin[0] = *(const GAS v4u*)gp; gin[1] = *(const GAS v4u*)(gp + 128 * 1024); const bf16* hp = HFb + e_; hin[0] = *(const GAS v4u*)hp; hin[1] = *(const GAS v4u*)(hp + 128 * 1024); } } while (0)
        { const LruSpan s0 = lru_span(0); LRU_FETCH(s0); }
#pragma unroll 1
        for (int d = 0; d < 2; ++d) {
            float S = 0.f;
            if (d == 1) asm volatile("s_waitcnt vmcnt(0)" ::: "memory");
            const float nba = -LOG2E * A_.in[25][d * 1024 + ch], nbx = -LOG2E * A_.in[27][d * 1024 + ch]; const float sp = -8.0f * LOG2E * log1pf(expf(-A_.in[28][d * 1024 + ch]));
            { const int row = tid >> 3, pc = tid & 7, st_ = row >> 5, e = row & 31;
              *(LAS v4u*)(wgt + row * 72 + 8 * pc) = *(const GAS v4u*)(WG + ((size_t)((n * 4 + 2 * d + st_) * 64 + 32 * hf + e) * 64 + 8 * pc)); }
#pragma unroll 1
        for (int s9 = 0; s9 < 9; ++s9) {
            const int step = 9 * d + s9;
            const LruSpan cur = lru_span(step);
            f32x4 xf[11];
            { const u32x2 z = {0u, 0u}; const int t0 = cur.tok0 + 8 * tg; if (t0 - 2 < 0) xin[0] = z; if (t0 - 1 < 0) xin[1] = z; if (t0 + 8 >= cur.T) xin[10] = z; }
#pragma unroll
            for (int i = 0; i < 11; ++i) { xf[i][0] = bf_lo(xin[i].x); xf[i][1] = __builtin_bit_cast(float, xin[i].x & 0xffff0000u); xf[i][2] = bf_lo(xin[i].y); xf[i][3] = __builtin_bit_cast(float, xin[i].y & 0xffff0000u); }
#pragma unroll
            for (int j = 0; j < 8; ++j) { const int tok = 8 * tg + j; const f32x4 a = cbv + cwv[0] * xf[j] + cwv[1] * xf[j + 1] + cwv[2] * xf[j + 2] + cwv[3] * xf[j + 3];
                if ((cq >> 3) == hf) *(LAS f32x4*)(xcf + tok * 36 + 4 * (cq & 7)) = a;
                u32x2 w; w.x = att::cvtpk_s(a[0], a[1]); w.y = att::cvtpk_s(a[2], a[3]); *(LAS u32x2*)(xcb + tok * 72 + 4 * cq) = w; }
            if (cur.dir && !cur.isctx) { *(LAS v4u*)(glt + trow * 40 + 8 * tq) = gin[0]; *(LAS v4u*)(glt + (trow + 128) * 40 + 8 * tq) = gin[1];
                                         *(LAS v4u*)(hft + trow * 40 + 8 * tq) = hin[0]; *(LAS v4u*)(hft + (trow + 128) * 40 + 8 * tq) = hin[1]; }
            __syncthreads();
            { const LruSpan nx = lru_span(step + 1 < 18 ? step + 1 : 17); LRU_FETCH(nx); }
            bf16x8 Af[4];
#pragma unroll
            for (int ks = 0; ks < 4; ++ks) Af[ks] = *(const LAS bf16x8*)(xcb + (32 * wave + r32) * 72 + 16 * ks + 8 * hi);
            f32x16 acc[2];
#pragma unroll
            for (int s = 0; s < 2; ++s) { acc[s] = (f32x16){};
#pragma unroll
                for (int ks = 0; ks < 4; ++ks) acc[s] = __builtin_amdgcn_mfma_f32_32x32x16_bf16(Af[ks], *(const LAS bf16x8*)(wgt + (s * 32 + r32) * 72 + 16 * ks + 8 * hi), acc[s], 0, 0, 0); }
            float af[16], bv[16];
#pragma unroll
            for (int r = 0; r < 16; ++r) { const int tok = 32 * wave + (r & 3) + 8 * (r >> 2) + 4 * hi; const float xv = xcf[tok * 36 + r32];
                const float rg = __builtin_amdgcn_rcpf(1.0f + __builtin_amdgcn_exp2f(__builtin_fmaf(acc[0][r], -LOG2E, nba))), ig = __builtin_amdgcn_rcpf(1.0f + __builtin_amdgcn_exp2f(__builtin_fmaf(acc[1][r], -LOG2E, nbx)));
                const float a = __builtin_amdgcn_exp2f(sp * rg);
                af[r] = a; bv[r] = __builtin_amdgcn_sqrtf(1.0f - a * a) * (ig * xv); }
            float RA[4], RB[4], LA[4], UA[4], LB[4], UB[4], st[4], h[16];
            if (cur.dir == 0) {
#pragma unroll
                for (int j = 0; j < 4; ++j) { float A = 1.f, Bv = 0.f;
#pragma unroll
                    for (int i = 0; i < 4; ++i) { Bv = af[4 * j + i] * Bv + bv[4 * j + i]; A *= af[4 * j + i]; }
                    RA[j] = A; RB[j] = Bv; }
            } else {
#pragma unroll
                for (int j = 0; j < 4; ++j) { float A = 1.f, Bv = 0.f;
#pragma unroll
                    for (int i = 3; i >= 0; --i) { Bv = af[4 * j + i] * Bv + bv[4 * j + i]; A *= af[4 * j + i]; }
                    RA[j] = A; RB[j] = Bv; }
            }
#pragma unroll
            for (int j = 0; j < 4; ++j) { auto ra = __builtin_amdgcn_permlane32_swap(__float_as_uint(RA[j]), __float_as_uint(RA[j]), false, false); LA[j] = __uint_as_float(ra[0]); UA[j] = __uint_as_float(ra[1]);
                auto rb = __builtin_amdgcn_permlane32_swap(__float_as_uint(RB[j]), __float_as_uint(RB[j]), false, false); LB[j] = __uint_as_float(rb[0]); UB[j] = __uint_as_float(rb[1]); }
            { float s = 0.f, At = 1.f;
              if (cur.dir == 0) {
#pragma unroll
                  for (int j = 0; j < 4; ++j) { s = LA[j] * s + LB[j]; s = UA[j] * s + UB[j]; At *= LA[j] * UA[j]; }
              } else {
#pragma unroll
                  for (int j = 3; j >= 0; --j) { s = UA[j] * s + UB[j]; s = LA[j] * s + LB[j]; At *= LA[j] * UA[j]; }
              }
              if (hi == 0) { typedef float f32x2_ __attribute__((ext_vector_type(2))); f32x2_ w2; w2[0] = At; w2[1] = s; *(LAS f32x2_*)(agg + (wave * 32 + r32) * 2) = w2; } }
            __syncthreads();
            float mine = 0.f;
            { float s = S;
#pragma unroll
              for (int k = 0; k < 8; ++k) { const int w = cur.dir ? 7 - k : k; typedef float f32x2_ __attribute__((ext_vector_type(2))); const f32x2_ ab2 = *(const LAS f32x2_*)(agg + (w * 32 + r32) * 2);
                  mine = (w == wave) ? s : mine; s = ab2[0] * s + ab2[1]; }
              S = s; }
            if (cur.dir == 0) {
                { float s = mine;
#pragma unroll
                  for (int j = 0; j < 4; ++j) { const float slo = s; s = LA[j] * s + LB[j]; const float sup = s; s = UA[j] * s + UB[j]; st[j] = hi ? sup : slo; } }
#pragma unroll
                for (int j = 0; j < 4; ++j) { float hh = st[j];
#pragma unroll
                    for (int i = 0; i < 4; ++i) { hh = af[4 * j + i] * hh + bv[4 * j + i]; h[4 * j + i] = hh; } }
            } else {
                { float s = mine;
#pragma unroll
                  for (int j = 3; j >= 0; --j) { const float sup = s; s = UA[j] * s + UB[j]; const float slo = s; s = LA[j] * s + LB[j]; st[j] = hi ? sup : slo; } }
#pragma unroll
                for (int j = 0; j < 4; ++j) { float hh = st[j];
#pragma unroll
                    for (int i = 3; i >= 0; --i) { hh = af[4 * j + i] * hh + bv[4 * j + i]; h[4 * j + i] = hh; } }
            }
            if (!cur.isctx) {
                if (cur.dir == 0) {
#pragma unroll
                    for (int r = 0; r < 16; ++r) { const int tok = 32 * wave + (r & 3) + 8 * (r >> 2) + 4 * hi; hft[tok * 40 + r32] = (unsigned short)att::cvtpk_s(h[r], 0.f); }
                } else {
#pragma unroll
                    for (int r = 0; r < 16; ++r) { const int tok = 32 * wave + (r & 3) + 8 * (r >> 2) + 4 * hi;
                        const float gl = bf_lo((unsigned)glt[tok * 40 + r32]), hfv = bf_lo((unsigned)hft[tok * 40 + r32]); glt[tok * 40 + r32] = (unsigned short)att::cvtpk_s((hfv + h[r]) * gl, 0.f); }
                }
            }
            __syncthreads();
            { const unsigned e_ = (unsigned)((cur.tok0 + trow) * 1024 + 8 * tq); const LAS unsigned short* src = (cur.dir ? glt : hft) + trow * 40 + 8 * tq;
              bf16* op = cur.isctx ? dummy : (cur.dir == 0 ? HFb + e_ : GL + e_); *(GAS v4u*)op = *(const LAS v4u*)src; *(GAS v4u*)(op + (cur.isctx ? 8 : 128 * 1024)) = *(const LAS v4u*)(src + 128 * 40); }
        } }
#undef LRU_FETCH
    }
}

#define XB_TMO      128
#define XB_XCNT(j)  (256  + 64 * (j))
#define XB_XSUB(j)  (1280 + 64 * (j))
#define XB_XGEN(j)  (2304 + 64 * (j))
#define XB_TOP      3328
#define XB_TOPGEN   3392
#define XCD_BAR_WORDS 3456
#define XB_SPIN_CAP (1u << 18)

__device__ __forceinline__ unsigned xb_ld(unsigned* p)              { return __hip_atomic_load(p, __ATOMIC_RELAXED, __HIP_MEMORY_SCOPE_AGENT); }
__device__ __forceinline__ unsigned xb_add(unsigned* p, unsigned v) { return __hip_atomic_fetch_add(p, v, __ATOMIC_RELAXED, __HIP_MEMORY_SCOPE_AGENT); }
__device__ __forceinline__ unsigned xb_xcc_id() { return (unsigned)__builtin_amdgcn_s_getreg((3 << 11) | 20) & 0xFu; }
#define XB_SPIN(cond, bar) do { unsigned _sp = 0; while (cond) { __builtin_amdgcn_s_sleep(1); \
    if ((++_sp & 255u) == 0u) { if (xb_ld(&(bar)[XB_TMO])) break; if (_sp > XB_SPIN_CAP) { atomicAdd(&(bar)[XB_TMO], 1u); break; } } } } while (0)

struct XcdBarrier {
    unsigned* bar; unsigned x;
    volatile LAS unsigned* st;
};

__device__ __forceinline__ XcdBarrier xcd_barrier_post(unsigned* bar, volatile LAS unsigned* st) {
    XcdBarrier b; b.bar = bar; b.x = xb_xcc_id(); b.st = st;
    if (threadIdx.x == 0) (void)xb_add(&bar[XB_XCNT(b.x)], 1u);
    return b;
}
__device__ __forceinline__ void xcd_barrier_complete(unsigned* bar, unsigned x, unsigned& nloc, unsigned& nx) {
    const unsigned G = gridDim.x * gridDim.y * gridDim.z;
    unsigned sum, cnt, mine, sp = 0u;
    for (;;) {
        sum = 0u; cnt = 0u; mine = 0u;
#pragma unroll
        for (unsigned j = 0; j < 16; ++j) { const unsigned c = xb_ld(&bar[XB_XCNT(j)]); sum += c; cnt += (c > 0u) ? 1u : 0u; mine = (j == x) ? c : mine; }
        if (sum == G) break;
        __builtin_amdgcn_s_sleep(1);
        if ((++sp & 255u) == 0u) { if (xb_ld(&bar[XB_TMO])) break; if (sp > XB_SPIN_CAP) { atomicAdd(&bar[XB_TMO], 1u); break; } }
    }
    nloc = mine > 0u ? mine : 1u; nx = cnt > 0u ? cnt : 1u;
}

__device__ __forceinline__ void xcd_barrier(const XcdBarrier& b) {
    asm volatile("s_waitcnt vmcnt(0)" ::: "memory");
    __syncthreads();
    if (threadIdx.x == 0) {
        unsigned* bar = b.bar; unsigned bx = b.x; asm volatile("" : "+s"(bx), "+s"(bar));
        __builtin_amdgcn_s_waitcnt(0);
        unsigned nloc = b.st[0], nx = b.st[1];
        if (nloc == 0u) { xcd_barrier_complete(bar, bx, nloc, nx); b.st[0] = nloc; b.st[1] = nx; }
        const unsigned old = xb_add(&bar[XB_XSUB(bx)], 1u);
        const unsigned gen = old / nloc;
        if (old + 1u == (gen + 1u) * nloc) {
            __builtin_amdgcn_fence(__ATOMIC_RELEASE, "agent");
            asm volatile("s_waitcnt vmcnt(0)" ::: "memory");
            const unsigned og = xb_add(&bar[XB_TOP], 1u);
            const unsigned tg = og / nx;
            if (og + 1u == (tg + 1u) * nx) xb_add(&bar[XB_TOPGEN], 1u);
            else XB_SPIN(xb_ld(&bar[XB_TOPGEN]) == tg, bar);
            __builtin_amdgcn_fence(__ATOMIC_ACQUIRE, "agent");
            xb_add(&bar[XB_XGEN(bx)], 1u);
            asm volatile("s_waitcnt vmcnt(0)" ::: "memory");
        } else {
            XB_SPIN(xb_ld(&bar[XB_XGEN(bx)]) == gen, bar);
            __builtin_amdgcn_fence(__ATOMIC_ACQUIRE, "agent");
            asm volatile("s_waitcnt vmcnt(0)" ::: "memory");
        }
    }
    __syncthreads();
}

constexpr int MISC_OFF = 131072 + 320;
#define GSYNC() xcd_barrier(bar)
__device__ __forceinline__ void xl_barrier(Frame& F) {
    asm volatile("s_waitcnt vmcnt(0)" ::: "memory");
    __syncthreads();
    if (threadIdx.x == 0) { unsigned* cntw = (unsigned*)(F.ws + WS_CTL) + 56320 + 64 * F.xg; unsigned* relw = (unsigned*)(F.ws + WS_CTL) + 57344 + 64 * F.xg;
        __builtin_amdgcn_s_waitcnt(0);
        const unsigned old = __hip_atomic_fetch_add(cntw, 1u, __ATOMIC_RELAXED, __HIP_MEMORY_SCOPE_AGENT); const unsigned gen = old >> 5;
        if ((old & 31u) == 31u) __hip_atomic_fetch_add(relw, 1u, __ATOMIC_RELAXED, __HIP_MEMORY_SCOPE_AGENT);
        else { unsigned sp = 0; while (__hip_atomic_load(relw, __ATOMIC_RELAXED, __HIP_MEMORY_SCOPE_AGENT) <= gen) { __builtin_amdgcn_s_sleep(1); if (++sp > (1u << 22)) break; } }
        __builtin_amdgcn_fence(__ATOMIC_ACQUIRE, "agent"); asm volatile("s_waitcnt vmcnt(0)" ::: "memory"); }
    __syncthreads();
}
#define XSYNC() do { if (F.xm) xl_barrier(F); else xcd_barrier(bar); } while (0)

#define SB_XSUB(j, x) (((j) < 18 ? 32768 + (j) * 1152 : 98304 + ((j) - 18) * 1152) + 64 * (x))
#define SB_TOP(j)     SB_XSUB(j, 16)
__device__ __forceinline__ void sb_arrive(Frame& F, int j) {
    asm volatile("s_waitcnt vmcnt(0)" ::: "memory");
    __syncthreads();
    if (F.xm) { if (threadIdx.x == 0) { unsigned* ctl = (unsigned*)(F.ws + WS_CTL);
            const unsigned old = __hip_atomic_fetch_add(ctl + SB_XSUB(j, F.xg), 1u, __ATOMIC_RELAXED, __HIP_MEMORY_SCOPE_AGENT);
            if (old + 1u == 32u) __hip_atomic_store(ctl + SB_XSUB(j, F.xg + 8), 32u, __ATOMIC_RELAXED, __HIP_MEMORY_SCOPE_AGENT); }
        return; }
    if (threadIdx.x == 0) { unsigned* ctl = (unsigned*)(F.ws + WS_CTL); const unsigned x = xb_xcc_id(); const unsigned nloc = ((volatile LAS unsigned*)(F.lds + MISC_OFF))[0];
        const unsigned old = __hip_atomic_fetch_add(ctl + SB_XSUB(j, x), 1u, __ATOMIC_RELAXED, __HIP_MEMORY_SCOPE_AGENT);
        if (old + 1u == nloc) {
            __builtin_amdgcn_fence(__ATOMIC_RELEASE, "agent"); asm volatile("s_waitcnt vmcnt(0)" ::: "memory");
            __hip_atomic_fetch_add(ctl + SB_TOP(j), nloc, __ATOMIC_RELAXED, __HIP_MEMORY_SCOPE_AGENT); } }
}
__device__ __forceinline__ void sb_wait(Frame& F, int j) {
    if (threadIdx.x == 0) { unsigned* w = (unsigned*)(F.ws + WS_CTL) + (F.xm ? SB_XSUB(j, F.xg + 8) : SB_TOP(j)); unsigned sp = 0; const unsigned need = F.xm ? 32u : (unsigned)F.G;
        while (__hip_atomic_load(w, __ATOMIC_RELAXED, __HIP_MEMORY_SCOPE_AGENT) < need) { __builtin_amdgcn_s_sleep(8); if (++sp > (1u << 21)) break; }
        __builtin_amdgcn_fence(__ATOMIC_ACQUIRE, "agent"); asm volatile("s_waitcnt vmcnt(0)" ::: "memory"); }
    __syncthreads();
}

__device__ __forceinline__ LAS const float* rstd_table(Frame& F, int pm) {
    LAS float* tb = (LAS float*)(F.lds + 131072 + 1024); const int tid_ = fresh_tid(F.wave0);
#pragma unroll
    for (int t = 0; t < 2; ++t) { const int lane_ = tid_ & 63, w_ = tid_ >> 6; const int r = t * 128 + w_ * 16 + (lane_ & 15);
        const float rs = pg8::row_rstd_q(F.SSQ, pm * 256 + r, lane_ >> 4); if ((lane_ >> 4) == 0) tb[r] = rs; }
    __syncthreads(); return (LAS const float*)tb;
}
template <int L> __device__ __forceinline__ void p1_std(Frame& F, const Args& A_) {
    constexpr int N = L == 0 ? 3072 : L == 1 ? 1536 : L == 2 ? 1280 : 2048;
    const bf16* wt = F.WT + (L == 0 ? WO_QKV0 : L == 1 ? WO_QKV1 : L == 2 ? WO_QKV2 : WO_WIN3);
    pg8::Gemm g{F.XS, wt, MT, N, 1024, 0}; pg8::StaticOrder S; if (F.xm) S.init_x(MT, N, F.xg, F.lidx); else S.init(MT, N, F.G, (int)blockIdx.x);
    pg8::EpiProj<L> E{F.SSQ, F.BIAS + (size_t)L * BIAS_SLOT, N, F.R, L == 0 ? 16 : L == 1 ? 4 : 2, A_.in[15], A_.in[16], F.CS};
    pg8::gemm_phase<pg8::EpiProj<L>, pg8::StaticOrder, true, true>(F.lds, g, S, E, F.wave0);
}
template <int L> __device__ __forceinline__ void mixer(Frame& F, const Args& A_, const XcdBarrier& bar) {
    if constexpr (L < 3) attn_phase<L>(F, A_);
    else lru_sweeps(F, A_);
}
template <int L> __device__ __forceinline__ void tail_std(Frame& F, const Args& A_, const XcdBarrier& bar) {
    const float* mod = F.MOD + (size_t)L * 9 * 6144;
    constexpr int Mo = L == 3 ? ML : MT;
    {
        const bf16* A = L == 3 ? (const bf16*)(F.R + SL_GL) : (const bf16*)F.HF;
        const bf16* wt = F.WT + (L == 0 ? WO_WO0 : L == 1 ? WO_WO1 : L == 2 ? WO_WO2 : WO_WOUT3);
        pg8::Gemm g{A, wt, Mo, 1024, 1024, L == 3 ? SLAB : (size_t)0}; pg8::StaticOrder S; if (F.xm) S.init_x(Mo, 1024, F.xg, F.lidx); else S.init(Mo, 1024, F.G, (int)blockIdx.x);
        pg8::EpiResid<L == 0> E{F.HL, F.HC, mod + 2 * 1024, mod + 4 * 1024, A_.in[7] + L * 1024, F.XS, F.SSQ, L == 0 ? A_.in[0] : nullptr, L == 0 ? A_.in[2] : nullptr};
        E.ssl = (LAS float*)(F.lds + 131072 + 11264);
        pg8::gemm_phase<pg8::EpiResid<L == 0>, pg8::StaticOrder, true, true>(F.lds, g, S, E, F.wave0);
    }
    XSYNC();
    {
        pg8::Gemm g{F.XS, F.WT + WO_FIN + (size_t)L * 5632 * 1024, Mo, 5632, 1024, 0}; pg8::StaticOrder S; if (F.xm) S.init_x(Mo, 5632, F.xg, F.lidx); else S.init(Mo, 5632, F.G, (int)blockIdx.x);
        pg8::EpiSwiGLU E{F.SSQ, F.BIAS + (size_t)(4 + L) * BIAS_SLOT, F.R};
        { pg8::Unit u0; if (S.next(0, u0)) { E.rpm = u0.pm; E.rsl = rstd_table(F, u0.pm); } }
        pg8::gemm_phase<pg8::EpiSwiGLU, pg8::StaticOrder, true, true>(F.lds, g, S, E, F.wave0);
    }
    XSYNC();
    {
        pg8::Gemm g{(const bf16*)(F.R + SL_HM), F.WT + WO_FOUT + (size_t)L * 1024 * 2816, Mo, 1024, 2816, SLAB}; pg8::StaticOrder S; if (F.xm) S.init_x(Mo, 1024, F.xg, F.lidx); else S.init(Mo, 1024, F.G, (int)blockIdx.x);
        const float* modn = F.MOD + (size_t)(L + 1) * 9 * 6144;
        if constexpr (L == 3) { if (S.nwg == S.G) {
            pg8::EpiResidFinal EF{F.HL, F.out, mod + 5 * 1024, A_.in[8], (float*)(F.ws + WS_SSQ + 1 * MiB), (unsigned*)(F.ws + WS_CTL) + 61440};
            pg8::gemm_phase<pg8::EpiResidFinal, pg8::StaticOrder, false, true>(F.lds, g, S, EF, F.wave0);
            return; } }
        pg8::EpiResid<false> E{F.HL, F.HC, mod + 5 * 1024, L < 3 ? modn + 1024 : nullptr, A_.in[6] + (L < 3 ? (L + 1) * 1024 : 0), L < 3 ? F.XS : nullptr, F.SSQ};
        E.ssl = (LAS float*)(F.lds + 131072 + 11264);
        pg8::gemm_phase<pg8::EpiResid<false>, pg8::StaticOrder, true, true>(F.lds, g, S, E, F.wave0);
    }
    XSYNC();
    if constexpr (L == 3) p_final(F, A_);
}
template <int L> __device__ __forceinline__ void chain(Frame& F, const Args& A_, const XcdBarrier& bar) {
    const float* mod = F.MOD + (size_t)L * 9 * 6144;
    const int c = F.xm ? (F.lidx ^ 16) : (int)blockIdx.x, G = F.xm ? 32 : (int)F.G, J = 6 * L, H2 = G / 2;
    const int EA = 18 + 2 * L, EC = 19 + 2 * L;
    const int lp0 = F.xm ? 8 * F.xg : 0, lnM = F.xm ? 8 : 64, cp0 = F.xm ? 64 + F.xg : 64, cnM = F.xm ? 1 : 8, nr = F.xm;
    {
        const bf16* wt = F.WT + (L == 0 ? WO_WO0 : L == 1 ? WO_WO1 : WO_WO2);
        pg8::Gemm g{(const bf16*)F.HF, wt, MT, 1024, 1024, 0};
        pg8::EpiResid<L == 0> E{F.HL, F.HC, mod + 2 * 1024, mod + 4 * 1024, A_.in[7] + L * 1024, F.XS, F.SSQ, L == 0 ? A_.in[0] : nullptr, L == 0 ? A_.in[2] : nullptr};
        E.ssl = (LAS float*)(F.lds + 131072 + 11264);
        pg8::ListOrder Sl; Sl.init(lp0, lnM, 1024, G, c, 0, 0, nr);
        if (F.xm) sb_wait(F, EA);
        pg8::gemm_phase<pg8::EpiResid<L == 0>, pg8::ListOrder, true, true>(F.lds, g, Sl, E, F.wave0);
        sb_arrive(F, J + 0);
        pg8::ListOrder Sc; Sc.init(cp0, cnM, 1024, G, c, 0, 1, nr);
        if (F.xm && Sc.any()) sb_wait(F, EC);
        pg8::gemm_phase<pg8::EpiResid<L == 0>, pg8::ListOrder, true, true>(F.lds, g, Sc, E, F.wave0);
        sb_arrive(F, J + 1);
    }
    {
        pg8::Gemm g{F.XS, F.WT + WO_FIN + (size_t)L * 5632 * 1024, MT, 5632, 1024, 0};
        pg8::EpiSwiGLU E{F.SSQ, F.BIAS + (size_t)(4 + L) * BIAS_SLOT, F.R};
        pg8::ListOrder Sl; Sl.init(lp0, lnM, 5632, G, c, H2, 0, nr);
        sb_wait(F, J + 0);
        if (F.xm) sb_wait(F, EC);
        { pg8::Unit u0; if (Sl.next(0, u0)) { E.rpm = u0.pm; E.rsl = rstd_table(F, u0.pm); } }
        pg8::gemm_phase<pg8::EpiSwiGLU, pg8::ListOrder, true, true>(F.lds, g, Sl, E, F.wave0);
        sb_arrive(F, J + 2);
        pg8::ListOrder Sc; Sc.init(cp0, cnM, 5632, G, c, 0, 0, nr, F.xm ? 16 : -1);
        if (Sc.any()) sb_wait(F, J + 1);
        pg8::gemm_phase<pg8::EpiSwiGLU, pg8::ListOrder, true, true>(F.lds, g, Sc, E, F.wave0);
        sb_arrive(F, J + 3);
    }
    {
        pg8::Gemm g{(const bf16*)(F.R + SL_HM), F.WT + WO_FOUT + (size_t)L * 1024 * 2816, MT, 1024, 2816, SLAB};
        const float* modn = F.MOD + (size_t)(L + 1) * 9 * 6144;
        pg8::EpiResid<false> E{F.HL, F.HC, mod + 5 * 1024, modn + 1024, A_.in[6] + (L + 1) * 1024, F.XS, F.SSQ};
        E.ssl = (LAS float*)(F.lds + 131072 + 11264);
        pg8::ListOrder Sl; Sl.init(lp0, lnM, 1024, G, c, 0, 0, nr);
        sb_wait(F, J + 2);
        pg8::gemm_phase<pg8::EpiResid<false>, pg8::ListOrder, true, true>(F.lds, g, Sl, E, F.wave0);
        sb_arrive(F, J + 4);
        pg8::ListOrder Sc; Sc.init(cp0, cnM, 1024, G, c, F.xm ? 24 : (5 * G) / 16, 1, nr);
        if (Sc.any()) sb_wait(F, J + 3);
        pg8::gemm_phase<pg8::EpiResid<false>, pg8::ListOrder, true, true>(F.lds, g, Sc, E, F.wave0);
        sb_arrive(F, J + 5);
    }
    {
        constexpr int N = L == 0 ? 1536 : L == 1 ? 1280 : 2048;
        const bf16* wt = F.WT + (L == 0 ? WO_QKV1 : L == 1 ? WO_QKV2 : WO_WIN3);
        pg8::Gemm g{F.XS, wt, MT, N, 1024, 0};
        pg8::EpiProj<L + 1> E{F.SSQ, F.BIAS + (size_t)(L + 1) * BIAS_SLOT, N, F.R, L == 0 ? 4 : 2, A_.in[15], A_.in[16], F.CS};
        if constexpr (L < 2) {
            LAS float* tb = (LAS float*)(F.lds + 131072 + 2048); const int tid_ = fresh_tid(F.wave0);
            for (int i = tid_; i < 2048; i += 512) tb[i] = F.CS[i];
            if (tid_ < 64) { tb[2048 + tid_] = A_.in[15][tid_]; tb[2112 + tid_] = A_.in[16][tid_]; }
            __syncthreads(); E.tb = (LAS const float*)tb; }
        pg8::ListOrder Sl; if (L == 0 && F.xm) { const bool ex = c >= 8 && c < 16; Sl.init(lp0, lnM, ex ? 0 : N, 24, ex ? 0 : (c >= 16 ? c - 16 : c + 16), 0, 0, nr); }
        else Sl.init(lp0, lnM, N, G, c, F.xm ? (L == 1 ? 16 : 8) : 0, 0, nr);
        sb_wait(F, J + 4);
        { pg8::Unit u0; if (Sl.next(0, u0)) { E.rpm = u0.pm; E.rsl = rstd_table(F, u0.pm); } }
        pg8::gemm_phase<pg8::EpiProj<L + 1>, pg8::ListOrder, true, true>(F.lds, g, Sl, E, F.wave0);
        pg8::ListOrder Sc; Sc.init(cp0, cnM, N, G, c, F.xm ? (L >= 1 ? 8 : 24) : H2, (L >= 1 && F.xm) ? 1 : 0, nr);
        if (Sc.any()) sb_wait(F, J + 5);
        pg8::gemm_phase<pg8::EpiProj<L + 1>, pg8::ListOrder, true, true>(F.lds, g, Sc, E, F.wave0);
    }
    XSYNC();
}

__global__ void __launch_bounds__(NWAVES * 64, 2) fwd_kernel(Args args) {
    extern __shared__ __attribute__((aligned(16))) unsigned char lds[];
    Frame F;
    F.lds = (LAS unsigned char*)lds;
        F.wave0 = __builtin_amdgcn_readfirstlane(threadIdx.x >> 6);
    F.G = gridDim.x; { const int bx = blockIdx.x; F.vcu = (F.G % 8 == 0) ? (bx % 8) * (F.G / 8) + bx / 8 : bx; }
    F.out = args.out; F.ws = args.ws;
    F.MOD = (float*)(F.ws + WS_MOD); F.CS = (float*)(F.ws + WS_CS); F.BIAS = (float*)(F.ws + WS_BIAS); F.SSQ = (float*)(F.ws + WS_SSQ); F.HC = (bf16*)(F.ws + WS_HC); F.HL = (bf16*)(F.ws + WS_LRU);
    F.WT = (bf16*)(F.ws + WS_WT); F.XS = (bf16*)(F.ws + WS_XS); F.R = F.ws + WS_R; F.HF = (float*)(F.ws + WS_HF);
    if (threadIdx.x < 8) ((LAS unsigned*)(F.lds + MISC_OFF))[threadIdx.x] = 0u;
    __syncthreads();
    XcdBarrier bar; bar.bar = (unsigned*)(F.ws + WS_CTL) + 4096; bar.st = (volatile LAS unsigned*)(F.lds + MISC_OFF); bar.x = xb_xcc_id();
    if (threadIdx.x == 0) { const unsigned li = xb_add(&bar.bar[XB_XCNT(bar.x)], 1u); ((volatile LAS unsigned*)(F.lds + MISC_OFF))[3] = li; }
    __syncthreads();
    F.xg = (int)bar.x; F.lidx = __builtin_amdgcn_readfirstlane((int)((volatile LAS unsigned*)(F.lds + MISC_OFF))[3]); F.xm = 0;
    p0a(F, args); lru_wprep(F, args); convert_all_weights(F, args);
    GSYNC();
    if (XCDMODE) {
        if (threadIdx.x == 0) { unsigned ok = (F.G == 256) ? 1u : 0u;
            for (unsigned j = 0; j < 16; ++j) { const unsigned cj = xb_ld(&bar.bar[XB_XCNT(j)]); if (cj != (j < 8 ? 32u : 0u)) ok = 0u; }
            ((volatile LAS unsigned*)(F.lds + MISC_OFF))[4] = ok; }
        __syncthreads();
        F.xm = __builtin_amdgcn_readfirstlane((int)((volatile LAS unsigned*)(F.lds + MISC_OFF))[4]);
    }
    p0b(F, args); GSYNC();
    p1_std<0>(F, args); XSYNC(); mixer<0>(F, args, bar); if (!(CHAIN && F.xm)) XSYNC();
    if constexpr (CHAIN) { chain<0>(F, args, bar); } else { tail_std<0>(F, args, bar); p1_std<1>(F, args); XSYNC(); }
    mixer<1>(F, args, bar); if (!(CHAIN && F.xm)) XSYNC();
    if constexpr (CHAIN) { chain<1>(F, args, bar); } else { tail_std<1>(F, args, bar); p1_std<2>(F, args); XSYNC(); }
    mixer<2>(F, args, bar); if (!(CHAIN && F.xm)) XSYNC();
    if constexpr (CHAIN) { chain<2>(F, args, bar); } else { tail_std<2>(F, args, bar); p1_std<3>(F, args); XSYNC(); }
    mixer<3>(F, args, bar); XSYNC();
    tail_std<3>(F, args, bar);
}

extern "C" void kernel_launch(void* const* d_in, const int* in_sizes, int n_in, void* d_out, int out_size, void* d_ws, size_t ws_size, hipStream_t stream) {
    static int grid = 0;
    if (grid == 0) {
        if (n_in != 30 || out_size != ML * DM || ws_size < WS_END) { fprintf(stderr, "kernel_launch: unexpected shapes (n_in %d out %d ws %zu); nothing launched\n", n_in, out_size, ws_size); grid = -1; return; }
        int dev = 0, cus = 0, per_cu = 0;
        if (hipGetDevice(&dev) != hipSuccess || hipDeviceGetAttribute(&cus, hipDeviceAttributeMultiprocessorCount, dev) != hipSuccess) { grid = -1; return; }
        if (hipFuncSetAttribute((const void*)fwd_kernel, hipFuncAttributeMaxDynamicSharedMemorySize, LDS_BYTES) != hipSuccess) { fprintf(stderr, "kernel_launch: hipFuncSetAttribute failed\n"); grid = -1; return; }
        if (hipOccupancyMaxActiveBlocksPerMultiprocessor(&per_cu, (const void*)fwd_kernel, NWAVES * 64, LDS_BYTES) != hipSuccess || per_cu < 1) { fprintf(stderr, "kernel_launch: occupancy query says %d\n", per_cu); per_cu = 1; }
        (void)hipGetLastError();
        grid = cus * (per_cu > 1 ? 1 : per_cu);
    }
    if (grid < 0) return;
    if (hipMemsetAsync((char*)d_ws + WS_CTL, 0, CTL_ZERO_BYTES, stream) != hipSuccess) { fprintf(stderr, "kernel_launch: memset failed\n"); return; }
    Args a{};
    for (int i = 0; i < 30; ++i) a.in[i] = (const float*)d_in[i];
    a.out = (float*)d_out; a.ws = (unsigned char*)d_ws;
    void* kargs[] = {&a};
    const hipError_t e = hipLaunchCooperativeKernel((const void*)fwd_kernel, dim3(grid), dim3(NWAVES * 64), kargs, LDS_BYTES, stream);
    if (e != hipSuccess) fprintf(stderr, "kernel_launch: cooperative launch failed: %s (grid %d)\n", hipGetErrorString(e), grid);
}
```
